# Optimizing an MI355X kernel written in HIP

```python
import math
import jax, jax.numpy as jnp
from jax import lax
import numpy as np

D_MODEL = 1024
BATCH = 2
SEQ = 8192
DEPTH = 1
DEC_BATCH = 8
DEC_SEQ = 8192
PAST_LEN = 128

MIX_WIDTH = D_MODEL
HG_WIDTH = MIX_WIDTH // 2
HG_EXPAND = 128
HG_HEADS = HG_WIDTH // HG_EXPAND
HG_DV = HG_WIDTH // HG_HEADS
HG_CHUNK = 64
AT_WIDTH = MIX_WIDTH - HG_WIDTH
AT_HEAD_DIM = 64
AT_HEADS = AT_WIDTH // AT_HEAD_DIM
AT_KV_HEADS = 2
WINDOW = 128
BLOCK = 128
ROPE_THETA = 10000.0
D_FF = 2816
EPS = 1e-6
N_IN = 5 * HG_WIDTH + AT_WIDTH + 2 * AT_KV_HEADS * AT_HEAD_DIM

kernel_name = "hymba_hgrn2_window_gqa_macaron_encoder"


def rmsnorm(x, g):
    xf = x.astype(jnp.float32)
    y = xf * lax.rsqrt(jnp.mean(xf * xf, axis=-1, keepdims=True) + EPS)
    return (y * g.astype(jnp.float32)).astype(x.dtype)


def swiglu(x, wi, wo):
    gu = x @ wi.astype(x.dtype)
    gate, up = jnp.split(gu, 2, axis=-1)
    return (jax.nn.silu(gate) * up) @ wo.astype(x.dtype)


def gla_scan(q, k, v, logf):
    B, S, H, DK = q.shape
    DV = v.shape[-1]
    C = HG_CHUNK
    N = S // C

    def to_chunks(a):
        return a.reshape(B, N, C, H, a.shape[-1]).transpose(1, 0, 3, 2, 4)

    qc, kc, vc, fc = to_chunks(q), to_chunks(k), to_chunks(v), to_chunks(logf)
    causal = jnp.tril(jnp.ones((C, C), dtype=bool))[:, :, None]

    def step(state, inp):
        qi, ki, vi, fi = inp
        b = jnp.cumsum(fi, axis=2)
        o_inter = jnp.einsum('bhtk,bhkv->bhtv', qi * jnp.exp(b), state)
        diff = b[:, :, :, None, :] - b[:, :, None, :, :]
        decay = jnp.exp(jnp.where(causal, diff, -jnp.inf))
        A = jnp.einsum('bhtk,bhsk,bhtsk->bhts', qi, ki, decay)
        o_intra = jnp.einsum('bhts,bhsv->bhtv', A, vi)
        b_last = b[:, :, -1:, :]
        new_state = jnp.exp(b_last[:, :, 0, :])[..., None] * state + jnp.einsum(
            'bhsk,bhsv->bhkv', ki * jnp.exp(b_last - b), vi)
        return new_state, o_inter + o_intra

    s0 = jnp.zeros((B, H, DK, DV), jnp.float32)
    _, o = lax.scan(step, s0, (qc, kc, vc, fc))
    return o.transpose(1, 0, 3, 2, 4).reshape(B, S, H, DV)


def hgrn2_bidir(hq, hf_fwd, hf_bwd, hi, hg, lb_fwd, lb_bwd, out_norm):
    B, S, _ = hq.shape
    heads = lambda a: a.reshape(B, S, HG_HEADS, -1)
    q = heads(jax.nn.silu(hq.astype(jnp.float32)))
    v = heads(hi.astype(jnp.float32))

    def gates(fpre, lb):
        f = lb + (1.0 - lb) * jax.nn.sigmoid(fpre.astype(jnp.float32))
        return heads(jnp.log(f)), heads(1.0 - f)

    logf_f, k_f = gates(hf_fwd, lb_fwd)
    logf_b, k_b = gates(hf_bwd, lb_bwd)
    o_f = gla_scan(q, k_f, v, logf_f)
    flip = lambda a: jnp.flip(a, axis=1)
    o_b = flip(gla_scan(flip(q), flip(k_b), flip(v), flip(logf_b)))
    o = o_f + o_b
    o = o * lax.rsqrt(jnp.mean(o * o, axis=-1, keepdims=True) + EPS) * out_norm.astype(jnp.float32)
    o = o.reshape(B, S, HG_WIDTH) * jax.nn.silu(hg.astype(jnp.float32))
    return o.astype(hq.dtype)


def rope(x, cos, sin):
    x1, x2 = jnp.split(x, 2, axis=-1)
    return jnp.concatenate([x1 * cos - x2 * sin, x2 * cos + x1 * sin], axis=-1)


def window_gqa(aq, ak, av, q_norm, k_norm, sink):
    B, S, _ = aq.shape
    dt = aq.dtype
    NB = S // BLOCK
    G = AT_HEADS // AT_KV_HEADS
    q = aq.reshape(B, S, AT_HEADS, AT_HEAD_DIM)
    k = ak.reshape(B, S, AT_KV_HEADS, AT_HEAD_DIM)
    v = av.reshape(B, S, AT_KV_HEADS, AT_HEAD_DIM)
    pos = jnp.arange(S, dtype=jnp.float32)
    inv_freq = ROPE_THETA ** (-jnp.arange(0, AT_HEAD_DIM, 2, dtype=jnp.float32) / AT_HEAD_DIM)
    ang = pos[:, None] * inv_freq[None, :]
    cos, sin = jnp.cos(ang)[:, None, :], jnp.sin(ang)[:, None, :]
    q = rope(rmsnorm(q, q_norm).astype(jnp.float32), cos, sin).astype(dt)
    k = rope(rmsnorm(k, k_norm).astype(jnp.float32), cos, sin).astype(dt)

    qb = q.reshape(B, NB, BLOCK, AT_KV_HEADS, G, AT_HEAD_DIM)
    padw = ((0, 0), (BLOCK, BLOCK), (0, 0), (0, 0))

    def band(a):
        ap = jnp.pad(a, padw).reshape(B, NB + 2, BLOCK, AT_KV_HEADS, AT_HEAD_DIM)
        return jnp.concatenate([ap[:, :-2], ap[:, 1:-1], ap[:, 2:]], axis=2)

    kb, vb = band(k), band(v)
    scale = 1.0 / math.sqrt(AT_HEAD_DIM)
    s = jnp.einsum('bnqhgd,bnkhd->bnhgqk', qb, kb, preferred_element_type=jnp.float32) * scale
    kpos = jnp.arange(3 * BLOCK) - BLOCK
    rel = kpos[None, :] - jnp.arange(BLOCK)[:, None]
    abs_k = jnp.arange(NB)[:, None, None] * BLOCK + kpos[None, None, :]
    mask = (jnp.abs(rel) <= WINDOW)[None] & (abs_k >= 0) & (abs_k < S)
    s = jnp.where(mask[None, :, None, None], s, -jnp.inf)
    sink_l = sink.astype(jnp.float32).reshape(AT_KV_HEADS, G)[None, None, :, :, None, None]
    m = jnp.maximum(jnp.max(s, axis=-1, keepdims=True), sink_l)
    p = jnp.exp(s - m)
    p = p / (jnp.sum(p, axis=-1, keepdims=True) + jnp.exp(sink_l - m))
    o = jnp.einsum('bnhgqk,bnkhd->bnqhgd', p.astype(dt), vb)
    return o.reshape(B, S, AT_WIDTH)


def setup_inputs(seed: int = 0) -> dict:
    key = jax.random.key(seed)
    ks = jax.random.split(key, 17)
    nrm = lambda k, shape, s: jax.random.normal(k, shape, jnp.float32) * s
    gain = lambda k, shape: 1.0 + nrm(k, shape, 0.05)
    return {
        "x_prompt": nrm(ks[0], (BATCH, SEQ, D_MODEL), 1.0),
        "x_sample": nrm(ks[1], (DEC_BATCH, DEC_SEQ, D_MODEL), 1.0),
        "ffn1_norm": gain(ks[2], (DEPTH, D_MODEL)),
        "ffn1_wi": nrm(ks[3], (DEPTH, D_MODEL, 2 * D_FF), D_MODEL ** -0.5),
        "ffn1_wo": nrm(ks[4], (DEPTH, D_FF, D_MODEL), D_FF ** -0.5),
        "mix_norm": gain(ks[5], (DEPTH, D_MODEL)),
        "w_in": nrm(ks[6], (DEPTH, D_MODEL, N_IN), D_MODEL ** -0.5),
        "hg_lb_fwd": nrm(ks[7], (DEPTH + 1, HG_WIDTH), 0.5),
        "hg_lb_bwd": nrm(ks[8], (DEPTH + 1, HG_WIDTH), 0.5),
        "hg_out_norm": gain(ks[9], (DEPTH, HG_DV)),
        "q_norm": gain(ks[10], (DEPTH, AT_HEAD_DIM)),
        "k_norm": gain(ks[11], (DEPTH, AT_HEAD_DIM)),
        "attn_sink": nrm(ks[12], (DEPTH, AT_HEADS), 0.5),
        "w_out": nrm(ks[13], (DEPTH, MIX_WIDTH, D_MODEL), MIX_WIDTH ** -0.5),
        "ffn2_norm": gain(ks[14], (DEPTH, D_MODEL)),
        "ffn2_wi": nrm(ks[15], (DEPTH, D_MODEL, 2 * D_FF), D_MODEL ** -0.5),
        "ffn2_wo": nrm(ks[16], (DEPTH, D_FF, D_MODEL), D_FF ** -0.5),
    }


def reference(x_prompt, x_sample, ffn1_norm, ffn1_wi, ffn1_wo, mix_norm, w_in, hg_lb_fwd, hg_lb_bwd,
              hg_out_norm, q_norm, k_norm, attn_sink, w_out, ffn2_norm, ffn2_wi, ffn2_wo):
    lb_f_all = jnp.cumsum(jax.nn.softmax(hg_lb_fwd.astype(jnp.float32), axis=0), axis=0)
    lb_b_all = jnp.cumsum(jax.nn.softmax(hg_lb_bwd.astype(jnp.float32), axis=0), axis=0)
    splits = np.cumsum([HG_WIDTH] * 5 + [AT_WIDTH, AT_KV_HEADS * AT_HEAD_DIM])

    def trunk(x):
        for l in range(DEPTH):
            x = x + 0.5 * swiglu(rmsnorm(x, ffn1_norm[l]), ffn1_wi[l], ffn1_wo[l])
            h = rmsnorm(x, mix_norm[l])
            proj = h @ w_in[l].astype(h.dtype)
            hq, hf_f, hf_b, hi, hg, aq, ak, av = jnp.split(proj, splits, axis=-1)
            o_hg = hgrn2_bidir(hq, hf_f, hf_b, hi, hg, lb_f_all[l], lb_b_all[l], hg_out_norm[l])
            o_at = window_gqa(aq, ak, av, q_norm[l], k_norm[l], attn_sink[l])
            mixed = jnp.concatenate([o_hg, o_at], axis=-1)
            x = x + mixed @ w_out[l].astype(x.dtype)
            x = x + 0.5 * swiglu(rmsnorm(x, ffn2_norm[l]), ffn2_wi[l], ffn2_wo[l])
        return x

    y_prompt = trunk(x_prompt)
    y_sample = trunk(x_sample)
    return (y_prompt, y_sample)
```

```cpp
#include <hip/hip_runtime.h>
#include <hip/hip_cooperative_groups.h>
#include <cstdio>
#include <cmath>
namespace cg = cooperative_groups;
constexpr int DM = 1024, SEQ = 8192, NSEQ = 10, MTOK = NSEQ * SEQ, NPROMPT = 2 * SEQ, DFF = 2816, NIN = 3328;
constexpr float EPSV = 1e-6f;
#include <hip/hip_runtime.h>
#include <cstdio>
#include <cstdint>
namespace pg8 {
#define PG8_LAS __attribute__((address_space(3)))
typedef unsigned short bf16_t;
typedef short bf16x8 __attribute__((ext_vector_type(8)));
typedef float f32x4 __attribute__((ext_vector_type(4)));
typedef unsigned u32x4 __attribute__((ext_vector_type(4)));
constexpr int BM = 256, BK = 64, HALF = 128, HTB = HALF * BK * 2  , STAGE_BYTES = 8 * HTB, NXCD = 8, WGM = 8;

__host__ __device__ __forceinline__ int lds_byte(int r, int c) { const int st = (r >> 4) * 2 + (c >> 5), rr = r & 15, cc = c & 31, ob = rr * 64 + cc * 2; return st * 1024 + (ob ^ (((ob >> 9) & 1) << 5)); }
__host__ __device__ __forceinline__ void stage_rc(int b, int& R, int& C) { const int st = b / 1024, sb = b % 1024, swz = sb ^ (((sb >> 9) & 1) << 5); R = (st >> 1) * 16 + swz / 64; C = (st & 1) * 32 + (swz % 64) / 2; }
__host__ __device__ __forceinline__ int perm32(int rho) { const int n = rho >> 4, i = rho & 15; return 8 * (i >> 2) + 4 * n + (i & 3); }

struct Unit { int pm, pn; };
struct Gemm { const bf16_t* A; const bf16_t* Bt; int M, N, K; };

struct StaticOrder {
    int nM, nN, nwg, G, c;
    __host__ __device__ void init(int M, int N, int G_, int c_) { nM = M / BM; nN = N / BM; nwg = nM * nN; G = G_; c = c_; }
    __host__ __device__ bool next(int i, Unit& u) const {
        const long L = (long)i * G + c; if (L >= nwg) return false;
        int wgid = (int)L; { const int q = nwg / NXCD, r = nwg % NXCD, xcd = wgid % NXCD, off = wgid / NXCD; wgid = (xcd < r ? xcd * (q + 1) : r * (q + 1) + (xcd - r) * q) + off; }
        const int nig = WGM * nN, gid = wgid / nig, fm = gid * WGM, gsz = (nM - fm) < WGM ? (nM - fm) : WGM;
        u.pm = fm + ((wgid % nig) % gsz); u.pn = (wgid % nig) / gsz; return true;
    }
    __device__ __forceinline__ void a_ready(const Unit&) const {}
    __device__ __forceinline__ void done(const Unit&) const {}
};

__device__ __forceinline__ unsigned cvt_pk_bf16(float lo, float hi) { unsigned r; asm volatile("v_cvt_pk_bf16_f32 %0, %1, %2" : "=v"(r) : "v"(lo), "v"(hi)); return r; }
__device__ __forceinline__ float sigmoidf_(float v) { return __builtin_amdgcn_rcpf(1.0f + __expf(-v)); }
__device__ __forceinline__ float siluf_(float v) { return v * sigmoidf_(v); }

template <bool NORMED> struct EpiSwiglu {
    static constexpr bool PERM = true, AFTER_DRAIN = false;
    bf16_t* H; const float* rstd;
    __device__ __forceinline__ void operator()(const f32x4 (&acc)[2][2][4][2], const Unit& u, int wr, int wc, int fr, int fq) const {
        const int row0 = u.pm * BM + wr * 64 + fr, col0 = u.pn * 128 + wc * 32 + 8 * fq;
        float rsv[2][4];
#pragma unroll
        for (int ai = 0; ai < 2; ++ai)
#pragma unroll
            for (int m = 0; m < 4; ++m) rsv[ai][m] = NORMED ? 1.0f : rstd[row0 + ai * HALF + m * 16];
#pragma unroll
        for (int ai = 0; ai < 2; ++ai)
#pragma unroll
            for (int m = 0; m < 4; ++m) { const int row = row0 + ai * HALF + m * 16; const float rs = rsv[ai][m];
                float hv[8];
#pragma unroll
                for (int n = 0; n < 2; ++n)
#pragma unroll
                    for (int j = 0; j < 4; ++j) { const float g = acc[ai][0][m][n][j] * rs, uu = acc[ai][1][m][n][j] * rs; hv[4 * n + j] = siluf_(g) * uu; }
                u32x4 w; w.x = cvt_pk_bf16(hv[0], hv[1]); w.y = cvt_pk_bf16(hv[2], hv[3]); w.z = cvt_pk_bf16(hv[4], hv[5]); w.w = cvt_pk_bf16(hv[6], hv[7]);
                *(u32x4*)(H + (size_t)row * DFF + col0) = w; }
    }
};
template <int RESMODE, bool OUT_F32, bool AUX, bool HALFSCALE> struct EpiRes {
    static constexpr bool PERM = true, AFTER_DRAIN = false;
    float* out; const float* xp; const float* xs; const bf16_t* resb; bf16_t* xb; float* ssq;
    __device__ __forceinline__ void operator()(const f32x4 (&acc)[2][2][4][2], const Unit& u, int wr, int wc, int fr, int fq) const {
        const int row0 = u.pm * BM + wr * 64 + fr, col0 = u.pn * BM + wc * 32 + 8 * fq;
#pragma unroll
        for (int ai = 0; ai < 2; ++ai)
#pragma unroll
            for (int m = 0; m < 4; ++m) { const int row = row0 + ai * HALF + m * 16;
                const float* resrow = (row < NPROMPT ? xp + (size_t)row * DM : xs + (size_t)(row - NPROMPT) * DM);
                float ss = 0.f;
#pragma unroll
                for (int bj = 0; bj < 2; ++bj) { const int col = col0 + bj * HALF; f32x4 r0, r1;
                    if (RESMODE == 0) { r0 = *(const f32x4*)(resrow + col); r1 = *(const f32x4*)(resrow + col + 4); }
                    else { const u32x4 w = *(const u32x4*)(resb + (size_t)row * DM + col);
                        r0 = (f32x4){__builtin_bit_cast(float, w.x << 16), __builtin_bit_cast(float, w.x & 0xffff0000u), __builtin_bit_cast(float, w.y << 16), __builtin_bit_cast(float, w.y & 0xffff0000u)};
                        r1 = (f32x4){__builtin_bit_cast(float, w.z << 16), __builtin_bit_cast(float, w.z & 0xffff0000u), __builtin_bit_cast(float, w.w << 16), __builtin_bit_cast(float, w.w & 0xffff0000u)}; }
                    const f32x4 o0 = r0 + acc[ai][bj][m][0] * (HALFSCALE ? 0.5f : 1.0f), o1 = r1 + acc[ai][bj][m][1] * (HALFSCALE ? 0.5f : 1.0f);
                    if (OUT_F32) { *(f32x4*)(out + (size_t)row * DM + col) = o0; *(f32x4*)(out + (size_t)row * DM + col + 4) = o1; }
                    else { u32x4 w; w.x = cvt_pk_bf16(o0[0], o0[1]); w.y = cvt_pk_bf16(o0[2], o0[3]); w.z = cvt_pk_bf16(o1[0], o1[1]); w.w = cvt_pk_bf16(o1[2], o1[3]); *(u32x4*)(xb + (size_t)row * DM + col) = w; }
                    if (AUX) ss += ((o0[0] * o0[0] + o0[1] * o0[1]) + (o0[2] * o0[2] + o0[3] * o0[3])) + ((o1[0] * o1[0] + o1[1] * o1[1]) + (o1[2] * o1[2] + o1[3] * o1[3])); }
                if (AUX) { ss += __shfl_xor(ss, 16); ss += __shfl_xor(ss, 32); if (fq == 0) ssq[(size_t)row * 16 + u.pn * 4 + wc] = ss; } }
    }
};
struct EpiProj {
    static constexpr bool PERM = true, AFTER_DRAIN = false;
    bf16_t* P; const float* ssq; const float* lbf; const float* lbb; const float* qn; const float* kn; const float* rope;
    __device__ __forceinline__ void operator()(const f32x4 (&acc)[2][2][4][2], const Unit& u, int wr, int wc, int fr, int fq) const {
        const int row0 = u.pm * BM + wr * 64 + fr, colw = wc * 32 + 8 * fq; const int pn = u.pn;
        float rsv[2][4];
#pragma unroll
        for (int ai = 0; ai < 2; ++ai)
#pragma unroll
            for (int m = 0; m < 4; ++m) rsv[ai][m] = ssq[row0 + ai * HALF + m * 16];
        if (pn >= 10) {
            const bool isv = (pn == 12 && wc >= 2), isq = pn < 12;
            const int cbase = isq ? 2560 + ((pn - 10) * 4 + wc) * 64 : (wc < 2 ? 3072 + wc * 64 : 3200 + (wc - 2) * 64);
            const float* gn = isq ? qn : kn; float glo[8], ghi[8];
#pragma unroll
            for (int j = 0; j < 8; ++j) { glo[j] = gn[8 * fq + j]; ghi[j] = gn[32 + 8 * fq + j]; }
#pragma unroll
            for (int ai = 0; ai < 2; ++ai)
#pragma unroll
                for (int m = 0; m < 4; ++m) { const int row = row0 + ai * HALF + m * 16;
                    const float rs = rsv[ai][m];
                    float lo[8], hi[8];
#pragma unroll
                    for (int n = 0; n < 2; ++n)
#pragma unroll
                        for (int j = 0; j < 4; ++j) { lo[4 * n + j] = acc[ai][0][m][n][j] * rs; hi[4 * n + j] = acc[ai][1][m][n][j] * rs; }
                    if (!isv) {
                        float ss = 0.f;
#pragma unroll
                        for (int j = 0; j < 8; ++j) ss += lo[j] * lo[j] + hi[j] * hi[j];
                        ss += __shfl_xor(ss, 16); ss += __shfl_xor(ss, 32);
                        const float rn = __builtin_amdgcn_rsqf(ss * (1.0f / 64.0f) + EPSV) * (isq ? 0.125f : 1.0f);
                        const float* rt = rope + (size_t)(row & (SEQ - 1)) * 64 + 8 * fq;
                        const f32x4 c0 = *(const f32x4*)(rt), c1 = *(const f32x4*)(rt + 4), n0 = *(const f32x4*)(rt + 32), n1 = *(const f32x4*)(rt + 36);
#pragma unroll
                        for (int j = 0; j < 8; ++j) { const float a = lo[j] * rn * glo[j], bb = hi[j] * rn * ghi[j], cs = (j < 4 ? c0[j] : c1[j - 4]), sn = (j < 4 ? n0[j] : n1[j - 4]); lo[j] = a * cs - bb * sn; hi[j] = bb * cs + a * sn; }
                    }
                    u32x4 w0, w1; w0.x = cvt_pk_bf16(lo[0], lo[1]); w0.y = cvt_pk_bf16(lo[2], lo[3]); w0.z = cvt_pk_bf16(lo[4], lo[5]); w0.w = cvt_pk_bf16(lo[6], lo[7]);
                    w1.x = cvt_pk_bf16(hi[0], hi[1]); w1.y = cvt_pk_bf16(hi[2], hi[3]); w1.z = cvt_pk_bf16(hi[4], hi[5]); w1.w = cvt_pk_bf16(hi[6], hi[7]);
                    *(u32x4*)(P + (size_t)row * NIN + cbase + 8 * fq) = w0; *(u32x4*)(P + (size_t)row * NIN + cbase + 32 + 8 * fq) = w1; }
            return;
        }
        const int kind = (pn < 2 || pn == 8 || pn == 9) ? 1 : ((pn >= 2 && pn < 6) ? 2 : 0);
        float lbv[2][8];
        if (kind == 2) { const float* lb = (pn < 4) ? lbf + (pn - 2) * 256 : lbb + (pn - 4) * 256;
#pragma unroll
            for (int bj = 0; bj < 2; ++bj)
#pragma unroll
                for (int j = 0; j < 8; ++j) lbv[bj][j] = lb[bj * HALF + colw + j]; }
#pragma unroll
        for (int ai = 0; ai < 2; ++ai)
#pragma unroll
            for (int m = 0; m < 4; ++m) { const int row = row0 + ai * HALF + m * 16;
                const float rs = rsv[ai][m];
#pragma unroll
                for (int bj = 0; bj < 2; ++bj) { float v[8];
#pragma unroll
                    for (int n = 0; n < 2; ++n)
#pragma unroll
                        for (int j = 0; j < 4; ++j) v[4 * n + j] = acc[ai][bj][m][n][j] * rs;
                    u32x4 w;
                    if (kind == 2) {
#pragma unroll
                        for (int j = 0; j < 8; ++j) { const float lb = lbv[bj][j]; v[j] = __logf(lb + (1.0f - lb) * sigmoidf_(v[j])); }
                        w.x = __builtin_bit_cast(unsigned, __builtin_amdgcn_cvt_pkrtz(v[0], v[1])); w.y = __builtin_bit_cast(unsigned, __builtin_amdgcn_cvt_pkrtz(v[2], v[3]));
                        w.z = __builtin_bit_cast(unsigned, __builtin_amdgcn_cvt_pkrtz(v[4], v[5])); w.w = __builtin_bit_cast(unsigned, __builtin_amdgcn_cvt_pkrtz(v[6], v[7]));
                    } else {
                        if (kind == 1) {
#pragma unroll
                            for (int j = 0; j < 8; ++j) v[j] = siluf_(v[j]); }
                        w.x = cvt_pk_bf16(v[0], v[1]); w.y = cvt_pk_bf16(v[2], v[3]); w.z = cvt_pk_bf16(v[4], v[5]); w.w = cvt_pk_bf16(v[6], v[7]); }
                    *(u32x4*)(P + (size_t)row * NIN + pn * BM + bj * HALF + colw) = w; } }
    }
};

template <class Epi, class Sched, bool ALIGN_EPI = false, bool SP2 = false>
__device__ __forceinline__ void gemm_phase(PG8_LAS unsigned char* lds, const Gemm g, const Sched& S, const Epi& E) {
    const int tid = threadIdx.x, wid = __builtin_amdgcn_readfirstlane(tid >> 6), lane = tid & 63, wr = wid >> 2, wc = wid & 3, fr = lane & 15, fq = lane >> 4;
    const int K = g.K, nt = K / BK;
    unsigned voffA[2], voffB[2];
#pragma unroll
    for (int i = 0; i < 2; ++i) { int R, C; stage_rc(tid * 16 + i * 8192, R, C); const int Rb = Epi::PERM ? ((R & ~31) + perm32(R & 31)) : R;
        voffA[i] = (unsigned)(R * K + C) * 2u; voffB[i] = (unsigned)(Rb * K + C) * 2u; }
    const size_t kstep = (size_t)(BK * 2);
    const size_t hstep = (size_t)HALF * K * 2;
    const size_t tstep = 2 * hstep;
    const unsigned ldsw = (unsigned)wid * 1024u;
    const int aoff = lds_byte(wr * 64 + fr, fq * 8), boff = lds_byte(wc * 32 + fr, fq * 8);
#define PG8_SA(b, h) (((b) * 2 + (h)) * HTB)
#define PG8_SB(b, h) ((4 + (b) * 2 + (h)) * HTB)
#define PG8_STAGE(bufoff, gbase, voff) do { _Pragma("unroll") for (int _i = 0; _i < 2; ++_i) \
        __builtin_amdgcn_global_load_lds((const unsigned*)((const char*)(gbase) + (voff)[_i]), (PG8_LAS unsigned*)(lds + (bufoff) + ldsw + _i * 8192), 16, 0, 0); } while (0)
#define PG8_LDA(dst, b, h) do { _Pragma("unroll") for (int m = 0; m < 4; ++m) _Pragma("unroll") for (int k = 0; k < 2; ++k) dst[m][k] = *(const PG8_LAS bf16x8*)(lds + PG8_SA(b, h) + aoff + m * 2048 + k * 1024); } while (0)
#define PG8_LDB(dst, b, h) do { _Pragma("unroll") for (int n = 0; n < 2; ++n) _Pragma("unroll") for (int k = 0; k < 2; ++k) dst[n][k] = *(const PG8_LAS bf16x8*)(lds + PG8_SB(b, h) + boff + n * 2048 + k * 1024); } while (0)
#define PG8_MMA(ai, bj, At, Bt) do { __builtin_amdgcn_s_setprio(1); _Pragma("unroll") for (int m = 0; m < 4; ++m) _Pragma("unroll") for (int n = 0; n < 2; ++n) _Pragma("unroll") for (int k = 0; k < 2; ++k) \
        acc[ai][bj][m][n] = __builtin_amdgcn_mfma_f32_16x16x32_bf16(Bt[n][k], At[m][k], acc[ai][bj][m][n], 0, 0, 0); __builtin_amdgcn_s_setprio(0); } while (0)
#define PG8_WAIT_V(n) asm volatile("s_waitcnt vmcnt(" #n ")" ::: "memory")
#define PG8_WAIT_L(n) asm volatile("s_waitcnt lgkmcnt(" #n ")" ::: "memory")
#define PG8_BAR __builtin_amdgcn_s_barrier()
#define PG8_SCHED __builtin_amdgcn_sched_barrier(0)
    Unit cur, nxt; int ui = 0;
    if (!S.next(0, cur)) return;
    f32x4 acc[2][2][4][2];
#pragma unroll
    for (int a = 0; a < 2; ++a)
#pragma unroll
        for (int b = 0; b < 2; ++b)
#pragma unroll
            for (int m = 0; m < 4; ++m)
#pragma unroll
                for (int n = 0; n < 2; ++n) acc[a][b][m][n] = (f32x4){0.f, 0.f, 0.f, 0.f};
    bf16x8 At[4][2], B0[2][2], B1[2][2];
    const char* cA = (const char*)g.A + (size_t)cur.pm * tstep; const char* cB = (const char*)g.Bt + (size_t)cur.pn * tstep;
    S.a_ready(cur);
    if constexpr (SP2) {
        PG8_STAGE(PG8_SB(0, 0), cB, voffB); PG8_STAGE(PG8_SB(0, 1), cB + hstep, voffB); PG8_STAGE(PG8_SA(0, 0), cA, voffA); PG8_STAGE(PG8_SA(0, 1), cA + hstep, voffA);
        if (wr == 1) PG8_BAR;
        PG8_WAIT_V(2); PG8_BAR;
        PG8_STAGE(PG8_SB(1, 0), cB + kstep, voffB); PG8_STAGE(PG8_SA(1, 0), cA + kstep, voffA); PG8_STAGE(PG8_SB(1, 1), cB + hstep + kstep, voffB);
        PG8_WAIT_V(6); PG8_BAR;
    } else {
        PG8_STAGE(PG8_SB(0, 0), cB, voffB); PG8_STAGE(PG8_SA(0, 0), cA, voffA); PG8_STAGE(PG8_SB(0, 1), cB + hstep, voffB); PG8_STAGE(PG8_SA(0, 1), cA + hstep, voffA);
        if (wr == 1) PG8_BAR;
        PG8_WAIT_V(4); PG8_BAR;
        PG8_STAGE(PG8_SB(1, 0), cB + kstep, voffB); PG8_STAGE(PG8_SA(1, 0), cA + kstep, voffA); PG8_STAGE(PG8_SB(1, 1), cB + hstep + kstep, voffB);
        PG8_WAIT_V(6); PG8_BAR;
    }
    for (;;) {
        const bool has_next = S.next(ui + 1, nxt);
        const char* nA = has_next ? (const char*)g.A + (size_t)nxt.pm * tstep : cA; const char* nB = has_next ? (const char*)g.Bt + (size_t)nxt.pn * tstep : cB;
        for (int t = 0; t < nt; t += 2) {
            const bool last = (t == nt - 2);
            const char* a1 = cA + (size_t)(t + 1) * kstep;
            const char* a2 = last ? nA : cA + (size_t)(t + 2) * kstep; const char* b2 = last ? nB : cB + (size_t)(t + 2) * kstep;
            const char* a3 = a2 + kstep; const char* b3 = b2 + kstep;
            if (last && has_next) S.a_ready(nxt);
            if constexpr (SP2) {
            PG8_LDB(B0, 0, 0); PG8_LDB(B1, 0, 1); PG8_SCHED; PG8_LDA(At, 0, 0); PG8_STAGE(PG8_SA(1, 1), a1 + hstep, voffA);
            PG8_WAIT_V(8); PG8_WAIT_L(0); PG8_BAR; PG8_MMA(0, 0, At, B0); PG8_MMA(0, 1, At, B1); PG8_BAR; PG8_SCHED;
            PG8_LDA(At, 0, 1); PG8_STAGE(PG8_SB(0, 0), b2, voffB); PG8_STAGE(PG8_SB(0, 1), b2 + hstep, voffB); PG8_STAGE(PG8_SA(0, 0), a2, voffA);
            PG8_WAIT_V(8); PG8_WAIT_L(0); PG8_BAR; PG8_MMA(1, 0, At, B0); PG8_MMA(1, 1, At, B1); PG8_BAR; PG8_SCHED;
            PG8_LDB(B0, 1, 0); PG8_LDB(B1, 1, 1); PG8_SCHED; PG8_LDA(At, 1, 0); PG8_STAGE(PG8_SA(0, 1), a2 + hstep, voffA);
            PG8_WAIT_V(8); PG8_WAIT_L(0); PG8_BAR; PG8_MMA(0, 0, At, B0); PG8_MMA(0, 1, At, B1); PG8_BAR; PG8_SCHED;
            PG8_LDA(At, 1, 1); PG8_STAGE(PG8_SB(1, 0), b3, voffB); PG8_STAGE(PG8_SB(1, 1), b3 + hstep, voffB); PG8_STAGE(PG8_SA(1, 0), a3, voffA);
            PG8_WAIT_V(8); PG8_WAIT_L(0); PG8_BAR; PG8_MMA(1, 0, At, B0); PG8_MMA(1, 1, At, B1); PG8_BAR; PG8_SCHED;
            } else {
            PG8_LDB(B0, 0, 0); PG8_SCHED; PG8_LDA(At, 0, 0); PG8_STAGE(PG8_SA(1, 1), a1 + hstep, voffA);
            PG8_WAIT_L(8); PG8_BAR; PG8_WAIT_L(0); PG8_MMA(0, 0, At, B0); PG8_BAR; PG8_SCHED;
            PG8_LDB(B1, 0, 1); PG8_STAGE(PG8_SB(0, 0), b2, voffB);
            PG8_BAR; PG8_WAIT_L(0); PG8_MMA(0, 1, At, B1); PG8_BAR;
            PG8_LDA(At, 0, 1); PG8_STAGE(PG8_SA(0, 0), a2, voffA);
            PG8_BAR; PG8_WAIT_L(0); PG8_MMA(1, 0, At, B0); PG8_BAR; PG8_SCHED;
            PG8_STAGE(PG8_SB(0, 1), b2 + hstep, voffB);
            PG8_WAIT_V(6); PG8_BAR; PG8_MMA(1, 1, At, B1); PG8_BAR;
            PG8_LDB(B0, 1, 0); PG8_SCHED; PG8_LDA(At, 1, 0); PG8_STAGE(PG8_SA(0, 1), a2 + hstep, voffA);
            PG8_WAIT_L(8); PG8_BAR; PG8_WAIT_L(0); PG8_MMA(0, 0, At, B0); PG8_BAR; PG8_SCHED;
            PG8_LDB(B1, 1, 1); PG8_STAGE(PG8_SB(1, 0), b3, voffB);
            PG8_BAR; PG8_WAIT_L(0); PG8_MMA(0, 1, At, B1); PG8_BAR;
            PG8_LDA(At, 1, 1); PG8_STAGE(PG8_SA(1, 0), a3, voffA);
            PG8_BAR; PG8_WAIT_L(0); PG8_MMA(1, 0, At, B0); PG8_BAR; PG8_SCHED;
            PG8_STAGE(PG8_SB(1, 1), b3 + hstep, voffB);
            PG8_WAIT_V(6); PG8_BAR; PG8_MMA(1, 1, At, B1); PG8_BAR;
            }
        }
        if constexpr (ALIGN_EPI) { if (wr == 0) PG8_BAR; }
        if constexpr (!Epi::AFTER_DRAIN) { E(acc, cur, wr, wc, fr, fq); S.done(cur); }
        if (!has_next) break;
#pragma unroll
        for (int a = 0; a < 2; ++a)
#pragma unroll
            for (int b = 0; b < 2; ++b)
#pragma unroll
                for (int m = 0; m < 4; ++m)
#pragma unroll
                    for (int n = 0; n < 2; ++n) acc[a][b][m][n] = (f32x4){0.f, 0.f, 0.f, 0.f};
        cur = nxt; cA = nA; cB = nB; ++ui;
        if constexpr (ALIGN_EPI) { if (wr == 1) PG8_BAR; }
    }
    PG8_WAIT_V(0);
    if constexpr (!ALIGN_EPI) { if (wr == 0) PG8_BAR; }
    PG8_BAR;
    if constexpr (Epi::AFTER_DRAIN) { E.fused(acc, cur, wr, wc, fr, fq, lds, wid, lane); S.done(cur); }
#undef PG8_SA
#undef PG8_SB
#undef PG8_STAGE
#undef PG8_LDA
#undef PG8_LDB
#undef PG8_MMA
#undef PG8_WAIT_V
#undef PG8_WAIT_L
#undef PG8_BAR
#undef PG8_SCHED
}
}

#define LAS __attribute__((address_space(3)))
#define DI __device__ __forceinline__
typedef unsigned short bf16;
typedef short bf16x8 __attribute__((ext_vector_type(8)));
typedef float f32x4 __attribute__((ext_vector_type(4)));
typedef float f32x16 __attribute__((ext_vector_type(16)));
typedef unsigned u32x4 __attribute__((ext_vector_type(4)));
typedef unsigned u32x2 __attribute__((ext_vector_type(2)));
#define MFMA32(a, b, c) __builtin_amdgcn_mfma_f32_32x32x16_bf16((a), (b), (c), 0, 0, 0)
#define LDS_WAIT() asm volatile("s_waitcnt lgkmcnt(0)" ::: "memory")

constexpr int NTHREADS = 512, NWAVES = 8;
constexpr int LDS_BYTES = 155648;
constexpr int WQ_OFF = LDS_BYTES - 64;
constexpr int HGW = 512, NATT_UNITS = NSEQ * 2 * (SEQ / 64), NSCAN_UNITS = NSEQ * 16;
constexpr size_t MiB = 1u << 20;
constexpr size_t WS_WI1 = 0, WS_WO1 = 12 * MiB, WS_WIN = 18 * MiB, WS_WOUT = 25 * MiB, WS_WI2 = 27 * MiB, WS_WO2 = 39 * MiB;
constexpr size_t WS_ROPE = 45 * MiB;
constexpr size_t WS_RSTD = 48 * MiB;
constexpr size_t WS_SSQ = 49 * MiB;
constexpr size_t WS_LB = 55 * MiB;
constexpr size_t WS_CNT = 56 * MiB;
constexpr size_t WS_BARW = 57 * MiB;
constexpr size_t WS_XB = 64 * MiB;
constexpr size_t WS_BIG = 224 * MiB;
constexpr size_t WS_O = 744 * MiB;
constexpr size_t WS_VEC = 904 * MiB;
constexpr size_t WS_END = 920 * MiB;
static_assert((size_t)DM * 2 * DFF * 2 <= 12 * MiB && (size_t)DFF * DM * 2 <= 6 * MiB && (size_t)NIN * DM * 2 <= 7 * MiB, "weight map");
static_assert((size_t)MTOK * 16 * 4 <= 6 * MiB && (size_t)MTOK * DM * 2 == 160 * MiB && (size_t)MTOK * NIN * 2 <= 520 * MiB, "ws map");

struct Params {
    const float* xp; const float* xs; const float* ffn1_norm; const float* ffn1_wi; const float* ffn1_wo; const float* mix_norm; const float* w_in;
    const float* lb_fwd; const float* lb_bwd; const float* out_norm; const float* q_norm; const float* k_norm; const float* sink; const float* w_out;
    const float* ffn2_norm; const float* ffn2_wi; const float* ffn2_wo;
    float* out; unsigned char* ws;
    double inv_freq_rev[32];
    int ph_lo, ph_hi, coop, pad;
};

DI float bf2f(unsigned short b) { return __builtin_bit_cast(float, (unsigned)b << 16); }
DI float bflo(unsigned w) { return __builtin_bit_cast(float, w << 16); }
DI float bfhi(unsigned w) { return __builtin_bit_cast(float, w & 0xffff0000u); }
DI unsigned pk2(float lo, float hi) { return pg8::cvt_pk_bf16(lo, hi); }
DI unsigned short f2bf(float f) { unsigned u = __builtin_bit_cast(unsigned, f); u += 0x7fffu + ((u >> 16) & 1u); return (unsigned short)(u >> 16); }
DI float h2f(unsigned short h) { return (float)__builtin_bit_cast(_Float16, h); }
DI int crow(int reg, int h) { return (reg & 3) + 8 * (reg >> 2) + 4 * h; }
DI bf16x8 frag(const LAS unsigned char* base, int ld, int row0, int k0, int lane) { return *(const LAS bf16x8*)(base + ((row0 + (lane & 31)) * ld + k0 + 8 * (lane >> 5)) * 2); }
DI f32x16 zero16() { f32x16 z; for (int i = 0; i < 16; ++i) z[i] = 0.f; return z; }

DI void p0_transpose_item(const float* W, int K, int N, bf16* Wt, const float* gain, int perm, int item, LAS float* scr, int lane) {
    const int ntile = N / 64, nt = item % ntile, kt = item / ntile, k0 = kt * 64, n0 = nt * 64;
    int src = n0 + lane;
    if (perm == 1) { const int pn = n0 >> 8, bj = (n0 >> 7) & 1, i = n0 & 127; src = bj * DFF + pn * 128 + i + lane; }
    if (perm == 2 && n0 >= 2560) {
        const int np = n0 + lane - 2560, t = np >> 8, r = np & 255, bj = r >> 7, wc = (r >> 5) & 3, dd = r & 31;
        const int base = (t == 0) ? 2560 + wc * 64 : (t == 1) ? 2560 + (4 + wc) * 64 : (wc < 2 ? 3072 + wc * 64 : 3200 + (wc - 2) * 64);
        src = base + bj * 32 + dd; }
    float wv[64];
#pragma unroll
    for (int kk = 0; kk < 64; ++kk) wv[kk] = W[(size_t)(k0 + kk) * N + src];
    if (gain) {
#pragma unroll
        for (int kk = 0; kk < 64; kk += 4) { const f32x4 g4 = *(const f32x4*)(gain + k0 + kk); wv[kk] *= g4[0]; wv[kk + 1] *= g4[1]; wv[kk + 2] *= g4[2]; wv[kk + 3] *= g4[3]; } }
#pragma unroll
    for (int kk = 0; kk < 64; ++kk) scr[lane * 65 + kk] = wv[kk];
    LDS_WAIT();
    const int c = lane & 7;
#pragma unroll
    for (int j = 0; j < 8; ++j) { const int n = (lane >> 3) + 8 * j; const LAS float* s = scr + n * 65 + 8 * c;
        u32x4 o; o.x = pk2(s[0], s[1]); o.y = pk2(s[2], s[3]); o.z = pk2(s[4], s[5]); o.w = pk2(s[6], s[7]);
        *(u32x4*)(Wt + (size_t)(n0 + n) * K + k0 + 8 * c) = o; }
    LDS_WAIT();
}
DI void p0_prologue(const Params& p, LAS unsigned char* lds, int tid, int G, int bid) {
    const int lane = tid & 63, wave = tid >> 6, gw = bid * NWAVES + wave, NGW = G * NWAVES;
    unsigned char* ws = p.ws;
    LAS float* scr = (LAS float*)(lds + wave * 16640);
    constexpr int I_WI = (DM / 64) * (2 * DFF / 64), I_WO = (DFF / 64) * (DM / 64), I_IN = (DM / 64) * (NIN / 64), I_OUT = (DM / 64) * (DM / 64);
    constexpr int NITEMS = 2 * I_WI + 2 * I_WO + I_IN + I_OUT;
    for (int it = gw; it < NITEMS; it += NGW) {
        int r = it;
        if (r < I_WI) { p0_transpose_item(p.ffn1_wi, DM, 2 * DFF, (bf16*)(ws + WS_WI1), p.ffn1_norm, 1, r, scr, lane); continue; } r -= I_WI;
        if (r < I_WI) { p0_transpose_item(p.ffn2_wi, DM, 2 * DFF, (bf16*)(ws + WS_WI2), p.ffn2_norm, 1, r, scr, lane); continue; } r -= I_WI;
        if (r < I_WO) { p0_transpose_item(p.ffn1_wo, DFF, DM, (bf16*)(ws + WS_WO1), nullptr, 0, r, scr, lane); continue; } r -= I_WO;
        if (r < I_WO) { p0_transpose_item(p.ffn2_wo, DFF, DM, (bf16*)(ws + WS_WO2), nullptr, 0, r, scr, lane); continue; } r -= I_WO;
        if (r < I_IN) { p0_transpose_item(p.w_in, DM, NIN, (bf16*)(ws + WS_WIN), p.mix_norm, 2, r, scr, lane); continue; } r -= I_IN;
        p0_transpose_item(p.w_out, DM, DM, (bf16*)(ws + WS_WOUT), nullptr, 0, r, scr, lane);
    }
    bf16* XB = (bf16*)(ws + WS_XB); float* RSTD = (float*)(ws + WS_RSTD);
    const int RPW = (MTOK + NGW - 1) / NGW;
    for (int row0_ = gw * RPW; row0_ < min((gw + 1) * RPW, MTOK); row0_ += 8) {
        f32x4 v[8][4]; bool on[8];
#pragma unroll
        for (int u = 0; u < 8; ++u) { const int row = row0_ + u; on[u] = row < min((gw + 1) * RPW, MTOK); const int rr = on[u] ? row : row0_;
            const float* xr = (rr < NPROMPT) ? p.xp + (size_t)rr * DM : p.xs + (size_t)(rr - NPROMPT) * DM;
#pragma unroll
            for (int j = 0; j < 4; ++j) v[u][j] = *(const f32x4*)(xr + 4 * lane + 256 * j); }
#pragma unroll
        for (int u = 0; u < 8; ++u) { if (!on[u]) continue; const int row = row0_ + u; float s = 0.f;
#pragma unroll
            for (int j = 0; j < 4; ++j) s += (v[u][j][0] * v[u][j][0] + v[u][j][1] * v[u][j][1]) + (v[u][j][2] * v[u][j][2] + v[u][j][3] * v[u][j][3]);
#pragma unroll
            for (int o = 32; o >= 1; o >>= 1) s += __shfl_xor(s, o);
            const float rsx = 1.0f / sqrtf(s * (1.0f / DM) + EPSV);
#pragma unroll
            for (int j = 0; j < 4; ++j) { u32x2 w; w.x = pk2(v[u][j][0] * rsx, v[u][j][1] * rsx); w.y = pk2(v[u][j][2] * rsx, v[u][j][3] * rsx); *(u32x2*)(XB + (size_t)row * DM + 4 * lane + 256 * j) = w; } }
    }
    float* ROPE = (float*)(ws + WS_ROPE);
    for (int i = bid * NTHREADS + tid; i < SEQ * 32; i += G * NTHREADS) { const int pos = i >> 5, fi = i & 31;
        const double rev = (double)pos * p.inv_freq_rev[fi]; const float fr = (float)(rev - rint(rev));
        ROPE[pos * 64 + fi] = __builtin_amdgcn_cosf(fr); ROPE[pos * 64 + 32 + fi] = __builtin_amdgcn_sinf(fr); }
    if (bid == 0) { float* LB = (float*)(ws + WS_LB);
        for (int c = tid; c < 2 * HGW; c += NTHREADS) { const float* a = (c < HGW) ? p.lb_fwd : p.lb_bwd; const int cc = c & (HGW - 1); LB[c] = 1.0f / (1.0f + expf(a[HGW + cc] - a[cc])); }
        if (tid < 8) *((unsigned*)(ws + WS_CNT) + 64 * tid) = 0u; }
}

typedef short s16x4 __attribute__((ext_vector_type(4)));
DI bf16x8 frag_tr(unsigned img, int ld, int s0, int c0, int lane) {
    const int i16 = lane & 15, q = i16 >> 2, pp = i16 & 3, blk = (lane >> 4) & 1, h = lane >> 5;
    const unsigned a0 = img + (unsigned)(((s0 + 8 * h + q) * ld + c0 + 16 * blk + 4 * pp) * 2), a1 = a0 + (unsigned)(8 * ld);
    s16x4 lo, hi;
    asm volatile("ds_read_b64_tr_b16 %0, %2\n\tds_read_b64_tr_b16 %1, %3\n\ts_waitcnt lgkmcnt(0)" : "=&v"(lo), "=&v"(hi) : "v"(a0), "v"(a1) : "memory");
    return __builtin_shufflevector(lo, hi, 0, 1, 2, 3, 4, 5, 6, 7);
}
template <int LD> DI void frag_tr4(bf16x8 (&f)[4], unsigned img, int s0, int c0, int lane) {
    const int i16 = lane & 15, q = i16 >> 2, pp = i16 & 3, blk = (lane >> 4) & 1, h = lane >> 5;
    const unsigned a0 = img + (unsigned)(((s0 + 8 * h + q) * LD + c0 + 16 * blk + 4 * pp) * 2);
    s16x4 r0, r1, r2, r3, r4, r5, r6, r7;
    asm volatile("ds_read_b64_tr_b16 %0, %8\n\tds_read_b64_tr_b16 %1, %8 offset:%9\n\tds_read_b64_tr_b16 %2, %8 offset:%10\n\tds_read_b64_tr_b16 %3, %8 offset:%11\n\t"
                 "ds_read_b64_tr_b16 %4, %8 offset:%12\n\tds_read_b64_tr_b16 %5, %8 offset:%13\n\tds_read_b64_tr_b16 %6, %8 offset:%14\n\tds_read_b64_tr_b16 %7, %8 offset:%15\n\ts_waitcnt lgkmcnt(0)"
                 : "=&v"(r0), "=&v"(r1), "=&v"(r2), "=&v"(r3), "=&v"(r4), "=&v"(r5), "=&v"(r6), "=&v"(r7)
                 : "v"(a0), "i"(8 * LD), "i"(32 * LD), "i"(40 * LD), "i"(64 * LD), "i"(72 * LD), "i"(96 * LD), "i"(104 * LD) : "memory");
    f[0] = __builtin_shufflevector(r0, r1, 0, 1, 2, 3, 4, 5, 6, 7); f[1] = __builtin_shufflevector(r2, r3, 0, 1, 2, 3, 4, 5, 6, 7);
    f[2] = __builtin_shufflevector(r4, r5, 0, 1, 2, 3, 4, 5, 6, 7); f[3] = __builtin_shufflevector(r6, r7, 0, 1, 2, 3, 4, 5, 6, 7);
}
constexpr int PP_Q = 0, PP_LF = 17408, PP_LB = 34816, PP_QB = 52224, PP_TOT = 69632;
DI void hgrn_prepass(const Params& p, LAS unsigned char* lds, int tid, int G, int bid) {
    bf16* PR = (bf16*)(p.ws + WS_BIG); bf16* QEB = (bf16*)p.out + (size_t)MTOK * DM; float* VEC = (float*)(p.ws + WS_VEC);
    const int r_a = tid >> 4, c_a = tid & 15, k = tid & 127, tq = tid >> 7;
    LAS float* TOT = (LAS float*)(lds + PP_TOT);
    u32x4 q0, q1, f0, f1, b0, b1;
#define PP_LOAD(u) do { const size_t rb = (size_t)((u) >> 2) * 64; const int hc = ((u) & 3) * 128 + 8 * c_a; const bf16* ra = PR + (rb + r_a) * NIN + hc; const bf16* rc = PR + (rb + r_a + 32) * NIN + hc; \
        q0 = *(const u32x4*)(ra); f0 = *(const u32x4*)(ra + 512); b0 = *(const u32x4*)(ra + 1024); q1 = *(const u32x4*)(rc); f1 = *(const u32x4*)(rc + 512); b1 = *(const u32x4*)(rc + 1024); } while (0)
    int unit = bid;
    if (unit < NSEQ * 128 * 4) PP_LOAD(unit);
    for (; unit < NSEQ * 128 * 4; unit += G) {
        { const int o0 = (r_a * 136 + 8 * c_a) * 2, o1 = ((r_a + 32) * 136 + 8 * c_a) * 2;
          *(LAS u32x4*)(lds + PP_Q + o0) = q0; *(LAS u32x4*)(lds + PP_Q + o1) = q1; *(LAS u32x4*)(lds + PP_LF + o0) = f0; *(LAS u32x4*)(lds + PP_LF + o1) = f1; *(LAS u32x4*)(lds + PP_LB + o0) = b0; *(LAS u32x4*)(lds + PP_LB + o1) = b1; }
        if (unit + G < NSEQ * 128 * 4) PP_LOAD(unit + G);
        __syncthreads();
        float q[16], lff[16], lfb[16], blf[16], blb[16];
#pragma unroll
        for (int i = 0; i < 16; ++i) { const int o = ((16 * tq + i) * 136 + k) * 2; q[i] = bf2f(*(const LAS unsigned short*)(lds + PP_Q + o)); lff[i] = h2f(*(const LAS unsigned short*)(lds + PP_LF + o)); lfb[i] = h2f(*(const LAS unsigned short*)(lds + PP_LB + o)); }
        { float run = 0.f;
#pragma unroll
          for (int i = 0; i < 16; ++i) { run += lff[i]; blf[i] = run; }
          TOT[tq * 128 + k] = run; run = 0.f;
#pragma unroll
          for (int i = 15; i >= 0; --i) { run += lfb[i]; blb[i] = run; }
          TOT[512 + tq * 128 + k] = run; }
        __syncthreads();
        { const float t0 = TOT[k], t1 = TOT[128 + k], t2 = TOT[256 + k], t3 = TOT[384 + k], u0 = TOT[512 + k], u1 = TOT[640 + k], u2 = TOT[768 + k], u3 = TOT[896 + k];
          const float offf = (tq > 0 ? t0 : 0.f) + (tq > 1 ? t1 : 0.f) + (tq > 2 ? t2 : 0.f), offb = (tq < 3 ? u3 : 0.f) + (tq < 2 ? u2 : 0.f) + (tq < 1 ? u1 : 0.f);
          const float bmid = t0 + t1, bmidb = u2 + u3;
#pragma unroll
          for (int i = 0; i < 16; ++i) { const int o = ((16 * tq + i) * 136 + k) * 2;
              const float bbf = blf[i] + offf, bbb = blb[i] + offb;
              const float qef = q[i] * __expf(bbf - bmid), kef = (1.0f - __expf(lff[i])) * __expf(bmid - bbf), qeb = q[i] * __expf(bbb - bmidb), keb = (1.0f - __expf(lfb[i])) * __expf(bmidb - bbb);
              const unsigned w1 = pk2(qef, kef), w2 = pk2(keb, qeb);
              *(LAS unsigned short*)(lds + PP_Q + o) = (unsigned short)(w1 & 0xffffu); *(LAS unsigned short*)(lds + PP_LF + o) = (unsigned short)(w1 >> 16); *(LAS unsigned short*)(lds + PP_LB + o) = (unsigned short)(w2 & 0xffffu); *(LAS unsigned short*)(lds + PP_QB + o) = (unsigned short)(w2 >> 16); }
          if (tq == 0) { float* vf = VEC + (size_t)(unit * 2) * 384; vf[k] = __expf(bmid); vf[128 + k] = __expf((t0 + t1) + (t2 + t3)); vf[256 + k] = __expf(t2 + t3);
                         vf[384 + k] = __expf(bmidb); vf[512 + k] = __expf((u0 + u1) + (u2 + u3)); vf[640 + k] = __expf(u0 + u1); } }
        __syncthreads();
        { const size_t rb = (size_t)(unit >> 2) * 64; const int hh = unit & 3, hc = hh * 128 + 8 * c_a; const int o0 = (r_a * 136 + 8 * c_a) * 2, o1 = ((r_a + 32) * 136 + 8 * c_a) * 2;
          bf16* ra = PR + (rb + r_a) * NIN + hc; bf16* rc = PR + (rb + r_a + 32) * NIN + hc;
          *(u32x4*)(ra) = *(const LAS u32x4*)(lds + PP_Q + o0); *(u32x4*)(rc) = *(const LAS u32x4*)(lds + PP_Q + o1);
          *(u32x4*)(ra + 512) = *(const LAS u32x4*)(lds + PP_LF + o0); *(u32x4*)(rc + 512) = *(const LAS u32x4*)(lds + PP_LF + o1);
          *(u32x4*)(ra + 1024) = *(const LAS u32x4*)(lds + PP_LB + o0); *(u32x4*)(rc + 1024) = *(const LAS u32x4*)(lds + PP_LB + o1);
          *(u32x4*)(QEB + (rb + r_a) * HGW + hc) = *(const LAS u32x4*)(lds + PP_QB + o0); *(u32x4*)(QEB + (rb + r_a + 32) * HGW + hc) = *(const LAS u32x4*)(lds + PP_QB + o1); }
        __syncthreads();
    }
#undef PP_LOAD
}

constexpr int S2_QE = 0, S2_KE = 17408, S2_V = 34816, S2_VECO = 44032, S2_BUF = 45568, S2_ST = 91136, S2_P = 108544;
DI void scan_unit2(const Params& p, LAS unsigned char* lds, unsigned lds32, int unit, int tid) {
    const int lane = tid & 63, wave = tid >> 6, h = lane >> 5, lr = lane & 31;
    const int b = unit >> 4, rem = unit & 15, hh = rem >> 2, dir = (rem >> 1) & 1, vh = rem & 1;
    const bf16* PR = (const bf16*)(p.ws + WS_BIG); const bf16* QEB = (const bf16*)p.out + (size_t)MTOK * DM; const float* VEC = (const float*)(p.ws + WS_VEC);
    bf16* OUT = (bf16*)(p.ws + WS_O) + (dir ? (size_t)MTOK * HGW : 0);
    const int colo = hh * 128 + vh * 64;
    const bf16* qsrc = dir ? QEB + hh * 128 : PR + hh * 128; const size_t qstride = dir ? HGW : NIN;
    const bf16* ksrc = PR + (dir ? 1024 : 512) + hh * 128; const bf16* vsrc = PR + 1536 + hh * 128 + vh * 64;
    for (int i = tid; i < 17408 / 4; i += NTHREADS) ((LAS unsigned*)(lds + S2_ST))[i] = 0u;
    f32x16 st = zero16();
    const int r_a = tid >> 4, c_a = tid & 15, r_v = tid >> 3, c_v = tid & 7;
    const int vi2 = wave >> 2, ki = wave & 3, kc = ki * 32 + lr, ti = (wave - 4) >> 1, vi = (wave - 4) & 1;
    const int ati = dir ? (wave > 1) : (wave > 0), asi = dir ? (wave > 0) : (wave > 1);
    u32x4 pq0, pq1, pk0, pk1, pv, pvec = (u32x4){0u, 0u, 0u, 0u};
#define S2_CH(i) (dir ? (SEQ / 64 - 1 - (i)) : (i))
#define S2_ROW0(i) ((size_t)b * SEQ + (size_t)S2_CH(i) * 64)
#define S2_VEC(i) (VEC + (size_t)((((b * 128 + S2_CH(i)) * 4 + hh) * 2 + dir)) * 384)
#define S2_LOAD(i) do { const size_t rb = S2_ROW0(i); pq0 = *(const u32x4*)(qsrc + (rb + r_a) * qstride + 8 * c_a); pq1 = *(const u32x4*)(qsrc + (rb + r_a + 32) * qstride + 8 * c_a); \
        pk0 = *(const u32x4*)(ksrc + (rb + r_a) * NIN + 8 * c_a); pk1 = *(const u32x4*)(ksrc + (rb + r_a + 32) * NIN + 8 * c_a); pv = *(const u32x4*)(vsrc + (rb + r_v) * NIN + 8 * c_v); if (tid < 96) pvec = *(const u32x4*)(S2_VEC(i) + 4 * tid); } while (0)
#define S2_STASH(bf) do { LAS unsigned char* bb_ = lds + (bf) * S2_BUF; *(LAS u32x4*)(bb_ + S2_QE + (r_a * 136 + 8 * c_a) * 2) = pq0; *(LAS u32x4*)(bb_ + S2_QE + ((r_a + 32) * 136 + 8 * c_a) * 2) = pq1; \
        *(LAS u32x4*)(bb_ + S2_KE + (r_a * 136 + 8 * c_a) * 2) = pk0; *(LAS u32x4*)(bb_ + S2_KE + ((r_a + 32) * 136 + 8 * c_a) * 2) = pk1; *(LAS u32x4*)(bb_ + S2_V + (r_v * 72 + 8 * c_v) * 2) = pv; if (tid < 96) *(LAS u32x4*)(bb_ + S2_VECO + 16 * tid) = pvec; } while (0)
    S2_LOAD(0); S2_STASH(0); S2_LOAD(1);
    for (int i = 0; i < SEQ / 64; ++i) {
        const int cur = i & 1; const LAS unsigned char* bufc = lds + cur * S2_BUF; const unsigned buf32 = lds32 + (unsigned)(cur * S2_BUF);
        __syncthreads();
        if (i + 1 < SEQ / 64) S2_STASH(cur ^ 1);
        if (i + 2 < SEQ / 64) S2_LOAD(i + 2);
        f32x16 oacc = zero16();
        if (wave < 3) { f32x16 a = zero16(), a2 = zero16(); bf16x8 fa[8], fb[8];
#pragma unroll
            for (int ks = 0; ks < 8; ++ks) { fa[ks] = frag(bufc + S2_KE, 136, asi * 32, ks * 16, lane); fb[ks] = frag(bufc + S2_QE, 136, ati * 32, ks * 16, lane); }
            __builtin_amdgcn_sched_barrier(0);
#pragma unroll
            for (int ks = 0; ks < 8; ks += 2) { a = MFMA32(fa[ks], fb[ks], a); a2 = MFMA32(fa[ks + 1], fb[ks + 1], a2); }
#pragma unroll
            for (int r = 0; r < 16; ++r) a[r] += a2[r];
            const int t = ati * 32 + lr;
#pragma unroll
            for (int g = 0; g < 4; ++g) { float v[4];
#pragma unroll
                for (int j = 0; j < 4; ++j) { const int s = asi * 32 + 8 * g + 4 * h + j; const bool keep = dir ? (s >= t) : (s <= t); v[j] = keep ? a[4 * g + j] : 0.f; }
                u32x2 w; w.x = pk2(v[0], v[1]); w.y = pk2(v[2], v[3]); *(LAS u32x2*)(lds + S2_P + (t * 72 + asi * 32 + 8 * g + 4 * h) * 2) = w; }
        } else if (wave >= 4) { bf16x8 fa[8], fb[8]; f32x16 o2 = zero16();
#pragma unroll
            for (int ks = 0; ks < 8; ++ks) { fa[ks] = frag(lds + S2_ST, 136, vi * 32, ks * 16, lane); fb[ks] = frag(bufc + S2_QE, 136, ti * 32, ks * 16, lane); }
            __builtin_amdgcn_sched_barrier(0);
#pragma unroll
            for (int ks = 0; ks < 8; ks += 2) { oacc = MFMA32(fa[ks], fb[ks], oacc); o2 = MFMA32(fa[ks + 1], fb[ks + 1], o2); }
#pragma unroll
            for (int r = 0; r < 16; ++r) oacc[r] += o2[r];
        }
        __syncthreads();
        if (wave >= 4) {
            bf16x8 vf[4]; frag_tr4<72>(vf, buf32 + S2_V, 0, vi * 32, lane);
            const int ks0 = dir ? 2 * ti : 0, ks1 = dir ? 4 : 2 * (ti + 1); u32x4 pfr[4];
#pragma unroll
            for (int ks = 0; ks < 4; ++ks) { pfr[ks] = __builtin_bit_cast(u32x4, frag(lds + S2_P, 72, ti * 32, ks * 16, lane)); }
            __builtin_amdgcn_sched_barrier(0);
#pragma unroll
            for (int ks = 0; ks < 4; ++ks) { const bool on = (ks >= ks0 && ks < ks1); u32x4 pw_ = pfr[ks]; pw_.x = on ? pw_.x : 0u; pw_.y = on ? pw_.y : 0u; pw_.z = on ? pw_.z : 0u; pw_.w = on ? pw_.w : 0u;
                oacc = MFMA32(vf[ks], __builtin_bit_cast(bf16x8, pw_), oacc); }
            bf16* op = OUT + (S2_ROW0(i) + ti * 32 + lr) * HGW + colo + vi * 32 + 4 * h;
#pragma unroll
            for (int g = 0; g < 4; ++g) { u32x2 w; w.x = (unsigned)f2bf(oacc[4 * g]) | ((unsigned)f2bf(oacc[4 * g + 1]) << 16); w.y = (unsigned)f2bf(oacc[4 * g + 2]) | ((unsigned)f2bf(oacc[4 * g + 3]) << 16); *(u32x2*)(op + 8 * g) = w; }
        }
        { const float dk_c = ((const LAS float*)(bufc + S2_VECO))[128 + kc], c2_c = ((const LAS float*)(bufc + S2_VECO))[256 + kc], em_n = ((const LAS float*)(lds + (cur ^ 1) * S2_BUF + S2_VECO))[kc];
          bf16x8 kf[4], v0[4]; frag_tr4<136>(kf, buf32 + S2_KE, 0, ki * 32, lane); frag_tr4<72>(v0, buf32 + S2_V, 0, vi2 * 32, lane); f32x16 u0 = zero16();
#pragma unroll
          for (int ks = 0; ks < 4; ++ks) u0 = MFMA32(v0[ks], kf[ks], u0);
#pragma unroll
          for (int r = 0; r < 16; ++r) { st[r] = st[r] * dk_c + c2_c * u0[r]; *(LAS unsigned short*)(lds + S2_ST + ((vi2 * 32 + crow(r, h)) * 136 + kc) * 2) = f2bf(st[r] * em_n); } }
    }
    __syncthreads();
#undef S2_CH
#undef S2_ROW0
#undef S2_VEC
#undef S2_LOAD
#undef S2_STASH
}

DI void attn_prepass(const Params& p, int tid, int G, int bid) {
    bf16* PR = (bf16*)(p.ws + WS_BIG); const float* ROPE = (const float*)(p.ws + WS_ROPE);
    const int c = tid & 7; const unsigned total = (unsigned)MTOK * 10u * 8u, stride = (unsigned)G * NTHREADS;
    const f32x4 qg0 = *(const f32x4*)(p.q_norm + 8 * c), qg1 = *(const f32x4*)(p.q_norm + 8 * c + 4), kg0 = *(const f32x4*)(p.k_norm + 8 * c), kg1 = *(const f32x4*)(p.k_norm + 8 * c + 4);
    for (unsigned base = (unsigned)bid * NTHREADS; base < total; base += 4u * stride) {
        bf16* ptr[4]; u32x4 w[4]; f32x4 c0[4], c1[4], s0[4], s1[4]; int hvv[4]; bool on[4];
#pragma unroll
        for (int u = 0; u < 4; ++u) { const unsigned bu = base + (unsigned)u * stride; on[u] = bu < total; const unsigned hvi = ((on[u] ? bu : base) + (unsigned)tid) >> 3;
            const int row = (int)(hvi / 10u), hv = (int)(hvi - (unsigned)row * 10u), pos = row & (SEQ - 1); hvv[u] = hv;
            ptr[u] = PR + (size_t)row * NIN + (hv < 8 ? 2560 + hv * 64 : 3072 + (hv - 8) * 64) + 8 * c; w[u] = *(const u32x4*)ptr[u];
            const float* rt = ROPE + pos * 64 + 8 * (c & 3); c0[u] = *(const f32x4*)(rt); c1[u] = *(const f32x4*)(rt + 4); s0[u] = *(const f32x4*)(rt + 32); s1[u] = *(const f32x4*)(rt + 36); }
#pragma unroll
        for (int u = 0; u < 4; ++u) { if (!on[u]) continue;
            const int hv = hvv[u];
            float x[8] = {bflo(w[u].x), bfhi(w[u].x), bflo(w[u].y), bfhi(w[u].y), bflo(w[u].z), bfhi(w[u].z), bflo(w[u].w), bfhi(w[u].w)};
            float ss = 0.f;
#pragma unroll
            for (int j = 0; j < 8; ++j) ss += x[j] * x[j];
            ss += __shfl_xor(ss, 1); ss += __shfl_xor(ss, 2); ss += __shfl_xor(ss, 4);
            const float rs = __builtin_amdgcn_rsqf(ss * (1.0f / 64.0f) + EPSV) * (hv < 8 ? 0.125f : 1.0f);
            float y[8];
#pragma unroll
            for (int j = 0; j < 8; ++j) { const float gq = (j < 4 ? qg0[j] : qg1[j - 4]), gk = (j < 4 ? kg0[j] : kg1[j - 4]); x[j] = x[j] * rs * (hv < 8 ? gq : gk); }
#pragma unroll
            for (int j = 0; j < 8; ++j) { const float pr = __shfl_xor(x[j], 4); const float cs = (j < 4 ? c0[u][j] : c1[u][j - 4]), sn = (j < 4 ? s0[u][j] : s1[u][j - 4]); y[j] = (c < 4) ? (x[j] * cs - pr * sn) : (x[j] * cs + pr * sn); }
            u32x4 o; o.x = pk2(y[0], y[1]); o.y = pk2(y[2], y[3]); o.z = pk2(y[4], y[5]); o.w = pk2(y[6], y[7]);
            *(u32x4*)ptr[u] = o; }
    }
}
constexpr int AT_KS = 0, AT_VS = 46080, AT_PW = 92160;
struct AttnRegs { u32x4 kw[5], vw[5]; };
DI void attn_load(const Params& p, int unit, int tid, AttnRegs& r) {
    const int b = unit >> 8, g = (unit >> 7) & 1, qb = unit & 127, key0 = qb * 64 - 128;
    const bf16* PR = (const bf16*)(p.ws + WS_BIG);
#pragma unroll
    for (int it = 0; it < 5; ++it) { const int item = tid + it * NTHREADS, kk = item >> 3, c = item & 7, pos = key0 + kk; const bool valid = pos >= 0 && pos < SEQ; const int pc = valid ? pos : 0;
        const bf16* rp = PR + ((size_t)b * SEQ + pc) * NIN + g * 64 + 8 * c; r.kw[it] = *(const u32x4*)(rp + 3072); r.vw[it] = *(const u32x4*)(rp + 3200);
        if (!valid) { r.kw[it] = (u32x4){0u, 0u, 0u, 0u}; r.vw[it] = r.kw[it]; } }
}
DI void attn_stash(LAS unsigned char* lds, int tid, const AttnRegs& r) {
#pragma unroll
    for (int it = 0; it < 5; ++it) { const int item = tid + it * NTHREADS, kk = item >> 3, c = item & 7;
        *(LAS u32x4*)(lds + AT_KS + (kk * 72 + 8 * c) * 2) = r.kw[it]; *(LAS u32x4*)(lds + AT_VS + (kk * 72 + 8 * c) * 2) = r.vw[it]; }
}
DI void attn_unit(const Params& p, LAS unsigned char* lds, unsigned lds32, int unit, int tid) {
    const int lane = tid & 63, wave = tid >> 6, h = lane >> 5, lr = lane & 31;
    const int b = unit >> 8, g = (unit >> 7) & 1, qb = unit & 127, q0 = qb * 64, key0 = q0 - 128;
    const bf16* PR = (const bf16*)(p.ws + WS_BIG);
    bf16* MIX = (bf16*)p.out;
    const int hd = wave >> 1, qs = wave & 1, head = g * 4 + hd, qpos = q0 + 32 * qs + lr; const size_t qrow = (size_t)b * SEQ + qpos;
    bf16x8 qf[4];
#pragma unroll
    for (int s = 0; s < 4; ++s) qf[s] = __builtin_bit_cast(bf16x8, *(const u32x4*)(PR + qrow * NIN + 2560 + head * 64 + 8 * h + 16 * s));
    float m = p.sink[head], l = 1.0f; f32x16 o0 = zero16(), o1 = zero16();
    const LAS unsigned char* pw = lds + AT_PW + wave * 4608;
    for (int c = 0; c < 5; ++c) { const int kb = 64 * c, kp0 = key0 + kb;
        if (kp0 + 63 < 0 || kp0 >= SEQ) continue;
        f32x16 s0 = zero16(), s1 = zero16(); bf16x8 ka_[4], kb_[4];
#pragma unroll
        for (int s = 0; s < 4; ++s) { ka_[s] = frag(lds + AT_KS, 72, kb, 16 * s, lane); kb_[s] = frag(lds + AT_KS, 72, kb + 32, 16 * s, lane); }
        __builtin_amdgcn_sched_barrier(0);
#pragma unroll
        for (int s = 0; s < 4; ++s) { s0 = MFMA32(ka_[s], qf[s], s0); s1 = MFMA32(kb_[s], qf[s], s1); }
        float cmax = -INFINITY;
        if (c == 0 || c == 4 || kp0 < 0 || kp0 + 63 >= SEQ) {
#pragma unroll
            for (int i = 0; i < 16; ++i) { const int ka = kp0 + crow(i, h), kc = ka + 32;
                const bool va = ka >= 0 && ka < SEQ && ka >= qpos - 128 && ka <= qpos + 128, vc = kc >= 0 && kc < SEQ && kc >= qpos - 128 && kc <= qpos + 128;
                s0[i] = va ? s0[i] : -INFINITY; s1[i] = vc ? s1[i] : -INFINITY; }
        }
#pragma unroll
        for (int i = 0; i < 16; ++i) cmax = fmaxf(cmax, fmaxf(s0[i], s1[i]));
        cmax = fmaxf(cmax, __shfl_xor(cmax, 32));
        const float mn = fmaxf(m, cmax), alpha = __expf(m - mn); m = mn;
        float ps = 0.f;
#pragma unroll
        for (int i = 0; i < 16; ++i) { s0[i] = __expf(s0[i] - mn); s1[i] = __expf(s1[i] - mn); ps += s0[i] + s1[i]; }
        ps += __shfl_xor(ps, 32); l = l * alpha + ps;
#pragma unroll
        for (int i = 0; i < 16; ++i) { o0[i] *= alpha; o1[i] *= alpha; }
#pragma unroll
        for (int gq = 0; gq < 4; ++gq) { u32x2 w; w.x = pk2(s0[4 * gq], s0[4 * gq + 1]); w.y = pk2(s0[4 * gq + 2], s0[4 * gq + 3]); *(LAS u32x2*)(pw + (lr * 72 + 8 * gq + 4 * h) * 2) = w;
            w.x = pk2(s1[4 * gq], s1[4 * gq + 1]); w.y = pk2(s1[4 * gq + 2], s1[4 * gq + 3]); *(LAS u32x2*)(pw + (lr * 72 + 32 + 8 * gq + 4 * h) * 2) = w; }
        LDS_WAIT();
        bf16x8 pf[4], va_[4], vb_[4];
#pragma unroll
        for (int ks = 0; ks < 4; ++ks) pf[ks] = frag(pw, 72, 0, 16 * ks, lane);
        frag_tr4<72>(va_, lds32 + AT_VS, kb, 0, lane); frag_tr4<72>(vb_, lds32 + AT_VS, kb, 32, lane);
#pragma unroll
        for (int ks = 0; ks < 4; ++ks) { o0 = MFMA32(va_[ks], pf[ks], o0); o1 = MFMA32(vb_[ks], pf[ks], o1); }
        LDS_WAIT();
    }
    { const float inv = 1.0f / l; bf16* op = MIX + qrow * DM + 512 + head * 64;
#pragma unroll
      for (int gq = 0; gq < 4; ++gq) { u32x2 w; w.x = pk2(o0[4 * gq] * inv, o0[4 * gq + 1] * inv); w.y = pk2(o0[4 * gq + 2] * inv, o0[4 * gq + 3] * inv); *(u32x2*)(op + 8 * gq + 4 * h) = w;
          w.x = pk2(o1[4 * gq] * inv, o1[4 * gq + 1] * inv); w.y = pk2(o1[4 * gq + 2] * inv, o1[4 * gq + 3] * inv); *(u32x2*)(op + 32 + 8 * gq + 4 * h) = w; } }
}

DI void combine_phase(const Params& p, int tid, int G, int bid) {
    const int lane = tid & 63, wave = tid >> 6, gw = bid * NWAVES + wave, NGW = G * NWAVES;
    const bf16* OF = (const bf16*)(p.ws + WS_O); const bf16* OB = OF + (size_t)MTOK * HGW; const bf16* PR = (const bf16*)(p.ws + WS_BIG); bf16* MIX = (bf16*)p.out;
    const int c0 = 8 * lane; const f32x4 n0 = *(const f32x4*)(p.out_norm + (c0 & 127)), n1 = *(const f32x4*)(p.out_norm + (c0 & 127) + 4);
    const int RPW = (MTOK + NGW - 1) / NGW;
    for (int row0_ = gw * RPW; row0_ < min((gw + 1) * RPW, MTOK); row0_ += 4) {
        u32x4 av[4], bv[4], gv4[4]; bool on[4];
#pragma unroll
        for (int u = 0; u < 4; ++u) { const int row = row0_ + u; on[u] = row < min((gw + 1) * RPW, MTOK); const size_t rr = on[u] ? row : row0_;
            av[u] = *(const u32x4*)(OF + rr * HGW + c0); bv[u] = *(const u32x4*)(OB + rr * HGW + c0); gv4[u] = *(const u32x4*)(PR + rr * NIN + 2048 + c0); }
#pragma unroll
        for (int u = 0; u < 4; ++u) { if (!on[u]) continue; const int row = row0_ + u; const u32x4 a = av[u], bq = bv[u], gg = gv4[u];
            float o[8] = {bflo(a.x) + bflo(bq.x), bfhi(a.x) + bfhi(bq.x), bflo(a.y) + bflo(bq.y), bfhi(a.y) + bfhi(bq.y), bflo(a.z) + bflo(bq.z), bfhi(a.z) + bfhi(bq.z), bflo(a.w) + bflo(bq.w), bfhi(a.w) + bfhi(bq.w)};
            const float gv[8] = {bflo(gg.x), bfhi(gg.x), bflo(gg.y), bfhi(gg.y), bflo(gg.z), bfhi(gg.z), bflo(gg.w), bfhi(gg.w)};
            float ss = 0.f;
#pragma unroll
            for (int j = 0; j < 8; ++j) ss += o[j] * o[j];
            ss += __shfl_xor(ss, 1); ss += __shfl_xor(ss, 2); ss += __shfl_xor(ss, 4); ss += __shfl_xor(ss, 8);
            const float rs = __builtin_amdgcn_rsqf(ss * (1.0f / 128.0f) + EPSV);
#pragma unroll
            for (int j = 0; j < 8; ++j) o[j] = o[j] * rs * (j < 4 ? n0[j] : n1[j - 4]) * gv[j];
            u32x4 w; w.x = pk2(o[0], o[1]); w.y = pk2(o[2], o[3]); w.z = pk2(o[4], o[5]); w.w = pk2(o[6], o[7]);
            *(u32x4*)(MIX + (size_t)row * DM + c0) = w; }
    }
}

#define XB_TMO      128
#define XB_XCNT(j)  (256  + 64 * (j))
#define XB_XSUB(j)  (1280 + 64 * (j))
#define XB_XGEN(j)  (2304 + 64 * (j))
#define XB_TOP      3328
#define XB_TOPGEN   3392
#define XCD_BAR_WORDS 3456
#define XB_SPIN_CAP (1u << 22)

__device__ __forceinline__ unsigned xb_ld(unsigned* p)              { return __hip_atomic_load(p, __ATOMIC_RELAXED, __HIP_MEMORY_SCOPE_AGENT); }
__device__ __forceinline__ unsigned xb_add(unsigned* p, unsigned v) { return __hip_atomic_fetch_add(p, v, __ATOMIC_RELAXED, __HIP_MEMORY_SCOPE_AGENT); }
__device__ __forceinline__ unsigned xb_xcc_id() { return (unsigned)__builtin_amdgcn_s_getreg((3 << 11) | 20) & 0xFu; }
#define XB_SPIN(cond, bar) do { unsigned _sp = 0; while (cond) { __builtin_amdgcn_s_sleep(1); \
    if ((++_sp & 255u) == 0u) { if (xb_ld(&(bar)[XB_TMO])) break; if (_sp > XB_SPIN_CAP) { atomicAdd(&(bar)[XB_TMO], 1u); break; } } } } while (0)

struct XcdBarrier {
    unsigned* bar; unsigned x;
    volatile LAS unsigned* st;
};

__device__ __forceinline__ XcdBarrier xcd_barrier_post(unsigned* bar, volatile LAS unsigned* st) {
    XcdBarrier b; b.bar = bar; b.x = xb_xcc_id(); b.st = st;
    if (threadIdx.x == 0) (void)xb_add(&bar[XB_XCNT(b.x)], 1u);
    return b;
}
__device__ __forceinline__ void xcd_barrier_complete(unsigned* bar, unsigned x, unsigned& nloc, unsigned& nx) {
    const unsigned G = gridDim.x * gridDim.y * gridDim.z;
    unsigned sum, cnt, mine, sp = 0u;
    for (;;) {
        sum = 0u; cnt = 0u; mine = 0u;
#pragma unroll
        for (unsigned j = 0; j < 16; ++j) { const unsigned c = xb_ld(&bar[XB_XCNT(j)]); sum += c; cnt += (c > 0u) ? 1u : 0u; mine = (j == x) ? c : mine; }
        if (sum == G) break;
        __builtin_amdgcn_s_sleep(1);
        if ((++sp & 255u) == 0u) { if (xb_ld(&bar[XB_TMO])) break; if (sp > XB_SPIN_CAP) { atomicAdd(&bar[XB_TMO], 1u); break; } }
    }
    nloc = mine > 0u ? mine : 1u; nx = cnt > 0u ? cnt : 1u;
}

__device__ __forceinline__ void xcd_barrier(const XcdBarrier& b) {
    asm volatile("s_waitcnt vmcnt(0)" ::: "memory");
    __syncthreads();
    if (threadIdx.x == 0) {
        unsigned* bar = b.bar;
        __builtin_amdgcn_s_waitcnt(0);
        unsigned nloc = b.st[0], nx = b.st[1];
        if (nloc == 0u) { xcd_barrier_complete(bar, b.x, nloc, nx); b.st[0] = nloc; b.st[1] = nx; }
        const unsigned old = xb_add(&bar[XB_XSUB(b.x)], 1u);
        const unsigned gen = old / nloc;
        if (old + 1u == (gen + 1u) * nloc) {
            __builtin_amdgcn_fence(__ATOMIC_RELEASE, "agent");
            asm volatile("s_waitcnt vmcnt(0)" ::: "memory");
            const unsigned og = xb_add(&bar[XB_TOP], 1u);
            const unsigned tg = og / nx;
            if (og + 1u == (tg + 1u) * nx) xb_add(&bar[XB_TOPGEN], 1u);
            else XB_SPIN(xb_ld(&bar[XB_TOPGEN]) == tg, bar);
            __builtin_amdgcn_fence(__ATOMIC_ACQUIRE, "agent");
            xb_add(&bar[XB_XGEN(b.x)], 1u);
            asm volatile("s_waitcnt vmcnt(0)" ::: "memory");
        } else {
            XB_SPIN(xb_ld(&bar[XB_XGEN(b.x)]) == gen, bar);
            __builtin_amdgcn_fence(__ATOMIC_ACQUIRE, "agent");
            asm volatile("s_waitcnt vmcnt(0)" ::: "memory");
        }
    }
    __syncthreads();
}


DI unsigned attn_dequeue(unsigned* heads, unsigned xcc) {
    constexpr unsigned PER = (unsigned)NATT_UNITS / 8u;
    for (unsigned t = 0; t < 8u; ++t) { const unsigned x = (xcc + t) & 7u; const unsigned u = atomicAdd(heads + 64 * x, 1u); if (u < PER) return x * PER + u; }
    return (unsigned)NATT_UNITS;
}
__global__ void __launch_bounds__(NTHREADS, 2) hymba_fwd(Params p) {
    extern __shared__ __attribute__((aligned(16))) unsigned char lds_raw[];
    LAS unsigned char* lds = (LAS unsigned char*)lds_raw;
    const int tid = threadIdx.x, G = gridDim.x, bid = blockIdx.x;
    unsigned char* ws = p.ws;
    const int lo = p.ph_lo, hi = p.ph_hi;
#ifndef PH_MASK
#define PH_MASK 0x1ff
#endif
#define IN(k) (lo <= (k) && (k) < hi)
#define SEAM(k) do { if (IN(k) && IN((k) + 1)) { if ((k) == 0) cg::this_grid().sync(); else xcd_barrier(xbar); } } while (0)
    volatile LAS unsigned* xst = (volatile LAS unsigned*)(lds + WQ_OFF + 16);
    if (tid == 0) { xst[0] = 0u; xst[1] = 0u; }
    __syncthreads();
    XcdBarrier xbar = xcd_barrier_post((unsigned*)(p.ws + WS_BARW), xst);
    bf16* XB = (bf16*)(ws + WS_XB); bf16* BIG = (bf16*)(ws + WS_BIG); bf16* X2B = (bf16*)(ws + WS_O);
    float* RSTD = (float*)(ws + WS_RSTD); float* SSQ = (float*)(ws + WS_SSQ); const float* LB = (const float*)(ws + WS_LB);
    if (((PH_MASK >> 0) & 1) && IN(0)) { p0_prologue(p, lds, tid, G, bid); }
    SEAM(0);
    if (((PH_MASK >> 1) & 1) && IN(1)) {
        pg8::Gemm g{XB, (const bf16*)(ws + WS_WI1), MTOK, 2 * DFF, DM}; pg8::StaticOrder S; S.init(MTOK, 2 * DFF, G, bid);
        pg8::EpiSwiglu<true> E{BIG, nullptr};
        pg8::gemm_phase<pg8::EpiSwiglu<true>, pg8::StaticOrder, true, true>(lds, g, S, E); }
    SEAM(1);
    if (((PH_MASK >> 2) & 1) && IN(2)) {
        pg8::Gemm g{BIG, (const bf16*)(ws + WS_WO1), MTOK, DM, DFF}; pg8::StaticOrder S; S.init(MTOK, DM, G, bid);
        pg8::EpiRes<0, false, true, true> E{nullptr, p.xp, p.xs, nullptr, XB, SSQ};
        pg8::gemm_phase<pg8::EpiRes<0, false, true, true>, pg8::StaticOrder, true, true>(lds, g, S, E); }
    SEAM(2);
    if (((PH_MASK >> 3) & 1) && IN(3)) {
        for (int row = bid * NTHREADS + tid; row < MTOK; row += G * NTHREADS) { const f32x4* sp = (const f32x4*)(SSQ + (size_t)row * 16); const f32x4 a = sp[0], b = sp[1], c = sp[2], d = sp[3];
            const float tot = ((a[0] + a[1]) + (a[2] + a[3])) + ((b[0] + b[1]) + (b[2] + b[3])) + ((c[0] + c[1]) + (c[2] + c[3])) + ((d[0] + d[1]) + (d[2] + d[3]));
            RSTD[row] = 1.0f / sqrtf(tot * (1.0f / DM) + EPSV); }
        xcd_barrier(xbar);
        pg8::Gemm g{XB, (const bf16*)(ws + WS_WIN), MTOK, NIN, DM}; pg8::StaticOrder S; S.init(MTOK, NIN, G, bid);
        pg8::EpiProj E{BIG, RSTD, LB, LB + HGW, p.q_norm, p.k_norm, (const float*)(ws + WS_ROPE)};
        pg8::gemm_phase<pg8::EpiProj, pg8::StaticOrder, true, true>(lds, g, S, E); }
    SEAM(3);
    if (((PH_MASK >> 4) & 1) && IN(4)) {
        hgrn_prepass(p, lds, tid, G, bid);
        xcd_barrier(xbar);
        const unsigned lds32 = (unsigned)(size_t)lds_raw;
        if (G == 256) { if (bid < NSCAN_UNITS) scan_unit2(p, lds, lds32, (bid & 7) * (NSCAN_UNITS / 8) + (bid >> 3), tid); }
        else for (int u = bid; u < NSCAN_UNITS; u += G) scan_unit2(p, lds, lds32, u, tid);
        unsigned* cnt = (unsigned*)(ws + WS_CNT); LAS unsigned* wq = (LAS unsigned*)(lds + WQ_OFF);
        const unsigned myx = xb_xcc_id() & 7u;
        __syncthreads(); if (tid == 0) *wq = attn_dequeue(cnt, myx); __syncthreads();
        unsigned u = *wq; AttnRegs ar; if (u < (unsigned)NATT_UNITS) attn_load(p, (int)u, tid, ar);
        while (u < (unsigned)NATT_UNITS) {
            __syncthreads();
            attn_stash(lds, tid, ar);
            if (tid == 0) *wq = attn_dequeue(cnt, myx);
            __syncthreads();
            const unsigned un = *wq; if (un < (unsigned)NATT_UNITS) attn_load(p, (int)un, tid, ar);
            attn_unit(p, lds, lds32, (int)u, tid);
            u = un; } }
    SEAM(4);
    if (((PH_MASK >> 5) & 1) && IN(5)) { combine_phase(p, tid, G, bid); }
    SEAM(5);
    if (((PH_MASK >> 6) & 1) && IN(6)) {
        pg8::Gemm g{(const bf16*)p.out, (const bf16*)(ws + WS_WOUT), MTOK, DM, DM}; pg8::StaticOrder S; S.init(MTOK, DM, G, bid);
        pg8::EpiRes<1, false, true, false> E{nullptr, nullptr, nullptr, XB, X2B, SSQ};
        pg8::gemm_phase<pg8::EpiRes<1, false, true, false>, pg8::StaticOrder, true, true>(lds, g, S, E); }
    SEAM(6);
    if (((PH_MASK >> 7) & 1) && IN(7)) {
        for (int row = bid * NTHREADS + tid; row < MTOK; row += G * NTHREADS) { const f32x4* sp = (const f32x4*)(SSQ + (size_t)row * 16); const f32x4 a = sp[0], b = sp[1], c = sp[2], d = sp[3];
            const float tot = ((a[0] + a[1]) + (a[2] + a[3])) + ((b[0] + b[1]) + (b[2] + b[3])) + ((c[0] + c[1]) + (c[2] + c[3])) + ((d[0] + d[1]) + (d[2] + d[3]));
            RSTD[row] = 1.0f / sqrtf(tot * (1.0f / DM) + EPSV); }
        xcd_barrier(xbar);
        pg8::Gemm g{X2B, (const bf16*)(ws + WS_WI2), MTOK, 2 * DFF, DM}; pg8::StaticOrder S; S.init(MTOK, 2 * DFF, G, bid);
        pg8::EpiSwiglu<false> E{BIG, RSTD};
        pg8::gemm_phase<pg8::EpiSwiglu<false>, pg8::StaticOrder, true, true>(lds, g, S, E); }
    SEAM(7);
    if (((PH_MASK >> 8) & 1) && IN(8)) {
        pg8::Gemm g{BIG, (const bf16*)(ws + WS_WO2), MTOK, DM, DFF}; pg8::StaticOrder S; S.init(MTOK, DM, G, bid);
        pg8::EpiRes<1, true, false, true> E{p.out, nullptr, nullptr, X2B, nullptr, nullptr};
        pg8::gemm_phase<pg8::EpiRes<1, true, false, true>, pg8::StaticOrder, true, true>(lds, g, S, E); }
#undef IN
#undef SEAM
}

#ifndef MK_MULTI
#define MK_MULTI 0
#endif
constexpr int NPHASES = 9;
extern "C" void kernel_launch(void* const* d_in, const int* in_sizes, int n_in, void* d_out, int out_size, void* d_ws, size_t ws_size, hipStream_t stream) {
    static int grid = 0;
    if (grid == 0) {
        int dev = 0, cus = 0;
        if (hipGetDevice(&dev) != hipSuccess || hipDeviceGetAttribute(&cus, hipDeviceAttributeMultiprocessorCount, dev) != hipSuccess) { fprintf(stderr, "kernel_launch: device query failed\n"); grid = -1; return; }
        if (hipFuncSetAttribute((const void*)hymba_fwd, hipFuncAttributeMaxDynamicSharedMemorySize, LDS_BYTES) != hipSuccess) { fprintf(stderr, "kernel_launch: hipFuncSetAttribute failed\n"); grid = -1; return; }
        int per_cu = 0;
        if (hipOccupancyMaxActiveBlocksPerMultiprocessor(&per_cu, (const void*)hymba_fwd, NTHREADS, LDS_BYTES) != hipSuccess || per_cu < 1) { fprintf(stderr, "kernel_launch: occupancy query says %d blocks per CU\n", per_cu); }
        (void)hipGetLastError();
        grid = cus;
        if (n_in != 17 || ws_size < WS_END) { fprintf(stderr, "kernel_launch: unexpected n_in %d or ws_size %zu (< %zu)\n", n_in, ws_size, (size_t)WS_END); }
    }
    if (grid < 0) return;
    Params p{};
    p.xp = (const float*)d_in[0]; p.xs = (const float*)d_in[1]; p.ffn1_norm = (const float*)d_in[2]; p.ffn1_wi = (const float*)d_in[3]; p.ffn1_wo = (const float*)d_in[4];
    p.mix_norm = (const float*)d_in[5]; p.w_in = (const float*)d_in[6]; p.lb_fwd = (const float*)d_in[7]; p.lb_bwd = (const float*)d_in[8]; p.out_norm = (const float*)d_in[9];
    p.q_norm = (const float*)d_in[10]; p.k_norm = (const float*)d_in[11]; p.sink = (const float*)d_in[12]; p.w_out = (const float*)d_in[13]; p.ffn2_norm = (const float*)d_in[14];
    p.ffn2_wi = (const float*)d_in[15]; p.ffn2_wo = (const float*)d_in[16];
    p.out = (float*)d_out; p.ws = (unsigned char*)d_ws;
    for (int i = 0; i < 32; ++i) p.inv_freq_rev[i] = pow(10000.0, -(double)(2 * i) / 64.0) / 6.283185307179586476925286766559;
#if MK_MULTI
    for (int ph = 0; ph < NPHASES; ++ph) { p.ph_lo = ph; p.ph_hi = ph + 1; p.coop = 0;
        hipLaunchKernelGGL(hymba_fwd, dim3(grid), dim3(NTHREADS), LDS_BYTES, stream, p);
        const hipError_t le = hipPeekAtLastError(); if (le != hipSuccess) { fprintf(stderr, "kernel_launch: launch %d failed: %s\n", ph, hipGetErrorName(le)); break; } }
#else
    if (hipMemsetAsync((unsigned char*)d_ws + WS_BARW, 0, 16384, stream) != hipSuccess) { fprintf(stderr, "kernel_launch: hipMemsetAsync failed\n"); return; }
    p.ph_lo = 0; p.ph_hi = NPHASES; p.coop = 1;
    void* args[] = {&p};
    const hipError_t le = hipLaunchCooperativeKernel((const void*)hymba_fwd, dim3(grid), dim3(NTHREADS), args, LDS_BYTES, stream);
    if (le != hipSuccess) fprintf(stderr, "kernel_launch: cooperative launch failed: %s (grid %d)\n", hipGetErrorName(le), grid);
#endif
}
```

```cpp
#include <hip/hip_runtime.h>
#include <hip/hip_cooperative_groups.h>
#include <cstdio>
#include <cmath>
namespace cg = cooperative_groups;
constexpr int DM = 1024, SEQ = 8192, NSEQ = 10, MTOK = NSEQ * SEQ, NPROMPT = 2 * SEQ, DFF = 2816, NIN = 3328;
constexpr float EPSV = 1e-6f;
#include <hip/hip_runtime.h>
#include <cstdio>
#include <cstdint>
namespace pg8 {
#define PG8_LAS __attribute__((address_space(3)))
typedef unsigned short bf16_t;
typedef short bf16x8 __attribute__((ext_vector_type(8)));
typedef float f32x4 __attribute__((ext_vector_type(4)));
typedef unsigned u32x4 __attribute__((ext_vector_type(4)));
constexpr int BM = 256, BK = 64, HALF = 128, HTB = HALF * BK * 2  , STAGE_BYTES = 8 * HTB, NXCD = 8, WGM = 8;

__host__ __device__ __forceinline__ int lds_byte(int r, int c) { const int st = (r >> 4) * 2 + (c >> 5), rr = r & 15, cc = c & 31, ob = rr * 64 + cc * 2; return st * 1024 + (ob ^ (((ob >> 9) & 1) << 5)); }
__host__ __device__ __forceinline__ void stage_rc(int b, int& R, int& C) { const int st = b / 1024, sb = b % 1024, swz = sb ^ (((sb >> 9) & 1) << 5); R = (st >> 1) * 16 + swz / 64; C = (st & 1) * 32 + (swz % 64) / 2; }
__host__ __device__ __forceinline__ int perm32(int rho) { const int n = rho >> 4, i = rho & 15; return 8 * (i >> 2) + 4 * n + (i & 3); }

struct Unit { int pm, pn; };
struct Gemm { const bf16_t* A; const bf16_t* Bt; int M, N, K; };

struct StaticOrder {
    int nM, nN, nwg, G, c;
    __host__ __device__ void init(int M, int N, int G_, int c_) { nM = M / BM; nN = N / BM; nwg = nM * nN; G = G_; c = c_; }
    __host__ __device__ bool next(int i, Unit& u) const {
        const long L = (long)i * G + c; if (L >= nwg) return false;
        int wgid = (int)L; { const int q = nwg / NXCD, r = nwg % NXCD, xcd = wgid % NXCD, off = wgid / NXCD; wgid = (xcd < r ? xcd * (q + 1) : r * (q + 1) + (xcd - r) * q) + off; }
        const int nig = WGM * nN, gid = wgid / nig, fm = gid * WGM, gsz = (nM - fm) < WGM ? (nM - fm) : WGM;
        u.pm = fm + ((wgid % nig) % gsz); u.pn = (wgid % nig) / gsz; return true;
    }
    __device__ __forceinline__ void a_ready(const Unit&) const {}
    __device__ __forceinline__ void done(const Unit&) const {}
};

__device__ __forceinline__ unsigned cvt_pk_bf16(float lo, float hi) { unsigned r; asm volatile("v_cvt_pk_bf16_f32 %0, %1, %2" : "=v"(r) : "v"(lo), "v"(hi)); return r; }
__device__ __forceinline__ float sigmoidf_(float v) { return __builtin_amdgcn_rcpf(1.0f + __expf(-v)); }
__device__ __forceinline__ float siluf_(float v) { return v * sigmoidf_(v); }

template <bool NORMED> struct EpiSwiglu {
    static constexpr bool PERM = true, AFTER_DRAIN = false;
    bf16_t* H; const float* rstd;
    __device__ __forceinline__ void operator()(const f32x4 (&acc)[2][2][4][2], const Unit& u, int wr, int wc, int fr, int fq) const {
        const int row0 = u.pm * BM + wr * 64 + fr, col0 = u.pn * 128 + wc * 32 + 8 * fq;
        float rsv[2][4];
#pragma unroll
        for (int ai = 0; ai < 2; ++ai)
#pragma unroll
            for (int m = 0; m < 4; ++m) rsv[ai][m] = NORMED ? 1.0f : rstd[row0 + ai * HALF + m * 16];
#pragma unroll
        for (int ai = 0; ai < 2; ++ai)
#pragma unroll
            for (int m = 0; m < 4; ++m) { const int row = row0 + ai * HALF + m * 16; const float rs = rsv[ai][m];
                float hv[8];
#pragma unroll
                for (int n = 0; n < 2; ++n)
#pragma unroll
                    for (int j = 0; j < 4; ++j) { const float g = acc[ai][0][m][n][j] * rs, uu = acc[ai][1][m][n][j] * rs; hv[4 * n + j] = siluf_(g) * uu; }
                u32x4 w; w.x = cvt_pk_bf16(hv[0], hv[1]); w.y = cvt_pk_bf16(hv[2], hv[3]); w.z = cvt_pk_bf16(hv[4], hv[5]); w.w = cvt_pk_bf16(hv[6], hv[7]);
                *(u32x4*)(H + (size_t)row * DFF + col0) = w; }
    }
};
template <int RESMODE, bool OUT_F32, bool AUX, bool HALFSCALE> struct EpiRes {
    static constexpr bool PERM = true, AFTER_DRAIN = false;
    float* out; const float* xp; const float* xs; const bf16_t* resb; bf16_t* xb; float* ssq;
    __device__ __forceinline__ void operator()(const f32x4 (&acc)[2][2][4][2], const Unit& u, int wr, int wc, int fr, int fq) const {
        const int row0 = u.pm * BM + wr * 64 + fr, col0 = u.pn * BM + wc * 32 + 8 * fq;
#pragma unroll
        for (int ai = 0; ai < 2; ++ai)
#pragma unroll
            for (int m = 0; m < 4; ++m) { const int row = row0 + ai * HALF + m * 16;
                const float* resrow = (row < NPROMPT ? xp + (size_t)row * DM : xs + (size_t)(row - NPROMPT) * DM);
                float ss = 0.f;
#pragma unroll
                for (int bj = 0; bj < 2; ++bj) { const int col = col0 + bj * HALF; f32x4 r0, r1;
                    if (RESMODE == 0) { r0 = *(const f32x4*)(resrow + col); r1 = *(const f32x4*)(resrow + col + 4); }
                    else { const u32x4 w = *(const u32x4*)(resb + (size_t)row * DM + col);
                        r0 = (f32x4){__builtin_bit_cast(float, w.x << 16), __builtin_bit_cast(float, w.x & 0xffff0000u), __builtin_bit_cast(float, w.y << 16), __builtin_bit_cast(float, w.y & 0xffff0000u)};
                        r1 = (f32x4){__builtin_bit_cast(float, w.z << 16), __builtin_bit_cast(float, w.z & 0xffff0000u), __builtin_bit_cast(float, w.w << 16), __builtin_bit_cast(float, w.w & 0xffff0000u)}; }
                    const f32x4 o0 = r0 + acc[ai][bj][m][0] * (HALFSCALE ? 0.5f : 1.0f), o1 = r1 + acc[ai][bj][m][1] * (HALFSCALE ? 0.5f : 1.0f);
                    if (OUT_F32) { *(f32x4*)(out + (size_t)row * DM + col) = o0; *(f32x4*)(out + (size_t)row * DM + col + 4) = o1; }
                    else { u32x4 w; w.x = cvt_pk_bf16(o0[0], o0[1]); w.y = cvt_pk_bf16(o0[2], o0[3]); w.z = cvt_pk_bf16(o1[0], o1[1]); w.w = cvt_pk_bf16(o1[2], o1[3]); *(u32x4*)(xb + (size_t)row * DM + col) = w; }
                    if (AUX) ss += ((o0[0] * o0[0] + o0[1] * o0[1]) + (o0[2] * o0[2] + o0[3] * o0[3])) + ((o1[0] * o1[0] + o1[1] * o1[1]) + (o1[2] * o1[2] + o1[3] * o1[3])); }
                if (AUX) { ss += __shfl_xor(ss, 16); ss += __shfl_xor(ss, 32); if (fq == 0) ssq[(size_t)row * 16 + u.pn * 4 + wc] = ss; } }
    }
};
struct EpiProj {
    static constexpr bool PERM = true, AFTER_DRAIN = false;
    bf16_t* P; const float* ssq; const float* lbf; const float* lbb; const float* qn; const float* kn; const float* rope;
    __device__ __forceinline__ void operator()(const f32x4 (&acc)[2][2][4][2], const Unit& u, int wr, int wc, int fr, int fq) const {
        const int row0 = u.pm * BM + wr * 64 + fr, colw = wc * 32 + 8 * fq; const int pn = u.pn;
        float rsv[2][4];
#pragma unroll
        for (int ai = 0; ai < 2; ++ai)
#pragma unroll
            for (int m = 0; m < 4; ++m) rsv[ai][m] = ssq[row0 + ai * HALF + m * 16];
        if (pn >= 10) {
            const bool isv = (pn == 12 && wc >= 2), isq = pn < 12;
            const int cbase = isq ? 2560 + ((pn - 10) * 4 + wc) * 64 : (wc < 2 ? 3072 + wc * 64 : 3200 + (wc - 2) * 64);
            const float* gn = isq ? qn : kn; float glo[8], ghi[8];
#pragma unroll
            for (int j = 0; j < 8; ++j) { glo[j] = gn[8 * fq + j]; ghi[j] = gn[32 + 8 * fq + j]; }
#pragma unroll
            for (int ai = 0; ai < 2; ++ai)
#pragma unroll
                for (int m = 0; m < 4; ++m) { const int row = row0 + ai * HALF + m * 16;
                    const float rs = rsv[ai][m];
                    float lo[8], hi[8];
#pragma unroll
                    for (int n = 0; n < 2; ++n)
#pragma unroll
                        for (int j = 0; j < 4; ++j) { lo[4 * n + j] = acc[ai][0][m][n][j] * rs; hi[4 * n + j] = acc[ai][1][m][n][j] * rs; }
                    if (!isv) {
                        float ss = 0.f;
#pragma unroll
                        for (int j = 0; j < 8; ++j) ss += lo[j] * lo[j] + hi[j] * hi[j];
                        ss += __shfl_xor(ss, 16); ss += __shfl_xor(ss, 32);
                        const float rn = __builtin_amdgcn_rsqf(ss * (1.0f / 64.0f) + EPSV) * (isq ? 0.125f : 1.0f);
                        const float* rt = rope + (size_t)(row & (SEQ - 1)) * 64 + 8 * fq;
                        const f32x4 c0 = *(const f32x4*)(rt), c1 = *(const f32x4*)(rt + 4), n0 = *(const f32x4*)(rt + 32), n1 = *(const f32x4*)(rt + 36);
#pragma unroll
                        for (int j = 0; j < 8; ++j) { const float a = lo[j] * rn * glo[j], bb = hi[j] * rn * ghi[j], cs = (j < 4 ? c0[j] : c1[j - 4]), sn = (j < 4 ? n0[j] : n1[j - 4]); lo[j] = a * cs - bb * sn; hi[j] = bb * cs + a * sn; }
                    }
                    u32x4 w0, w1; w0.x = cvt_pk_bf16(lo[0], lo[1]); w0.y = cvt_pk_bf16(lo[2], lo[3]); w0.z = cvt_pk_bf16(lo[4], lo[5]); w0.w = cvt_pk_bf16(lo[6], lo[7]);
                    w1.x = cvt_pk_bf16(hi[0], hi[1]); w1.y = cvt_pk_bf16(hi[2], hi[3]); w1.z = cvt_pk_bf16(hi[4], hi[5]); w1.w = cvt_pk_bf16(hi[6], hi[7]);
                    *(u32x4*)(P + (size_t)row * NIN + cbase + 8 * fq) = w0; *(u32x4*)(P + (size_t)row * NIN + cbase + 32 + 8 * fq) = w1; }
            return;
        }
        const int kind = (pn < 2 || pn == 8 || pn == 9) ? 1 : ((pn >= 2 && pn < 6) ? 2 : 0);
        float lbv[2][8];
        if (kind == 2) { const float* lb = (pn < 4) ? lbf + (pn - 2) * 256 : lbb + (pn - 4) * 256;
#pragma unroll
            for (int bj = 0; bj < 2; ++bj)
#pragma unroll
                for (int j = 0; j < 8; ++j) lbv[bj][j] = lb[bj * HALF + colw + j]; }
#pragma unroll
        for (int ai = 0; ai < 2; ++ai)
#pragma unroll
            for (int m = 0; m < 4; ++m) { const int row = row0 + ai * HALF + m * 16;
                const float rs = rsv[ai][m];
#pragma unroll
                for (int bj = 0; bj < 2; ++bj) { float v[8];
#pragma unroll
                    for (int n = 0; n < 2; ++n)
#pragma unroll
                        for (int j = 0; j < 4; ++j) v[4 * n + j] = acc[ai][bj][m][n][j] * rs;
                    u32x4 w;
                    if (kind == 2) {
#pragma unroll
                        for (int j = 0; j < 8; ++j) { const float lb = lbv[bj][j]; v[j] = __logf(lb + (1.0f - lb) * sigmoidf_(v[j])); }
                        w.x = __builtin_bit_cast(unsigned, __builtin_amdgcn_cvt_pkrtz(v[0], v[1])); w.y = __builtin_bit_cast(unsigned, __builtin_amdgcn_cvt_pkrtz(v[2], v[3]));
                        w.z = __builtin_bit_cast(unsigned, __builtin_amdgcn_cvt_pkrtz(v[4], v[5])); w.w = __builtin_bit_cast(unsigned, __builtin_amdgcn_cvt_pkrtz(v[6], v[7]));
                    } else {
                        if (kind == 1) {
#pragma unroll
                            for (int j = 0; j < 8; ++j) v[j] = siluf_(v[j]); }
                        w.x = cvt_pk_bf16(v[0], v[1]); w.y = cvt_pk_bf16(v[2], v[3]); w.z = cvt_pk_bf16(v[4], v[5]); w.w = cvt_pk_bf16(v[6], v[7]); }
                    *(u32x4*)(P + (size_t)row * NIN + pn * BM + bj * HALF + colw) = w; } }
    }
};

template <class Epi, class Sched, bool ALIGN_EPI = false, bool SP2 = false>
__device__ __forceinline__ void gemm_phase(PG8_LAS unsigned char* lds, const Gemm g, const Sched& S, const Epi& E) {
    const int tid = threadIdx.x, wid = __builtin_amdgcn_readfirstlane(tid >> 6), lane = tid & 63, wr = wid >> 2, wc = wid & 3, fr = lane & 15, fq = lane >> 4;
    const int K = g.K, nt = K / BK;
    unsigned voffA[2], voffB[2];
#pragma unroll
    for (int i = 0; i < 2; ++i) { int R, C; stage_rc(tid * 16 + i * 8192, R, C); const int Rb = Epi::PERM ? ((R & ~31) + perm32(R & 31)) : R;
        voffA[i] = (unsigned)(R * K + C) * 2u; voffB[i] = (unsigned)(Rb * K + C) * 2u; }
    const size_t kstep = (size_t)(BK * 2);
    const size_t hstep = (size_t)HALF * K * 2;
    const size_t tstep = 2 * hstep;
    const unsigned ldsw = (unsigned)wid * 1024u;
    const int aoff = lds_byte(wr * 64 + fr, fq * 8), boff = lds_byte(wc * 32 + fr, fq * 8);
#define PG8_SA(b, h) (((b) * 2 + (h)) * HTB)
#define PG8_SB(b, h) ((4 + (b) * 2 + (h)) * HTB)
#define PG8_STAGE(bufoff, gbase, voff) do { _Pragma("unroll") for (int _i = 0; _i < 2; ++_i) \
        __builtin_amdgcn_global_load_lds((const unsigned*)((const char*)(gbase) + (voff)[_i]), (PG8_LAS unsigned*)(lds + (bufoff) + ldsw + _i * 8192), 16, 0, 0); } while (0)
#define PG8_LDA(dst, b, h) do { _Pragma("unroll") for (int m = 0; m < 4; ++m) _Pragma("unroll") for (int k = 0; k < 2; ++k) dst[m][k] = *(const PG8_LAS bf16x8*)(lds + PG8_SA(b, h) + aoff + m * 2048 + k * 1024); } while (0)
#define PG8_LDB(dst, b, h) do { _Pragma("unroll") for (int n = 0; n < 2; ++n) _Pragma("unroll") for (int k = 0; k < 2; ++k) dst[n][k] = *(const PG8_LAS bf16x8*)(lds + PG8_SB(b, h) + boff + n * 2048 + k * 1024); } while (0)
#define PG8_MMA(ai, bj, At, Bt) do { __builtin_amdgcn_s_setprio(1); _Pragma("unroll") for (int m = 0; m < 4; ++m) _Pragma("unroll") for (int n = 0; n < 2; ++n) _Pragma("unroll") for (int k = 0; k < 2; ++k) \
        acc[ai][bj][m][n] = __builtin_amdgcn_mfma_f32_16x16x32_bf16(Bt[n][k], At[m][k], acc[ai][bj][m][n], 0, 0, 0); __builtin_amdgcn_s_setprio(0); } while (0)
#define PG8_WAIT_V(n) asm volatile("s_waitcnt vmcnt(" #n ")" ::: "memory")
#define PG8_WAIT_L(n) asm volatile("s_waitcnt lgkmcnt(" #n ")" ::: "memory")
#define PG8_BAR __builtin_amdgcn_s_barrier()
#define PG8_SCHED __builtin_amdgcn_sched_barrier(0)
    Unit cur, nxt; int ui = 0;
    if (!S.next(0, cur)) return;
    f32x4 acc[2][2][4][2];
#pragma unroll
    for (int a = 0; a < 2; ++a)
#pragma unroll
        for (int b = 0; b < 2; ++b)
#pragma unroll
            for (int m = 0; m < 4; ++m)
#pragma unroll
                for (int n = 0; n < 2; ++n) acc[a][b][m][n] = (f32x4){0.f, 0.f, 0.f, 0.f};
    bf16x8 At[4][2], B0[2][2], B1[2][2];
    const char* cA = (const char*)g.A + (size_t)cur.pm * tstep; const char* cB = (const char*)g.Bt + (size_t)cur.pn * tstep;
    S.a_ready(cur);
    if constexpr (SP2) {
        PG8_STAGE(PG8_SB(0, 0), cB, voffB); PG8_STAGE(PG8_SB(0, 1), cB + hstep, voffB); PG8_STAGE(PG8_SA(0, 0), cA, voffA); PG8_STAGE(PG8_SA(0, 1), cA + hstep, voffA);
        if (wr == 1) PG8_BAR;
        PG8_WAIT_V(2); PG8_BAR;
        PG8_STAGE(PG8_SB(1, 0), cB + kstep, voffB); PG8_STAGE(PG8_SA(1, 0), cA + kstep, voffA); PG8_STAGE(PG8_SB(1, 1), cB + hstep + kstep, voffB);
        PG8_WAIT_V(6); PG8_BAR;
    } else {
        PG8_STAGE(PG8_SB(0, 0), cB, voffB); PG8_STAGE(PG8_SA(0, 0), cA, voffA); PG8_STAGE(PG8_SB(0, 1), cB + hstep, voffB); PG8_STAGE(PG8_SA(0, 1), cA + hstep, voffA);
        if (wr == 1) PG8_BAR;
        PG8_WAIT_V(4); PG8_BAR;
        PG8_STAGE(PG8_SB(1, 0), cB + kstep, voffB); PG8_STAGE(PG8_SA(1, 0), cA + kstep, voffA); PG8_STAGE(PG8_SB(1, 1), cB + hstep + kstep, voffB);
        PG8_WAIT_V(6); PG8_BAR;
    }
    for (;;) {
        const bool has_next = S.next(ui + 1, nxt);
        const char* nA = has_next ? (const char*)g.A + (size_t)nxt.pm * tstep : cA; const char* nB = has_next ? (const char*)g.Bt + (size_t)nxt.pn * tstep : cB;
        for (int t = 0; t < nt; t += 2) {
            const bool last = (t == nt - 2);
            const char* a1 = cA + (size_t)(t + 1) * kstep;
            const char* a2 = last ? nA : cA + (size_t)(t + 2) * kstep; const char* b2 = last ? nB : cB + (size_t)(t + 2) * kstep;
            const char* a3 = a2 + kstep; const char* b3 = b2 + kstep;
            if (last && has_next) S.a_ready(nxt);
            if constexpr (SP2) {
            PG8_LDB(B0, 0, 0); PG8_LDB(B1, 0, 1); PG8_SCHED; PG8_LDA(At, 0, 0); PG8_STAGE(PG8_SA(1, 1), a1 + hstep, voffA);
            PG8_WAIT_V(8); PG8_WAIT_L(0); PG8_BAR; PG8_MMA(0, 0, At, B0); PG8_MMA(0, 1, At, B1); PG8_BAR; PG8_SCHED;
            PG8_LDA(At, 0, 1); PG8_STAGE(PG8_SB(0, 0), b2, voffB); PG8_STAGE(PG8_SB(0, 1), b2 + hstep, voffB); PG8_STAGE(PG8_SA(0, 0), a2, voffA);
            PG8_WAIT_V(8); PG8_WAIT_L(0); PG8_BAR; PG8_MMA(1, 0, At, B0); PG8_MMA(1, 1, At, B1); PG8_BAR; PG8_SCHED;
            PG8_LDB(B0, 1, 0); PG8_LDB(B1, 1, 1); PG8_SCHED; PG8_LDA(At, 1, 0); PG8_STAGE(PG8_SA(0, 1), a2 + hstep, voffA);
            PG8_WAIT_V(8); PG8_WAIT_L(0); PG8_BAR; PG8_MMA(0, 0, At, B0); PG8_MMA(0, 1, At, B1); PG8_BAR; PG8_SCHED;
            PG8_LDA(At, 1, 1); PG8_STAGE(PG8_SB(1, 0), b3, voffB); PG8_STAGE(PG8_SB(1, 1), b3 + hstep, voffB); PG8_STAGE(PG8_SA(1, 0), a3, voffA);
            PG8_WAIT_V(8); PG8_WAIT_L(0); PG8_BAR; PG8_MMA(1, 0, At, B0); PG8_MMA(1, 1, At, B1); PG8_BAR; PG8_SCHED;
            } else {
            PG8_LDB(B0, 0, 0); PG8_SCHED; PG8_LDA(At, 0, 0); PG8_STAGE(PG8_SA(1, 1), a1 + hstep, voffA);
            PG8_WAIT_L(8); PG8_BAR; PG8_WAIT_L(0); PG8_MMA(0, 0, At, B0); PG8_BAR; PG8_SCHED;
            PG8_LDB(B1, 0, 1); PG8_STAGE(PG8_SB(0, 0), b2, voffB);
            PG8_BAR; PG8_WAIT_L(0); PG8_MMA(0, 1, At, B1); PG8_BAR;
            PG8_LDA(At, 0, 1); PG8_STAGE(PG8_SA(0, 0), a2, voffA);
            PG8_BAR; PG8_WAIT_L(0); PG8_MMA(1, 0, At, B0); PG8_BAR; PG8_SCHED;
            PG8_STAGE(PG8_SB(0, 1), b2 + hstep, voffB);
            PG8_WAIT_V(6); PG8_BAR; PG8_MMA(1, 1, At, B1); PG8_BAR;
            PG8_LDB(B0, 1, 0); PG8_SCHED; PG8_LDA(At, 1, 0); PG8_STAGE(PG8_SA(0, 1), a2 + hstep, voffA);
            PG8_WAIT_L(8); PG8_BAR; PG8_WAIT_L(0); PG8_MMA(0, 0, At, B0); PG8_BAR; PG8_SCHED;
            PG8_LDB(B1, 1, 1); PG8_STAGE(PG8_SB(1, 0), b3, voffB);
            PG8_BAR; PG8_WAIT_L(0); PG8_MMA(0, 1, At, B1); PG8_BAR;
            PG8_LDA(At, 1, 1); PG8_STAGE(PG8_SA(1, 0), a3, voffA);
            PG8_BAR; PG8_WAIT_L(0); PG8_MMA(1, 0, At, B0); PG8_BAR; PG8_SCHED;
            PG8_STAGE(PG8_SB(1, 1), b3 + hstep, voffB);
            PG8_WAIT_V(6); PG8_BAR; PG8_MMA(1, 1, At, B1); PG8_BAR;
            }
        }
        if constexpr (ALIGN_EPI) { if (wr == 0) PG8_BAR; }
        if constexpr (!Epi::AFTER_DRAIN) { E(acc, cur, wr, wc, fr, fq); S.done(cur); }
        if (!has_next) break;
#pragma unroll
        for (int a = 0; a < 2; ++a)
#pragma unroll
            for (int b = 0; b < 2; ++b)
#pragma unroll
                for (int m = 0; m < 4; ++m)
#pragma unroll
                    for (int n = 0; n < 2; ++n) acc[a][b][m][n] = (f32x4){0.f, 0.f, 0.f, 0.f};
        cur = nxt; cA = nA; cB = nB; ++ui;
        if constexpr (ALIGN_EPI) { if (wr == 1) PG8_BAR; }
    }
    PG8_WAIT_V(0);
    if constexpr (!ALIGN_EPI) { if (wr == 0) PG8_BAR; }
    PG8_BAR;
    if constexpr (Epi::AFTER_DRAIN) { E.fused(acc, cur, wr, wc, fr, fq, lds, wid, lane); S.done(cur); }
#undef PG8_SA
#undef PG8_SB
#undef PG8_STAGE
#undef PG8_LDA
#undef PG8_LDB
#undef PG8_MMA
#undef PG8_WAIT_V
#undef PG8_WAIT_L
#undef PG8_BAR
#undef PG8_SCHED
}
}

#define LAS __attribute__((address_space(3)))
#define DI __device__ __forceinline__
typedef unsigned short bf16;
typedef short bf16x8 __attribute__((ext_vector_type(8)));
typedef float f32x4 __attribute__((ext_vector_type(4)));
typedef float f32x16 __attribute__((ext_vector_type(16)));
typedef unsigned u32x4 __attribute__((ext_vector_type(4)));
typedef unsigned u32x2 __attribute__((ext_vector_type(2)));
#define MFMA32(a, b, c) __builtin_amdgcn_mfma_f32_32x32x16_bf16((a), (b), (c), 0, 0, 0)
#define LDS_WAIT() asm volatile("s_waitcnt lgkmcnt(0)" ::: "memory")

constexpr int NTHREADS = 512, NWAVES = 8;
constexpr int LDS_BYTES = 155648;
constexpr int WQ_OFF = LDS_BYTES - 64;
constexpr int HGW = 512, NATT_UNITS = NSEQ * 2 * (SEQ / 64), NSCAN_UNITS = NSEQ * 16;
constexpr size_t MiB = 1u << 20;
constexpr size_t WS_WI1 = 0, WS_WO1 = 12 * MiB, WS_WIN = 18 * MiB, WS_WOUT = 25 * MiB, WS_WI2 = 27 * MiB, WS_WO2 = 39 * MiB;
constexpr size_t WS_ROPE = 45 * MiB;
constexpr size_t WS_RSTD = 48 * MiB;
constexpr size_t WS_SSQ = 49 * MiB;
constexpr size_t WS_LB = 55 * MiB;
constexpr size_t WS_CNT = 56 * MiB;
constexpr size_t WS_BARW = 57 * MiB;
constexpr size_t WS_XB = 64 * MiB;
constexpr size_t WS_BIG = 224 * MiB;
constexpr size_t WS_O = 744 * MiB;
constexpr size_t WS_VEC = 904 * MiB;
constexpr size_t WS_END = 920 * MiB;
static_assert((size_t)DM * 2 * DFF * 2 <= 12 * MiB && (size_t)DFF * DM * 2 <= 6 * MiB && (size_t)NIN * DM * 2 <= 7 * MiB, "weight map");
static_assert((size_t)MTOK * 16 * 4 <= 6 * MiB && (size_t)MTOK * DM * 2 == 160 * MiB && (size_t)MTOK * NIN * 2 <= 520 * MiB, "ws map");

struct Params {
    const float* xp; const float* xs; const float* ffn1_norm; const float* ffn1_wi; const float* ffn1_wo; const float* mix_norm; const float* w_in;
    const float* lb_fwd; const float* lb_bwd; const float* out_norm; const float* q_norm; const float* k_norm; const float* sink; const float* w_out;
    const float* ffn2_norm; const float* ffn2_wi; const float* ffn2_wo;
    float* out; unsigned char* ws;
    double inv_freq_rev[32];
    int ph_lo, ph_hi, coop, pad;
};

DI float bf2f(unsigned short b) { return __builtin_bit_cast(float, (unsigned)b << 16); }
DI float bflo(unsigned w) { return __builtin_bit_cast(float, w << 16); }
DI float bfhi(unsigned w) { return __builtin_bit_cast(float, w & 0xffff0000u); }
DI unsigned pk2(float lo, float hi) { return pg8::cvt_pk_bf16(lo, hi); }
DI unsigned short f2bf(float f) { unsigned u = __builtin_bit_cast(unsigned, f); u += 0x7fffu + ((u >> 16) & 1u); return (unsigned short)(u >> 16); }
DI float h2f(unsigned short h) { return (float)__builtin_bit_cast(_Float16, h); }
DI int crow(int reg, int h) { return (reg & 3) + 8 * (reg >> 2) + 4 * h; }
DI bf16x8 frag(const LAS unsigned char* base, int ld, int row0, int k0, int lane) { return *(const LAS bf16x8*)(base + ((row0 + (lane & 31)) * ld + k0 + 8 * (lane >> 5)) * 2); }
DI f32x16 zero16() { f32x16 z; for (int i = 0; i < 16; ++i) z[i] = 0.f; return z; }

DI void p0_transpose_item(const float* W, int K, int N, bf16* Wt, const float* gain, int perm, int item, LAS float* scr, int lane) {
    const int ntile = N / 64, nt = item % ntile, kt = item / ntile, k0 = kt * 64, n0 = nt * 64;
    int src = n0 + lane;
    if (perm == 1) { const int pn = n0 >> 8, bj = (n0 >> 7) & 1, i = n0 & 127; src = bj * DFF + pn * 128 + i + lane; }
    if (perm == 2 && n0 >= 2560) {
        const int np = n0 + lane - 2560, t = np >> 8, r = np & 255, bj = r >> 7, wc = (r >> 5) & 3, dd = r & 31;
        const int base = (t == 0) ? 2560 + wc * 64 : (t == 1) ? 2560 + (4 + wc) * 64 : (wc < 2 ? 3072 + wc * 64 : 3200 + (wc - 2) * 64);
        src = base + bj * 32 + dd; }
    float wv[64];
#pragma unroll
    for (int kk = 0; kk < 64; ++kk) wv[kk] = W[(size_t)(k0 + kk) * N + src];
    if (gain) {
#pragma unroll
        for (int kk = 0; kk < 64; kk += 4) { const f32x4 g4 = *(const f32x4*)(gain + k0 + kk); wv[kk] *= g4[0]; wv[kk + 1] *= g4[1]; wv[kk + 2] *= g4[2]; wv[kk + 3] *= g4[3]; } }
#pragma unroll
    for (int kk = 0; kk < 64; ++kk) scr[lane * 65 + kk] = wv[kk];
    LDS_WAIT();
    const int c = lane & 7;
#pragma unroll
    for (int j = 0; j < 8; ++j) { const int n = (lane >> 3) + 8 * j; const LAS float* s = scr + n * 65 + 8 * c;
        u32x4 o; o.x = pk2(s[0], s[1]); o.y = pk2(s[2], s[3]); o.z = pk2(s[4], s[5]); o.w = pk2(s[6], s[7]);
        *(u32x4*)(Wt + (size_t)(n0 + n) * K + k0 + 8 * c) = o; }
    LDS_WAIT();
}
DI void p0_prologue(const Params& p, LAS unsigned char* lds, int tid, int G, int bid) {
    const int lane = tid & 63, wave = tid >> 6, gw = bid * NWAVES + wave, NGW = G * NWAVES;
    unsigned char* ws = p.ws;
    LAS float* scr = (LAS float*)(lds + wave * 16640);
    constexpr int I_WI = (DM / 64) * (2 * DFF / 64), I_WO = (DFF / 64) * (DM / 64), I_IN = (DM / 64) * (NIN / 64), I_OUT = (DM / 64) * (DM / 64);
    constexpr int NITEMS = 2 * I_WI + 2 * I_WO + I_IN + I_OUT;
    for (int it = gw; it < NITEMS; it += NGW) {
        int r = it;
        if (r < I_WI) { p0_transpose_item(p.ffn1_wi, DM, 2 * DFF, (bf16*)(ws + WS_WI1), p.ffn1_norm, 1, r, scr, lane); continue; } r -= I_WI;
        if (r < I_WI) { p0_transpose_item(p.ffn2_wi, DM, 2 * DFF, (bf16*)(ws + WS_WI2), p.ffn2_norm, 1, r, scr, lane); continue; } r -= I_WI;
        if (r < I_WO) { p0_transpose_item(p.ffn1_wo, DFF, DM, (bf16*)(ws + WS_WO1), nullptr, 0, r, scr, lane); continue; } r -= I_WO;
        if (r < I_WO) { p0_transpose_item(p.ffn2_wo, DFF, DM, (bf16*)(ws + WS_WO2), nullptr, 0, r, scr, lane); continue; } r -= I_WO;
        if (r < I_IN) { p0_transpose_item(p.w_in, DM, NIN, (bf16*)(ws + WS_WIN), p.mix_norm, 2, r, scr, lane); continue; } r -= I_IN;
        p0_transpose_item(p.w_out, DM, DM, (bf16*)(ws + WS_WOUT), nullptr, 0, r, scr, lane);
    }
    bf16* XB = (bf16*)(ws + WS_XB); float* RSTD = (float*)(ws + WS_RSTD);
    const int RPW = (MTOK + NGW - 1) / NGW;
    for (int row0_ = gw * RPW; row0_ < min((gw + 1) * RPW, MTOK); row0_ += 8) {
        f32x4 v[8][4]; bool on[8];
#pragma unroll
        for (int u = 0; u < 8; ++u) { const int row = row0_ + u; on[u] = row < min((gw + 1) * RPW, MTOK); const int rr = on[u] ? row : row0_;
            const float* xr = (rr < NPROMPT) ? p.xp + (size_t)rr * DM : p.xs + (size_t)(rr - NPROMPT) * DM;
#pragma unroll
            for (int j = 0; j < 4; ++j) v[u][j] = *(const f32x4*)(xr + 4 * lane + 256 * j); }
#pragma unroll
        for (int u = 0; u < 8; ++u) { if (!on[u]) continue; const int row = row0_ + u; float s = 0.f;
#pragma unroll
            for (int j = 0; j < 4; ++j) s += (v[u][j][0] * v[u][j][0] + v[u][j][1] * v[u][j][1]) + (v[u][j][2] * v[u][j][2] + v[u][j][3] * v[u][j][3]);
#pragma unroll
            for (int o = 32; o >= 1; o >>= 1) s += __shfl_xor(s, o);
            const float rsx = 1.0f / sqrtf(s * (1.0f / DM) + EPSV);
#pragma unroll
            for (int j = 0; j < 4; ++j) { u32x2 w; w.x = pk2(v[u][j][0] * rsx, v[u][j][1] * rsx); w.y = pk2(v[u][j][2] * rsx, v[u][j][3] * rsx); *(u32x2*)(XB + (size_t)row * DM + 4 * lane + 256 * j) = w; } }
    }
    float* ROPE = (float*)(ws + WS_ROPE);
    for (int i = bid * NTHREADS + tid; i < SEQ * 32; i += G * NTHREADS) { const int pos = i >> 5, fi = i & 31;
        const double rev = (double)pos * p.inv_freq_rev[fi]; const float fr = (float)(rev - rint(rev));
        ROPE[pos * 64 + fi] = __builtin_amdgcn_cosf(fr); ROPE[pos * 64 + 32 + fi] = __builtin_amdgcn_sinf(fr); }
    if (bid == 0) { float* LB = (float*)(ws + WS_LB);
        for (int c = tid; c < 2 * HGW; c += NTHREADS) { const float* a = (c < HGW) ? p.lb_fwd : p.lb_bwd; const int cc = c & (HGW - 1); LB[c] = 1.0f / (1.0f + expf(a[HGW + cc] - a[cc])); }
        if (tid < 8) *((unsigned*)(ws + WS_CNT) + 64 * tid) = 0u; }
}

typedef short s16x4 __attribute__((ext_vector_type(4)));
DI bf16x8 frag_tr(unsigned img, int ld, int s0, int c0, int lane) {
    const int i16 = lane & 15, q = i16 >> 2, pp = i16 & 3, blk = (lane >> 4) & 1, h = lane >> 5;
    const unsigned a0 = img + (unsigned)(((s0 + 8 * h + q) * ld + c0 + 16 * blk + 4 * pp) * 2), a1 = a0 + (unsigned)(8 * ld);
    s16x4 lo, hi;
    asm volatile("ds_read_b64_tr_b16 %0, %2\n\tds_read_b64_tr_b16 %1, %3\n\ts_waitcnt lgkmcnt(0)" : "=&v"(lo), "=&v"(hi) : "v"(a0), "v"(a1) : "memory");
    return __builtin_shufflevector(lo, hi, 0, 1, 2, 3, 4, 5, 6, 7);
}
template <int LD> DI void frag_tr4(bf16x8 (&f)[4], unsigned img, int s0, int c0, int lane) {
    const int i16 = lane & 15, q = i16 >> 2, pp = i16 & 3, blk = (lane >> 4) & 1, h = lane >> 5;
    const unsigned a0 = img + (unsigned)(((s0 + 8 * h + q) * LD + c0 + 16 * blk + 4 * pp) * 2);
    s16x4 r0, r1, r2, r3, r4, r5, r6, r7;
    asm volatile("ds_read_b64_tr_b16 %0, %8\n\tds_read_b64_tr_b16 %1, %8 offset:%9\n\tds_read_b64_tr_b16 %2, %8 offset:%10\n\tds_read_b64_tr_b16 %3, %8 offset:%11\n\t"
                 "ds_read_b64_tr_b16 %4, %8 offset:%12\n\tds_read_b64_tr_b16 %5, %8 offset:%13\n\tds_read_b64_tr_b16 %6, %8 offset:%14\n\tds_read_b64_tr_b16 %7, %8 offset:%15\n\ts_waitcnt lgkmcnt(0)"
                 : "=&v"(r0), "=&v"(r1), "=&v"(r2), "=&v"(r3), "=&v"(r4), "=&v"(r5), "=&v"(r6), "=&v"(r7)
                 : "v"(a0), "i"(8 * LD), "i"(32 * LD), "i"(40 * LD), "i"(64 * LD), "i"(72 * LD), "i"(96 * LD), "i"(104 * LD) : "memory");
    f[0] = __builtin_shufflevector(r0, r1, 0, 1, 2, 3, 4, 5, 6, 7); f[1] = __builtin_shufflevector(r2, r3, 0, 1, 2, 3, 4, 5, 6, 7);
    f[2] = __builtin_shufflevector(r4, r5, 0, 1, 2, 3, 4, 5, 6, 7); f[3] = __builtin_shufflevector(r6, r7, 0, 1, 2, 3, 4, 5, 6, 7);
}
constexpr int PP_Q = 0, PP_LF = 17408, PP_LB = 34816, PP_QB = 52224, PP_TOT = 69632;
DI void hgrn_prepass(const Params& p, LAS unsigned char* lds, int tid, int G, int bid) {
    bf16* PR = (bf16*)(p.ws + WS_BIG); bf16* QEB = (bf16*)p.out + (size_t)MTOK * DM; float* VEC = (float*)(p.ws + WS_VEC);
    const int r_a = tid >> 4, c_a = tid & 15, k = tid & 127, tq = tid >> 7;
    LAS float* TOT = (LAS float*)(lds + PP_TOT);
    u32x4 q0, q1, f0, f1, b0, b1;
#define PP_LOAD(u) do { const size_t rb = (size_t)((u) >> 2) * 64; const int hc = ((u) & 3) * 128 + 8 * c_a; const bf16* ra = PR + (rb + r_a) * NIN + hc; const bf16* rc = PR + (rb + r_a + 32) * NIN + hc; \
        q0 = *(const u32x4*)(ra); f0 = *(const u32x4*)(ra + 512); b0 = *(const u32x4*)(ra + 1024); q1 = *(const u32x4*)(rc); f1 = *(const u32x4*)(rc + 512); b1 = *(const u32x4*)(rc + 1024); } while (0)
    int unit = bid;
    if (unit < NSEQ * 128 * 4) PP_LOAD(unit);
    for (; unit < NSEQ * 128 * 4; unit += G) {
        { const int o0 = (r_a * 136 + 8 * c_a) * 2, o1 = ((r_a + 32) * 136 + 8 * c_a) * 2;
          *(LAS u32x4*)(lds + PP_Q + o0) = q0; *(LAS u32x4*)(lds + PP_Q + o1) = q1; *(LAS u32x4*)(lds + PP_LF + o0) = f0; *(LAS u32x4*)(lds + PP_LF + o1) = f1; *(LAS u32x4*)(lds + PP_LB + o0) = b0; *(LAS u32x4*)(lds + PP_LB + o1) = b1; }
        if (unit + G < NSEQ * 128 * 4) PP_LOAD(unit + G);
        __syncthreads();
        float q[16], lff[16], lfb[16], blf[16], blb[16];
#pragma unroll
        for (int i = 0; i < 16; ++i) { const int o = ((16 * tq + i) * 136 + k) * 2; q[i] = bf2f(*(const LAS unsigned short*)(lds + PP_Q + o)); lff[i] = h2f(*(const LAS unsigned short*)(lds + PP_LF + o)); lfb[i] = h2f(*(const LAS unsigned short*)(lds + PP_LB + o)); }
        { float run = 0.f;
#pragma unroll
          for (int i = 0; i < 16; ++i) { run += lff[i]; blf[i] = run; }
          TOT[tq * 128 + k] = run; run = 0.f;
#pragma unroll
          for (int i = 15; i >= 0; --i) { run += lfb[i]; blb[i] = run; }
          TOT[512 + tq * 128 + k] = run; }
        __syncthreads();
        { const float t0 = TOT[k], t1 = TOT[128 + k], t2 = TOT[256 + k], t3 = TOT[384 + k], u0 = TOT[512 + k], u1 = TOT[640 + k], u2 = TOT[768 + k], u3 = TOT[896 + k];
          const float offf = (tq > 0 ? t0 : 0.f) + (tq > 1 ? t1 : 0.f) + (tq > 2 ? t2 : 0.f), offb = (tq < 3 ? u3 : 0.f) + (tq < 2 ? u2 : 0.f) + (tq < 1 ? u1 : 0.f);
          const float bmid = t0 + t1, bmidb = u2 + u3;
#pragma unroll
          for (int i = 0; i < 16; ++i) { const int o = ((16 * tq + i) * 136 + k) * 2;
              const float bbf = blf[i] + offf, bbb = blb[i] + offb;
              const float qef = q[i] * __expf(bbf - bmid), kef = (1.0f - __expf(lff[i])) * __expf(bmid - bbf), qeb = q[i] * __expf(bbb - bmidb), keb = (1.0f - __expf(lfb[i])) * __expf(bmidb - bbb);
              const unsigned w1 = pk2(qef, kef), w2 = pk2(keb, qeb);
              *(LAS unsigned short*)(lds + PP_Q + o) = (unsigned short)(w1 & 0xffffu); *(LAS unsigned short*)(lds + PP_LF + o) = (unsigned short)(w1 >> 16); *(LAS unsigned short*)(lds + PP_LB + o) = (unsigned short)(w2 & 0xffffu); *(LAS unsigned short*)(lds + PP_QB + o) = (unsigned short)(w2 >> 16); }
          if (tq == 0) { float* vf = VEC + (size_t)(unit * 2) * 384; vf[k] = __expf(bmid); vf[128 + k] = __expf((t0 + t1) + (t2 + t3)); vf[256 + k] = __expf(t2 + t3);
                         vf[384 + k] = __expf(bmidb); vf[512 + k] = __expf((u0 + u1) + (u2 + u3)); vf[640 + k] = __expf(u0 + u1); } }
        __syncthreads();
        { const size_t rb = (size_t)(unit >> 2) * 64; const int hh = unit & 3, hc = hh * 128 + 8 * c_a; const int o0 = (r_a * 136 + 8 * c_a) * 2, o1 = ((r_a + 32) * 136 + 8 * c_a) * 2;
          bf16* ra = PR + (rb + r_a) * NIN + hc; bf16* rc = PR + (rb + r_a + 32) * NIN + hc;
          *(u32x4*)(ra) = *(const LAS u32x4*)(lds + PP_Q + o0); *(u32x4*)(rc) = *(const LAS u32x4*)(lds + PP_Q + o1);
          *(u32x4*)(ra + 512) = *(const LAS u32x4*)(lds + PP_LF + o0); *(u32x4*)(rc + 512) = *(const LAS u32x4*)(lds + PP_LF + o1);
          *(u32x4*)(ra + 1024) = *(const LAS u32x4*)(lds + PP_LB + o0); *(u32x4*)(rc + 1024) = *(const LAS u32x4*)(lds + PP_LB + o1);
          *(u32x4*)(QEB + (rb + r_a) * HGW + hc) = *(const LAS u32x4*)(lds + PP_QB + o0); *(u32x4*)(QEB + (rb + r_a + 32) * HGW + hc) = *(const LAS u32x4*)(lds + PP_QB + o1); }
        __syncthreads();
    }
#undef PP_LOAD
}

constexpr int S2_QE = 0, S2_KE = 17408, S2_V = 34816, S2_VECO = 44032, S2_BUF = 45568, S2_ST = 91136, S2_P = 108544;
DI void scan_unit2(const Params& p, LAS unsigned char* lds, unsigned lds32, int unit, int tid) {
    const int lane = tid & 63, wave = tid >> 6, h = lane >> 5, lr = lane & 31;
    const int b = unit >> 4, rem = unit & 15, hh = rem >> 2, dir = (rem >> 1) & 1, vh = rem & 1;
    const bf16* PR = (const bf16*)(p.ws + WS_BIG); const bf16* QEB = (const bf16*)p.out + (size_t)MTOK * DM; const float* VEC = (const float*)(p.ws + WS_VEC);
    bf16* OUT = (bf16*)(p.ws + WS_O) + (dir ? (size_t)MTOK * HGW : 0);
    const int colo = hh * 128 + vh * 64;
    const bf16* qsrc = dir ? QEB + hh * 128 : PR + hh * 128; const size_t qstride = dir ? HGW : NIN;
    const bf16* ksrc = PR + (dir ? 1024 : 512) + hh * 128; const bf16* vsrc = PR + 1536 + hh * 128 + vh * 64;
    for (int i = tid; i < 17408 / 4; i += NTHREADS) ((LAS unsigned*)(lds + S2_ST))[i] = 0u;
    f32x16 st = zero16();
    const int r_a = tid >> 4, c_a = tid & 15, r_v = tid >> 3, c_v = tid & 7;
    const int vi2 = wave >> 2, ki = wave & 3, kc = ki * 32 + lr, ti = (wave - 4) >> 1, vi = (wave - 4) & 1;
    const int ati = dir ? (wave > 1) : (wave > 0), asi = dir ? (wave > 0) : (wave > 1);
    u32x4 pq0, pq1, pk0, pk1, pv, pvec = (u32x4){0u, 0u, 0u, 0u};
#define S2_CH(i) (dir ? (SEQ / 64 - 1 - (i)) : (i))
#define S2_ROW0(i) ((size_t)b * SEQ + (size_t)S2_CH(i) * 64)
#define S2_VEC(i) (VEC + (size_t)((((b * 128 + S2_CH(i)) * 4 + hh) * 2 + dir)) * 384)
#define S2_LOAD(i) do { const size_t rb = S2_ROW0(i); pq0 = *(const u32x4*)(qsrc + (rb + r_a) * qstride + 8 * c_a); pq1 = *(const u32x4*)(qsrc + (rb + r_a + 32) * qstride + 8 * c_a); \
        pk0 = *(const u32x4*)(ksrc + (rb + r_a) * NIN + 8 * c_a); pk1 = *(const u32x4*)(ksrc + (rb + r_a + 32) * NIN + 8 * c_a); pv = *(const u32x4*)(vsrc + (rb + r_v) * NIN + 8 * c_v); if (tid < 96) pvec = *(const u32x4*)(S2_VEC(i) + 4 * tid); } while (0)
#define S2_STASH(bf) do { LAS unsigned char* bb_ = lds + (bf) * S2_BUF; *(LAS u32x4*)(bb_ + S2_QE + (r_a * 136 + 8 * c_a) * 2) = pq0; *(LAS u32x4*)(bb_ + S2_QE + ((r_a + 32) * 136 + 8 * c_a) * 2) = pq1; \
        *(LAS u32x4*)(bb_ + S2_KE + (r_a * 136 + 8 * c_a) * 2) = pk0; *(LAS u32x4*)(bb_ + S2_KE + ((r_a + 32) * 136 + 8 * c_a) * 2) = pk1; *(LAS u32x4*)(bb_ + S2_V + (r_v * 72 + 8 * c_v) * 2) = pv; if (tid < 96) *(LAS u32x4*)(bb_ + S2_VECO + 16 * tid) = pvec; } while (0)
    S2_LOAD(0); S2_STASH(0); S2_LOAD(1);
    for (int i = 0; i < SEQ / 64; ++i) {
        const int cur = i & 1; const LAS unsigned char* bufc = lds + cur * S2_BUF; const unsigned buf32 = lds32 + (unsigned)(cur * S2_BUF);
        __syncthreads();
        if (i + 1 < SEQ / 64) S2_STASH(cur ^ 1);
        if (i + 2 < SEQ / 64) S2_LOAD(i + 2);
        f32x16 oacc = zero16();
        if (wave < 3) { f32x16 a = zero16(), a2 = zero16(); bf16x8 fa[8], fb[8];
#pragma unroll
            for (int ks = 0; ks < 8; ++ks) { fa[ks] = frag(bufc + S2_KE, 136, asi * 32, ks * 16, lane); fb[ks] = frag(bufc + S2_QE, 136, ati * 32, ks * 16, lane); }
            __builtin_amdgcn_sched_barrier(0);
#pragma unroll
            for (int ks = 0; ks < 8; ks += 2) { a = MFMA32(fa[ks], fb[ks], a); a2 = MFMA32(fa[ks + 1], fb[ks + 1], a2); }
#pragma unroll
            for (int r = 0; r < 16; ++r) a[r] += a2[r];
            const int t = ati * 32 + lr;
#pragma unroll
            for (int g = 0; g < 4; ++g) { float v[4];
#pragma unroll
                for (int j = 0; j < 4; ++j) { const int s = asi * 32 + 8 * g + 4 * h + j; const bool keep = dir ? (s >= t) : (s <= t); v[j] = keep ? a[4 * g + j] : 0.f; }
                u32x2 w; w.x = pk2(v[0], v[1]); w.y = pk2(v[2], v[3]); *(LAS u32x2*)(lds + S2_P + (t * 72 + asi * 32 + 8 * g + 4 * h) * 2) = w; }
        } else if (wave >= 4) { bf16x8 fa[8], fb[8]; f32x16 o2 = zero16();
#pragma unroll
            for (int ks = 0; ks < 8; ++ks) { fa[ks] = frag(lds + S2_ST, 136, vi * 32, ks * 16, lane); fb[ks] = frag(bufc + S2_QE, 136, ti * 32, ks * 16, lane); }
            __builtin_amdgcn_sched_barrier(0);
#pragma unroll
            for (int ks = 0; ks < 8; ks += 2) { oacc = MFMA32(fa[ks], fb[ks], oacc); o2 = MFMA32(fa[ks + 1], fb[ks + 1], o2); }
#pragma unroll
            for (int r = 0; r < 16; ++r) oacc[r] += o2[r];
        }
        __syncthreads();
        if (wave >= 4) {
            bf16x8 vf[4]; frag_tr4<72>(vf, buf32 + S2_V, 0, vi * 32, lane);
            const int ks0 = dir ? 2 * ti : 0, ks1 = dir ? 4 : 2 * (ti + 1); u32x4 pfr[4];
#pragma unroll
            for (int ks = 0; ks < 4; ++ks) { pfr[ks] = __builtin_bit_cast(u32x4, frag(lds + S2_P, 72, ti * 32, ks * 16, lane)); }
            __builtin_amdgcn_sched_barrier(0);
#pragma unroll
            for (int ks = 0; ks < 4; ++ks) { const bool on = (ks >= ks0 && ks < ks1); u32x4 pw_ = pfr[ks]; pw_.x = on ? pw_.x : 0u; pw_.y = on ? pw_.y : 0u; pw_.z = on ? pw_.z : 0u; pw_.w = on ? pw_.w : 0u;
                oacc = MFMA32(vf[ks], __builtin_bit_cast(bf16x8, pw_), oacc); }
            bf16* op = OUT + (S2_ROW0(i) + ti * 32 + lr) * HGW + colo + vi * 32 + 4 * h;
#pragma unroll
            for (int g = 0; g < 4; ++g) { u32x2 w; w.x = (unsigned)f2bf(oacc[4 * g]) | ((unsigned)f2bf(oacc[4 * g + 1]) << 16); w.y = (unsigned)f2bf(oacc[4 * g + 2]) | ((unsigned)f2bf(oacc[4 * g + 3]) << 16); *(u32x2*)(op + 8 * g) = w; }
        }
        { const float dk_c = ((const LAS float*)(bufc + S2_VECO))[128 + kc], c2_c = ((const LAS float*)(bufc + S2_VECO))[256 + kc], em_n = ((const LAS float*)(lds + (cur ^ 1) * S2_BUF + S2_VECO))[kc];
          bf16x8 kf[4], v0[4]; frag_tr4<136>(kf, buf32 + S2_KE, 0, ki * 32, lane); frag_tr4<72>(v0, buf32 + S2_V, 0, vi2 * 32, lane); f32x16 u0 = zero16();
#pragma unroll
          for (int ks = 0; ks < 4; ++ks) u0 = MFMA32(v0[ks], kf[ks], u0);
#pragma unroll
          for (int r = 0; r < 16; ++r) { st[r] = st[r] * dk_c + c2_c * u0[r]; *(LAS unsigned short*)(lds + S2_ST + ((vi2 * 32 + crow(r, h)) * 136 + kc) * 2) = f2bf(st[r] * em_n); } }
    }
    __syncthreads();
#undef S2_CH
#undef S2_ROW0
#undef S2_VEC
#undef S2_LOAD
#undef S2_STASH
}

DI void attn_prepass(const Params& p, int tid, int G, int bid) {
    bf16* PR = (bf16*)(p.ws + WS_BIG); const float* ROPE = (const float*)(p.ws + WS_ROPE);
    const int c = tid & 7; const unsigned total = (unsigned)MTOK * 10u * 8u, stride = (unsigned)G * NTHREADS;
    const f32x4 qg0 = *(const f32x4*)(p.q_norm + 8 * c), qg1 = *(const f32x4*)(p.q_norm + 8 * c + 4), kg0 = *(const f32x4*)(p.k_norm + 8 * c), kg1 = *(const f32x4*)(p.k_norm + 8 * c + 4);
    for (unsigned base = (unsigned)bid * NTHREADS; base < total; base += 4u * stride) {
        bf16* ptr[4]; u32x4 w[4]; f32x4 c0[4], c1[4], s0[4], s1[4]; int hvv[4]; bool on[4];
#pragma unroll
        for (int u = 0; u < 4; ++u) { const unsigned bu = base + (unsigned)u * stride; on[u] = bu < total; const unsigned hvi = ((on[u] ? bu : base) + (unsigned)tid) >> 3;
            const int row = (int)(hvi / 10u), hv = (int)(hvi - (unsigned)row * 10u), pos = row & (SEQ - 1); hvv[u] = hv;
            ptr[u] = PR + (size_t)row * NIN + (hv < 8 ? 2560 + hv * 64 : 3072 + (hv - 8) * 64) + 8 * c; w[u] = *(const u32x4*)ptr[u];
            const float* rt = ROPE + pos * 64 + 8 * (c & 3); c0[u] = *(const f32x4*)(rt); c1[u] = *(const f32x4*)(rt + 4); s0[u] = *(const f32x4*)(rt + 32); s1[u] = *(const f32x4*)(rt + 36); }
#pragma unroll
        for (int u = 0; u < 4; ++u) { if (!on[u]) continue;
            const int hv = hvv[u];
            float x[8] = {bflo(w[u].x), bfhi(w[u].x), bflo(w[u].y), bfhi(w[u].y), bflo(w[u].z), bfhi(w[u].z), bflo(w[u].w), bfhi(w[u].w)};
            float ss = 0.f;
#pragma unroll
            for (int j = 0; j < 8; ++j) ss += x[j] * x[j];
            ss += __shfl_xor(ss, 1); ss += __shfl_xor(ss, 2); ss += __shfl_xor(ss, 4);
            const float rs = __builtin_amdgcn_rsqf(ss * (1.0f / 64.0f) + EPSV) * (hv < 8 ? 0.125f : 1.0f);
            float y[8];
#pragma unroll
            for (int j = 0; j < 8; ++j) { const float gq = (j < 4 ? qg0[j] : qg1[j - 4]), gk = (j < 4 ? kg0[j] : kg1[j - 4]); x[j] = x[j] * rs * (hv < 8 ? gq : gk); }
#pragma unroll
            for (int j = 0; j < 8; ++j) { const float pr = __shfl_xor(x[j], 4); const float cs = (j < 4 ? c0[u][j] : c1[u][j - 4]), sn = (j < 4 ? s0[u][j] : s1[u][j - 4]); y[j] = (c < 4) ? (x[j] * cs - pr * sn) : (x[j] * cs + pr * sn); }
            u32x4 o; o.x = pk2(y[0], y[1]); o.y = pk2(y[2], y[3]); o.z = pk2(y[4], y[5]); o.w = pk2(y[6], y[7]);
            *(u32x4*)ptr[u] = o; }
    }
}
constexpr int AT_KS = 0, AT_VS = 46080, AT_PW = 92160;
struct AttnRegs { u32x4 kw[5], vw[5]; };
DI void attn_load(const Params& p, int unit, int tid, AttnRegs& r) {
    const int b = unit >> 8, g = (unit >> 7) & 1, qb = unit & 127, key0 = qb * 64 - 128;
    const bf16* PR = (const bf16*)(p.ws + WS_BIG);
#pragma unroll
    for (int it = 0; it < 5; ++it) { const int item = tid + it * NTHREADS, kk = item >> 3, c = item & 7, pos = key0 + kk; const bool valid = pos >= 0 && pos < SEQ; const int pc = valid ? pos : 0;
        const bf16* rp = PR + ((size_t)b * SEQ + pc) * NIN + g * 64 + 8 * c; r.kw[it] = *(const u32x4*)(rp + 3072); r.vw[it] = *(const u32x4*)(rp + 3200);
        if (!valid) { r.kw[it] = (u32x4){0u, 0u, 0u, 0u}; r.vw[it] = r.kw[it]; } }
}
DI void attn_stash(LAS unsigned char* lds, int tid, const AttnRegs& r) {
#pragma unroll
    for (int it = 0; it < 5; ++it) { const int item = tid + it * NTHREADS, kk = item >> 3, c = item & 7;
        *(LAS u32x4*)(lds + AT_KS + (kk * 72 + 8 * c) * 2) = r.kw[it]; *(LAS u32x4*)(lds + AT_VS + (kk * 72 + 8 * c) * 2) = r.vw[it]; }
}
DI void attn_unit(const Params& p, LAS unsigned char* lds, unsigned lds32, int unit, int tid) {
    const int lane = tid & 63, wave = tid >> 6, h = lane >> 5, lr = lane & 31;
    const int b = unit >> 8, g = (unit >> 7) & 1, qb = unit & 127, q0 = qb * 64, key0 = q0 - 128;
    const bf16* PR = (const bf16*)(p.ws + WS_BIG);
    bf16* MIX = (bf16*)p.out;
    const int hd = wave >> 1, qs = wave & 1, head = g * 4 + hd, qpos = q0 + 32 * qs + lr; const size_t qrow = (size_t)b * SEQ + qpos;
    bf16x8 qf[4];
#pragma unroll
    for (int s = 0; s < 4; ++s) qf[s] = __builtin_bit_cast(bf16x8, *(const u32x4*)(PR + qrow * NIN + 2560 + head * 64 + 8 * h + 16 * s));
    float m = p.sink[head], l = 1.0f; f32x16 o0 = zero16(), o1 = zero16();
    const LAS unsigned char* pw = lds + AT_PW + wave * 4608;
    for (int c = 0; c < 5; ++c) { const int kb = 64 * c, kp0 = key0 + kb;
        if (kp0 + 63 < 0 || kp0 >= SEQ) continue;
        f32x16 s0 = zero16(), s1 = zero16(); bf16x8 ka_[4], kb_[4];
#pragma unroll
        for (int s = 0; s < 4; ++s) { ka_[s] = frag(lds + AT_KS, 72, kb, 16 * s, lane); kb_[s] = frag(lds + AT_KS, 72, kb + 32, 16 * s, lane); }
        __builtin_amdgcn_sched_barrier(0);
#pragma unroll
        for (int s = 0; s < 4; ++s) { s0 = MFMA32(ka_[s], qf[s], s0); s1 = MFMA32(kb_[s], qf[s], s1); }
        float cmax = -INFINITY;
        if (c == 0 || c == 4 || kp0 < 0 || kp0 + 63 >= SEQ) {
#pragma unroll
            for (int i = 0; i < 16; ++i) { const int ka = kp0 + crow(i, h), kc = ka + 32;
                const bool va = ka >= 0 && ka < SEQ && ka >= qpos - 128 && ka <= qpos + 128, vc = kc >= 0 && kc < SEQ && kc >= qpos - 128 && kc <= qpos + 128;
                s0[i] = va ? s0[i] : -INFINITY; s1[i] = vc ? s1[i] : -INFINITY; }
        }
#pragma unroll
        for (int i = 0; i < 16; ++i) cmax = fmaxf(cmax, fmaxf(s0[i], s1[i]));
        cmax = fmaxf(cmax, __shfl_xor(cmax, 32));
        const float mn = fmaxf(m, cmax), alpha = __expf(m - mn); m = mn;
        float ps = 0.f;
#pragma unroll
        for (int i = 0; i < 16; ++i) { s0[i] = __expf(s0[i] - mn); s1[i] = __expf(s1[i] - mn); ps += s0[i] + s1[i]; }
        ps += __shfl_xor(ps, 32); l = l * alpha + ps;
#pragma unroll
        for (int i = 0; i < 16; ++i) { o0[i] *= alpha; o1[i] *= alpha; }
#pragma unroll
        for (int gq = 0; gq < 4; ++gq) { u32x2 w; w.x = pk2(s0[4 * gq], s0[4 * gq + 1]); w.y = pk2(s0[4 * gq + 2], s0[4 * gq + 3]); *(LAS u32x2*)(pw + (lr * 72 + 8 * gq + 4 * h) * 2) = w;
            w.x = pk2(s1[4 * gq], s1[4 * gq + 1]); w.y = pk2(s1[4 * gq + 2], s1[4 * gq + 3]); *(LAS u32x2*)(pw + (lr * 72 + 32 + 8 * gq + 4 * h) * 2) = w; }
        LDS_WAIT();
        bf16x8 pf[4], va_[4], vb_[4];
#pragma unroll
        for (int ks = 0; ks < 4; ++ks) pf[ks] = frag(pw, 72, 0, 16 * ks, lane);
        frag_tr4<72>(va_, lds32 + AT_VS, kb, 0, lane); frag_tr4<72>(vb_, lds32 + AT_VS, kb, 32, lane);
#pragma unroll
        for (int ks = 0; ks < 4; ++ks) { o0 = MFMA32(va_[ks], pf[ks], o0); o1 = MFMA32(vb_[ks], pf[ks], o1); }
        LDS_WAIT();
    }
    { const float inv = 1.0f / l; bf16* op = MIX + qrow * DM + 512 + head * 64;
#pragma unroll
      for (int gq = 0; gq < 4; ++gq) { u32x2 w; w.x = pk2(o0[4 * gq] * inv, o0[4 * gq + 1] * inv); w.y = pk2(o0[4 * gq + 2] * inv, o0[4 * gq + 3] * inv); *(u32x2*)(op + 8 * gq + 4 * h) = w;
          w.x = pk2(o1[4 * gq] * inv, o1[4 * gq + 1] * inv); w.y = pk2(o1[4 * gq + 2] * inv, o1[4 * gq + 3] * inv); *(u32x2*)(op + 32 + 8 * gq + 4 * h) = w; } }
}

DI void combine_phase(const Params& p, int tid, int G, int bid) {
    const int lane = tid & 63, wave = tid >> 6, gw = bid * NWAVES + wave, NGW = G * NWAVES;
    const bf16* OF = (const bf16*)(p.ws + WS_O); const bf16* OB = OF + (size_t)MTOK * HGW; const bf16* PR = (const bf16*)(p.ws + WS_BIG); bf16* MIX = (bf16*)p.out;
    const int c0 = 8 * lane; const f32x4 n0 = *(const f32x4*)(p.out_norm + (c0 & 127)), n1 = *(const f32x4*)(p.out_norm + (c0 & 127) + 4);
    const int RPW = (MTOK + NGW - 1) / NGW;
    for (int row0_ = gw * RPW; row0_ < min((gw + 1) * RPW, MTOK); row0_ += 4) {
        u32x4 av[4], bv[4], gv4[4]; bool on[4];
#pragma unroll
        for (int u = 0; u < 4; ++u) { const int row = row0_ + u; on[u] = row < min((gw + 1) * RPW, MTOK); const size_t rr = on[u] ? row : row0_;
            av[u] = *(const u32x4*)(OF + rr * HGW + c0); bv[u] = *(const u32x4*)(OB + rr * HGW + c0); gv4[u] = *(const u32x4*)(PR + rr * NIN + 2048 + c0); }
#pragma unroll
        for (int u = 0; u < 4; ++u) { if (!on[u]) continue; const int row = row0_ + u; const u32x4 a = av[u], bq = bv[u], gg = gv4[u];
            float o[8] = {bflo(a.x) + bflo(bq.x), bfhi(a.x) + bfhi(bq.x), bflo(a.y) + bflo(bq.y), bfhi(a.y) + bfhi(bq.y), bflo(a.z) + bflo(bq.z), bfhi(a.z) + bfhi(bq.z), bflo(a.w) + bflo(bq.w), bfhi(a.w) + bfhi(bq.w)};
            const float gv[8] = {bflo(gg.x), bfhi(gg.x), bflo(gg.y), bfhi(gg.y), bflo(gg.z), bfhi(gg.z), bflo(gg.w), bfhi(gg.w)};
            float ss = 0.f;
#pragma unroll
            for (int j = 0; j < 8; ++j) ss += o[j] * o[j];
            ss += __shfl_xor(ss, 1); ss += __shfl_xor(ss, 2); ss += __shfl_xor(ss, 4); ss += __shfl_xor(ss, 8);
            const float rs = __builtin_amdgcn_rsqf(ss * (1.0f / 128.0f) + EPSV);
#pragma unroll
            for (int j = 0; j < 8; ++j) o[j] = o[j] * rs * (j < 4 ? n0[j] : n1[j - 4]) * gv[j];
            u32x4 w; w.x = pk2(o[0], o[1]); w.y = pk2(o[2], o[3]); w.z = pk2(o[4], o[5]); w.w = pk2(o[6], o[7]);
            *(u32x4*)(MIX + (size_t)row * DM + c0) = w; }
    }
}

#define XB_TMO      128
#define XB_XCNT(j)  (256  + 64 * (j))
#define XB_XSUB(j)  (1280 + 64 * (j))
#define XB_XGEN(j)  (2304 + 64 * (j))
#define XB_TOP      3328
#define XB_TOPGEN   3392
#define XCD_BAR_WORDS 3456
#define XB_SPIN_CAP (1u << 22)

__device__ __forceinline__ unsigned xb_ld(unsigned* p)              { return __hip_atomic_load(p, __ATOMIC_RELAXED, __HIP_MEMORY_SCOPE_AGENT); }
__device__ __forceinline__ unsigned xb_add(unsigned* p, unsigned v) { return __hip_atomic_fetch_add(p, v, __ATOMIC_RELAXED, __HIP_MEMORY_SCOPE_AGENT); }
__device__ __forceinline__ unsigned xb_xcc_id() { return (unsigned)__builtin_amdgcn_s_getreg((3 << 11) | 20) & 0xFu; }
#define XB_SPIN(cond, bar) do { unsigned _sp = 0; while (cond) { __builtin_amdgcn_s_sleep(1); \
    if ((++_sp & 255u) == 0u) { if (xb_ld(&(bar)[XB_TMO])) break; if (_sp > XB_SPIN_CAP) { atomicAdd(&(bar)[XB_TMO], 1u); break; } } } } while (0)

struct XcdBarrier {
    unsigned* bar; unsigned x;
    volatile LAS unsigned* st;
};

__device__ __forceinline__ XcdBarrier xcd_barrier_post(unsigned* bar, volatile LAS unsigned* st) {
    XcdBarrier b; b.bar = bar; b.x = xb_xcc_id(); b.st = st;
    if (threadIdx.x == 0) (void)xb_add(&bar[XB_XCNT(b.x)], 1u);
    return b;
}
__device__ __forceinline__ void xcd_barrier_complete(unsigned* bar, unsigned x, unsigned& nloc, unsigned& nx) {
    const unsigned G = gridDim.x * gridDim.y * gridDim.z;
    unsigned sum, cnt, mine, sp = 0u;
    for (;;) {
        sum = 0u; cnt = 0u; mine = 0u;
#pragma unroll
        for (unsigned j = 0; j < 16; ++j) { const unsigned c = xb_ld(&bar[XB_XCNT(j)]); sum += c; cnt += (c > 0u) ? 1u : 0u; mine = (j == x) ? c : mine; }
        if (sum == G) break;
        __builtin_amdgcn_s_sleep(1);
        if ((++sp & 255u) == 0u) { if (xb_ld(&bar[XB_TMO])) break; if (sp > XB_SPIN_CAP) { atomicAdd(&bar[XB_TMO], 1u); break; } }
    }
    nloc = mine > 0u ? mine : 1u; nx = cnt > 0u ? cnt : 1u;
}

__device__ __forceinline__ void xcd_barrier(const XcdBarrier& b) {
    asm volatile("s_waitcnt vmcnt(0)" ::: "memory");
    __syncthreads();
    if (threadIdx.x == 0) {
        unsigned* bar = b.bar;
        __builtin_amdgcn_s_waitcnt(0);
        unsigned nloc = b.st[0], nx = b.st[1];
        if (nloc == 0u) { xcd_barrier_complete(bar, b.x, nloc, nx); b.st[0] = nloc; b.st[1] = nx; }
        const unsigned old = xb_add(&bar[XB_XSUB(b.x)], 1u);
        const unsigned gen = old / nloc;
        if (old + 1u == (gen + 1u) * nloc) {
            __builtin_amdgcn_fence(__ATOMIC_RELEASE, "agent");
            asm volatile("s_waitcnt vmcnt(0)" ::: "memory");
            const unsigned og = xb_add(&bar[XB_TOP], 1u);
            const unsigned tg = og / nx;
            if (og + 1u == (tg + 1u) * nx) xb_add(&bar[XB_TOPGEN], 1u);
            else XB_SPIN(xb_ld(&bar[XB_TOPGEN]) == tg, bar);
            __builtin_amdgcn_fence(__ATOMIC_ACQUIRE, "agent");
            xb_add(&bar[XB_XGEN(b.x)], 1u);
            asm volatile("s_waitcnt vmcnt(0)" ::: "memory");
        } else {
            XB_SPIN(xb_ld(&bar[XB_XGEN(b.x)]) == gen, bar);
            __builtin_amdgcn_fence(__ATOMIC_ACQUIRE, "agent");
            asm volatile("s_waitcnt vmcnt(0)" ::: "memory");
        }
    }
    __syncthreads();
}


DI unsigned attn_dequeue(unsigned* heads, unsigned xcc) {
    constexpr unsigned PER = (unsigned)NATT_UNITS / 8u;
    for (unsigned t = 0; t < 8u; ++t) { const unsigned x = (xcc + t) & 7u; const unsigned u = atomicAdd(heads + 64 * x, 1u); if (u < PER) return x * PER + u; }
    return (unsigned)NATT_UNITS;
}
__global__ void __launch_bounds__(NTHREADS, 2) hymba_fwd(Params p) {
    extern __shared__ __attribute__((aligned(16))) unsigned char lds_raw[];
    LAS unsigned char* lds = (LAS unsigned char*)lds_raw;
    const int tid = threadIdx.x, G = gridDim.x, bid = blockIdx.x;
    unsigned char* ws = p.ws;
    const int lo = p.ph_lo, hi = p.ph_hi;
#ifndef PH_MASK
#define PH_MASK 0x1ff
#endif
#define IN(k) (lo <= (k) && (k) < hi)
#define SEAM(k) do { if (IN(k) && IN((k) + 1)) { xcd_barrier(xbar); } } while (0)
    volatile LAS unsigned* xst = (volatile LAS unsigned*)(lds + WQ_OFF + 16);
    if (tid == 0) { xst[0] = 0u; xst[1] = 0u; }
    __syncthreads();
    XcdBarrier xbar = xcd_barrier_post((unsigned*)(p.ws + WS_BARW), xst);
    if (p.coop == 2) cg::this_grid().sync();
    bf16* XB = (bf16*)(ws + WS_XB); bf16* BIG = (bf16*)(ws + WS_BIG); bf16* X2B = (bf16*)(ws + WS_O);
    float* RSTD = (float*)(ws + WS_RSTD); float* SSQ = (float*)(ws + WS_SSQ); const float* LB = (const float*)(ws + WS_LB);
    if (((PH_MASK >> 0) & 1) && IN(0)) { p0_prologue(p, lds, tid, G, bid); }
    SEAM(0);
    if (((PH_MASK >> 1) & 1) && IN(1)) {
        pg8::Gemm g{XB, (const bf16*)(ws + WS_WI1), MTOK, 2 * DFF, DM}; pg8::StaticOrder S; S.init(MTOK, 2 * DFF, G, bid);
        pg8::EpiSwiglu<true> E{BIG, nullptr};
        pg8::gemm_phase<pg8::EpiSwiglu<true>, pg8::StaticOrder, true, true>(lds, g, S, E); }
    SEAM(1);
    if (((PH_MASK >> 2) & 1) && IN(2)) {
        pg8::Gemm g{BIG, (const bf16*)(ws + WS_WO1), MTOK, DM, DFF}; pg8::StaticOrder S; S.init(MTOK, DM, G, bid);
        pg8::EpiRes<0, false, true, true> E{nullptr, p.xp, p.xs, nullptr, XB, SSQ};
        pg8::gemm_phase<pg8::EpiRes<0, false, true, true>, pg8::StaticOrder, true, true>(lds, g, S, E); }
    SEAM(2);
    if (((PH_MASK >> 3) & 1) && IN(3)) {
        for (int row = bid * NTHREADS + tid; row < MTOK; row += G * NTHREADS) { const f32x4* sp = (const f32x4*)(SSQ + (size_t)row * 16); const f32x4 a = sp[0], b = sp[1], c = sp[2], d = sp[3];
            const float tot = ((a[0] + a[1]) + (a[2] + a[3])) + ((b[0] + b[1]) + (b[2] + b[3])) + ((c[0] + c[1]) + (c[2] + c[3])) + ((d[0] + d[1]) + (d[2] + d[3]));
            RSTD[row] = 1.0f / sqrtf(tot * (1.0f / DM) + EPSV); }
        xcd_barrier(xbar);
        pg8::Gemm g{XB, (const bf16*)(ws + WS_WIN), MTOK, NIN, DM}; pg8::StaticOrder S; S.init(MTOK, NIN, G, bid);
        pg8::EpiProj E{BIG, RSTD, LB, LB + HGW, p.q_norm, p.k_norm, (const float*)(ws + WS_ROPE)};
        pg8::gemm_phase<pg8::EpiProj, pg8::StaticOrder, true, true>(lds, g, S, E); }
    SEAM(3);
    if (((PH_MASK >> 4) & 1) && IN(4)) {
        hgrn_prepass(p, lds, tid, G, bid);
        xcd_barrier(xbar);
        const unsigned lds32 = (unsigned)(size_t)lds_raw;
        for (int u = bid; u < NSCAN_UNITS; u += G) scan_unit2(p, lds, lds32, u, tid);
        unsigned* cnt = (unsigned*)(ws + WS_CNT); LAS unsigned* wq = (LAS unsigned*)(lds + WQ_OFF);
        const unsigned myx = xb_xcc_id() & 7u;
        __syncthreads(); if (tid == 0) *wq = attn_dequeue(cnt, myx); __syncthreads();
        unsigned u = *wq; AttnRegs ar; if (u < (unsigned)NATT_UNITS) attn_load(p, (int)u, tid, ar);
        while (u < (unsigned)NATT_UNITS) {
            __syncthreads();
            attn_stash(lds, tid, ar);
            if (tid == 0) *wq = attn_dequeue(cnt, myx);
            __syncthreads();
            const unsigned un = *wq; if (un < (unsigned)NATT_UNITS) attn_load(p, (int)un, tid, ar);
            attn_unit(p, lds, lds32, (int)u, tid);
            u = un; } }
    SEAM(4);
    if (((PH_MASK >> 5) & 1) && IN(5)) { combine_phase(p, tid, G, bid); }
    SEAM(5);
    if (((PH_MASK >> 6) & 1) && IN(6)) {
        pg8::Gemm g{(const bf16*)p.out, (const bf16*)(ws + WS_WOUT), MTOK, DM, DM}; pg8::StaticOrder S; S.init(MTOK, DM, G, bid);
        pg8::EpiRes<1, false, true, false> E{nullptr, nullptr, nullptr, XB, X2B, SSQ};
        pg8::gemm_phase<pg8::EpiRes<1, false, true, false>, pg8::StaticOrder, true, true>(lds, g, S, E); }
    SEAM(6);
    if (((PH_MASK >> 7) & 1) && IN(7)) {
        for (int row = bid * NTHREADS + tid; row < MTOK; row += G * NTHREADS) { const f32x4* sp = (const f32x4*)(SSQ + (size_t)row * 16); const f32x4 a = sp[0], b = sp[1], c = sp[2], d = sp[3];
            const float tot = ((a[0] + a[1]) + (a[2] + a[3])) + ((b[0] + b[1]) + (b[2] + b[3])) + ((c[0] + c[1]) + (c[2] + c[3])) + ((d[0] + d[1]) + (d[2] + d[3]));
            RSTD[row] = 1.0f / sqrtf(tot * (1.0f / DM) + EPSV); }
        xcd_barrier(xbar);
        pg8::Gemm g{X2B, (const bf16*)(ws + WS_WI2), MTOK, 2 * DFF, DM}; pg8::StaticOrder S; S.init(MTOK, 2 * DFF, G, bid);
        pg8::EpiSwiglu<false> E{BIG, RSTD};
        pg8::gemm_phase<pg8::EpiSwiglu<false>, pg8::StaticOrder, true, true>(lds, g, S, E); }
    SEAM(7);
    if (((PH_MASK >> 8) & 1) && IN(8)) {
        pg8::Gemm g{BIG, (const bf16*)(ws + WS_WO2), MTOK, DM, DFF}; pg8::StaticOrder S; S.init(MTOK, DM, G, bid);
        pg8::EpiRes<1, true, false, true> E{p.out, nullptr, nullptr, X2B, nullptr, nullptr};
        pg8::gemm_phase<pg8::EpiRes<1, true, false, true>, pg8::StaticOrder, true, true>(lds, g, S, E); }
#undef IN
#undef SEAM
}

#ifndef MK_MULTI
#define MK_MULTI 0
#endif
constexpr int NPHASES = 9;
extern "C" void kernel_launch(void* const* d_in, const int* in_sizes, int n_in, void* d_out, int out_size, void* d_ws, size_t ws_size, hipStream_t stream) {
    static int grid = 0;
    if (grid == 0) {
        int dev = 0, cus = 0;
        if (hipGetDevice(&dev) != hipSuccess || hipDeviceGetAttribute(&cus, hipDeviceAttributeMultiprocessorCount, dev) != hipSuccess) { fprintf(stderr, "kernel_launch: device query failed\n"); grid = -1; return; }
        if (hipFuncSetAttribute((const void*)hymba_fwd, hipFuncAttributeMaxDynamicSharedMemorySize, LDS_BYTES) != hipSuccess) { fprintf(stderr, "kernel_launch: hipFuncSetAttribute failed\n"); grid = -1; return; }
        int per_cu = 0;
        if (hipOccupancyMaxActiveBlocksPerMultiprocessor(&per_cu, (const void*)hymba_fwd, NTHREADS, LDS_BYTES) != hipSuccess || per_cu < 1) { fprintf(stderr, "kernel_launch: occupancy query says %d blocks per CU\n", per_cu); }
        (void)hipGetLastError();
        grid = cus;
        if (n_in != 17 || ws_size < WS_END) { fprintf(stderr, "kernel_launch: unexpected n_in %d or ws_size %zu (< %zu)\n", n_in, ws_size, (size_t)WS_END); }
    }
    if (grid < 0) return;
    Params p{};
    p.xp = (const float*)d_in[0]; p.xs = (const float*)d_in[1]; p.ffn1_norm = (const float*)d_in[2]; p.ffn1_wi = (const float*)d_in[3]; p.ffn1_wo = (const float*)d_in[4];
    p.mix_norm = (const float*)d_in[5]; p.w_in = (const float*)d_in[6]; p.lb_fwd = (const float*)d_in[7]; p.lb_bwd = (const float*)d_in[8]; p.out_norm = (const float*)d_in[9];
    p.q_norm = (const float*)d_in[10]; p.k_norm = (const float*)d_in[11]; p.sink = (const float*)d_in[12]; p.w_out = (const float*)d_in[13]; p.ffn2_norm = (const float*)d_in[14];
    p.ffn2_wi = (const float*)d_in[15]; p.ffn2_wo = (const float*)d_in[16];
    p.out = (float*)d_out; p.ws = (unsigned char*)d_ws;
    for (int i = 0; i < 32; ++i) p.inv_freq_rev[i] = pow(10000.0, -(double)(2 * i) / 64.0) / 6.283185307179586476925286766559;
#if MK_MULTI
    for (int ph = 0; ph < NPHASES; ++ph) { p.ph_lo = ph; p.ph_hi = ph + 1; p.coop = 0;
        hipLaunchKernelGGL(hymba_fwd, dim3(grid), dim3(NTHREADS), LDS_BYTES, stream, p);
        const hipError_t le = hipPeekAtLastError(); if (le != hipSuccess) { fprintf(stderr, "kernel_launch: launch %d failed: %s\n", ph, hipGetErrorName(le)); break; } }
#else
    if (hipMemsetAsync((unsigned char*)d_ws + WS_BARW, 0, 16384, stream) != hipSuccess) { fprintf(stderr, "kernel_launch: hipMemsetAsync failed\n"); return; }
    p.ph_lo = 0; p.ph_hi = NPHASES; p.coop = 1;
    void* args[] = {&p};
    const hipError_t le = hipLaunchCooperativeKernel((const void*)hymba_fwd, dim3(grid), dim3(NTHREADS), args, LDS_BYTES, stream);
    if (le != hipSuccess) fprintf(stderr, "kernel_launch: cooperative launch failed: %s (grid %d)\n", hipGetErrorName(le), grid);
#endif
}
```

```cpp
#include <hip/hip_runtime.h>
#include <hip/hip_cooperative_groups.h>
#include <cstdio>
#include <cmath>
namespace cg = cooperative_groups;
constexpr int DM = 1024, SEQ = 8192, NSEQ = 10, MTOK = NSEQ * SEQ, NPROMPT = 2 * SEQ, DFF = 2816, NIN = 3328;
constexpr float EPSV = 1e-6f;
#include <hip/hip_runtime.h>
#include <cstdio>
#include <cstdint>
namespace pg8 {
#define PG8_LAS __attribute__((address_space(3)))
typedef unsigned short bf16_t;
typedef short bf16x8 __attribute__((ext_vector_type(8)));
typedef float f32x4 __attribute__((ext_vector_type(4)));
typedef unsigned u32x4 __attribute__((ext_vector_type(4)));
constexpr int BM = 256, BK = 64, HALF = 128, HTB = HALF * BK * 2  , STAGE_BYTES = 8 * HTB, NXCD = 8, WGM = 8;

__host__ __device__ __forceinline__ int lds_byte(int r, int c) { const int st = (r >> 4) * 2 + (c >> 5), rr = r & 15, cc = c & 31, ob = rr * 64 + cc * 2; return st * 1024 + (ob ^ (((ob >> 9) & 1) << 5)); }
__host__ __device__ __forceinline__ void stage_rc(int b, int& R, int& C) { const int st = b / 1024, sb = b % 1024, swz = sb ^ (((sb >> 9) & 1) << 5); R = (st >> 1) * 16 + swz / 64; C = (st & 1) * 32 + (swz % 64) / 2; }
__host__ __device__ __forceinline__ int perm32(int rho) { const int n = rho >> 4, i = rho & 15; return 8 * (i >> 2) + 4 * n + (i & 3); }

struct Unit { int pm, pn; };
struct Gemm { const bf16_t* A; const bf16_t* Bt; int M, N, K; };

struct StaticOrder {
    int nM, nN, nwg, G, c;
    __host__ __device__ void init(int M, int N, int G_, int c_) { nM = M / BM; nN = N / BM; nwg = nM * nN; G = G_; c = c_; }
    __host__ __device__ bool next(int i, Unit& u) const {
        const long L = (long)i * G + c; if (L >= nwg) return false;
        int wgid = (int)L; { const int q = nwg / NXCD, r = nwg % NXCD, xcd = wgid % NXCD, off = wgid / NXCD; wgid = (xcd < r ? xcd * (q + 1) : r * (q + 1) + (xcd - r) * q) + off; }
        const int nig = WGM * nN, gid = wgid / nig, fm = gid * WGM, gsz = (nM - fm) < WGM ? (nM - fm) : WGM;
        u.pm = fm + ((wgid % nig) % gsz); u.pn = (wgid % nig) / gsz; return true;
    }
    __device__ __forceinline__ void a_ready(const Unit&) const {}
    __device__ __forceinline__ void done(const Unit&) const {}
};

__device__ __forceinline__ unsigned cvt_pk_bf16(float lo, float hi) { unsigned r; asm volatile("v_cvt_pk_bf16_f32 %0, %1, %2" : "=v"(r) : "v"(lo), "v"(hi)); return r; }
__device__ __forceinline__ float sigmoidf_(float v) { return __builtin_amdgcn_rcpf(1.0f + __expf(-v)); }
__device__ __forceinline__ float siluf_(float v) { return v * sigmoidf_(v); }

template <bool NORMED> struct EpiSwiglu {
    static constexpr bool PERM = true, AFTER_DRAIN = false;
    bf16_t* H; const float* rstd;
    __device__ __forceinline__ void operator()(const f32x4 (&acc)[2][2][4][2], const Unit& u, int wr, int wc, int fr, int fq) const {
        const int row0 = u.pm * BM + wr * 64 + fr, col0 = u.pn * 128 + wc * 32 + 8 * fq;
        float rsv[2][4];
#pragma unroll
        for (int ai = 0; ai < 2; ++ai)
#pragma unroll
            for (int m = 0; m < 4; ++m) rsv[ai][m] = NORMED ? 1.0f : rstd[row0 + ai * HALF + m * 16];
#pragma unroll
        for (int ai = 0; ai < 2; ++ai)
#pragma unroll
            for (int m = 0; m < 4; ++m) { const int row = row0 + ai * HALF + m * 16; const float rs = rsv[ai][m];
                float hv[8];
#pragma unroll
                for (int n = 0; n < 2; ++n)
#pragma unroll
                    for (int j = 0; j < 4; ++j) { const float g = acc[ai][0][m][n][j] * rs, uu = acc[ai][1][m][n][j] * rs; hv[4 * n + j] = siluf_(g) * uu; }
                u32x4 w; w.x = cvt_pk_bf16(hv[0], hv[1]); w.y = cvt_pk_bf16(hv[2], hv[3]); w.z = cvt_pk_bf16(hv[4], hv[5]); w.w = cvt_pk_bf16(hv[6], hv[7]);
                *(u32x4*)(H + (size_t)row * DFF + col0) = w; }
    }
};
template <int RESMODE, bool OUT_F32, bool AUX, bool HALFSCALE> struct EpiRes {
    static constexpr bool PERM = true, AFTER_DRAIN = false;
    float* out; const float* xp; const float* xs; const bf16_t* resb; bf16_t* xb; float* ssq;
    __device__ __forceinline__ void operator()(const f32x4 (&acc)[2][2][4][2], const Unit& u, int wr, int wc, int fr, int fq) const {
        const int row0 = u.pm * BM + wr * 64 + fr, col0 = u.pn * BM + wc * 32 + 8 * fq;
#pragma unroll
        for (int ai = 0; ai < 2; ++ai)
#pragma unroll
            for (int m = 0; m < 4; ++m) { const int row = row0 + ai * HALF + m * 16;
                const float* resrow = (row < NPROMPT ? xp + (size_t)row * DM : xs + (size_t)(row - NPROMPT) * DM);
                float ss = 0.f;
#pragma unroll
                for (int bj = 0; bj < 2; ++bj) { const int col = col0 + bj * HALF; f32x4 r0, r1;
                    if (RESMODE == 0) { r0 = *(const f32x4*)(resrow + col); r1 = *(const f32x4*)(resrow + col + 4); }
                    else { const u32x4 w = *(const u32x4*)(resb + (size_t)row * DM + col);
                        r0 = (f32x4){__builtin_bit_cast(float, w.x << 16), __builtin_bit_cast(float, w.x & 0xffff0000u), __builtin_bit_cast(float, w.y << 16), __builtin_bit_cast(float, w.y & 0xffff0000u)};
                        r1 = (f32x4){__builtin_bit_cast(float, w.z << 16), __builtin_bit_cast(float, w.z & 0xffff0000u), __builtin_bit_cast(float, w.w << 16), __builtin_bit_cast(float, w.w & 0xffff0000u)}; }
                    const f32x4 o0 = r0 + acc[ai][bj][m][0] * (HALFSCALE ? 0.5f : 1.0f), o1 = r1 + acc[ai][bj][m][1] * (HALFSCALE ? 0.5f : 1.0f);
                    if (OUT_F32) { *(f32x4*)(out + (size_t)row * DM + col) = o0; *(f32x4*)(out + (size_t)row * DM + col + 4) = o1; }
                    else { u32x4 w; w.x = cvt_pk_bf16(o0[0], o0[1]); w.y = cvt_pk_bf16(o0[2], o0[3]); w.z = cvt_pk_bf16(o1[0], o1[1]); w.w = cvt_pk_bf16(o1[2], o1[3]); *(u32x4*)(xb + (size_t)row * DM + col) = w; }
                    if (AUX) ss += ((o0[0] * o0[0] + o0[1] * o0[1]) + (o0[2] * o0[2] + o0[3] * o0[3])) + ((o1[0] * o1[0] + o1[1] * o1[1]) + (o1[2] * o1[2] + o1[3] * o1[3])); }
                if (AUX) { ss += __shfl_xor(ss, 16); ss += __shfl_xor(ss, 32); if (fq == 0) ssq[(size_t)row * 16 + u.pn * 4 + wc] = ss; } }
    }
};
struct EpiProj {
    static constexpr bool PERM = true, AFTER_DRAIN = false;
    bf16_t* P; const float* ssq; const float* lbf; const float* lbb; const float* qn; const float* kn; const float* rope;
    __device__ __forceinline__ void operator()(const f32x4 (&acc)[2][2][4][2], const Unit& u, int wr, int wc, int fr, int fq) const {
        const int row0 = u.pm * BM + wr * 64 + fr, colw = wc * 32 + 8 * fq; const int pn = u.pn;
        float rsv[2][4];
#pragma unroll
        for (int ai = 0; ai < 2; ++ai)
#pragma unroll
            for (int m = 0; m < 4; ++m) rsv[ai][m] = ssq[row0 + ai * HALF + m * 16];
        if (pn >= 10) {
            const bool isv = (pn == 12 && wc >= 2), isq = pn < 12;
            const int cbase = isq ? 2560 + ((pn - 10) * 4 + wc) * 64 : (wc < 2 ? 3072 + wc * 64 : 3200 + (wc - 2) * 64);
            const float* gn = isq ? qn : kn; float glo[8], ghi[8];
#pragma unroll
            for (int j = 0; j < 8; ++j) { glo[j] = gn[8 * fq + j]; ghi[j] = gn[32 + 8 * fq + j]; }
#pragma unroll
            for (int ai = 0; ai < 2; ++ai)
#pragma unroll
                for (int m = 0; m < 4; ++m) { const int row = row0 + ai * HALF + m * 16;
                    const float rs = rsv[ai][m];
                    float lo[8], hi[8];
#pragma unroll
                    for (int n = 0; n < 2; ++n)
#pragma unroll
                        for (int j = 0; j < 4; ++j) { lo[4 * n + j] = acc[ai][0][m][n][j] * rs; hi[4 * n + j] = acc[ai][1][m][n][j] * rs; }
                    if (!isv) {
                        float ss = 0.f;
#pragma unroll
                        for (int j = 0; j < 8; ++j) ss += lo[j] * lo[j] + hi[j] * hi[j];
                        ss += __shfl_xor(ss, 16); ss += __shfl_xor(ss, 32);
                        const float rn = __builtin_amdgcn_rsqf(ss * (1.0f / 64.0f) + EPSV) * (isq ? 0.125f : 1.0f);
                        const float* rt = rope + (size_t)(row & (SEQ - 1)) * 64 + 8 * fq;
                        const f32x4 c0 = *(const f32x4*)(rt), c1 = *(const f32x4*)(rt + 4), n0 = *(const f32x4*)(rt + 32), n1 = *(const f32x4*)(rt + 36);
#pragma unroll
                        for (int j = 0; j < 8; ++j) { const float a = lo[j] * rn * glo[j], bb = hi[j] * rn * ghi[j], cs = (j < 4 ? c0[j] : c1[j - 4]), sn = (j < 4 ? n0[j] : n1[j - 4]); lo[j] = a * cs - bb * sn; hi[j] = bb * cs + a * sn; }
                    }
                    u32x4 w0, w1; w0.x = cvt_pk_bf16(lo[0], lo[1]); w0.y = cvt_pk_bf16(lo[2], lo[3]); w0.z = cvt_pk_bf16(lo[4], lo[5]); w0.w = cvt_pk_bf16(lo[6], lo[7]);
                    w1.x = cvt_pk_bf16(hi[0], hi[1]); w1.y = cvt_pk_bf16(hi[2], hi[3]); w1.z = cvt_pk_bf16(hi[4], hi[5]); w1.w = cvt_pk_bf16(hi[6], hi[7]);
                    *(u32x4*)(P + (size_t)row * NIN + cbase + 8 * fq) = w0; *(u32x4*)(P + (size_t)row * NIN + cbase + 32 + 8 * fq) = w1; }
            return;
        }
        const int kind = (pn < 2 || pn == 8 || pn == 9) ? 1 : ((pn >= 2 && pn < 6) ? 2 : 0);
        float lbv[2][8];
        if (kind == 2) { const float* lb = (pn < 4) ? lbf + (pn - 2) * 256 : lbb + (pn - 4) * 256;
#pragma unroll
            for (int bj = 0; bj < 2; ++bj)
#pragma unroll
                for (int j = 0; j < 8; ++j) lbv[bj][j] = lb[bj * HALF + colw + j]; }
#pragma unroll
        for (int ai = 0; ai < 2; ++ai)
#pragma unroll
            for (int m = 0; m < 4; ++m) { const int row = row0 + ai * HALF + m * 16;
                const float rs = rsv[ai][m];
#pragma unroll
                for (int bj = 0; bj < 2; ++bj) { float v[8];
#pragma unroll
                    for (int n = 0; n < 2; ++n)
#pragma unroll
                        for (int j = 0; j < 4; ++j) v[4 * n + j] = acc[ai][bj][m][n][j] * rs;
                    u32x4 w;
                    if (kind == 2) {
#pragma unroll
                        for (int j = 0; j < 8; ++j) { const float lb = lbv[bj][j]; v[j] = __logf(lb + (1.0f - lb) * sigmoidf_(v[j])); }
                        w.x = __builtin_bit_cast(unsigned, __builtin_amdgcn_cvt_pkrtz(v[0], v[1])); w.y = __builtin_bit_cast(unsigned, __builtin_amdgcn_cvt_pkrtz(v[2], v[3]));
                        w.z = __builtin_bit_cast(unsigned, __builtin_amdgcn_cvt_pkrtz(v[4], v[5])); w.w = __builtin_bit_cast(unsigned, __builtin_amdgcn_cvt_pkrtz(v[6], v[7]));
                    } else {
                        if (kind == 1) {
#pragma unroll
                            for (int j = 0; j < 8; ++j) v[j] = siluf_(v[j]); }
                        w.x = cvt_pk_bf16(v[0], v[1]); w.y = cvt_pk_bf16(v[2], v[3]); w.z = cvt_pk_bf16(v[4], v[5]); w.w = cvt_pk_bf16(v[6], v[7]); }
                    *(u32x4*)(P + (size_t)row * NIN + pn * BM + bj * HALF + colw) = w; } }
    }
};

template <class Epi, class Sched, bool ALIGN_EPI = false, bool SP2 = false>
__device__ __forceinline__ void gemm_phase(PG8_LAS unsigned char* lds, const Gemm g, const Sched& S, const Epi& E) {
    const int tid = threadIdx.x, wid = __builtin_amdgcn_readfirstlane(tid >> 6), lane = tid & 63, wr = wid >> 2, wc = wid & 3, fr = lane & 15, fq = lane >> 4;
    const int K = g.K, nt = K / BK;
    unsigned voffA[2], voffB[2];
#pragma unroll
    for (int i = 0; i < 2; ++i) { int R, C; stage_rc(tid * 16 + i * 8192, R, C); const int Rb = Epi::PERM ? ((R & ~31) + perm32(R & 31)) : R;
        voffA[i] = (unsigned)(R * K + C) * 2u; voffB[i] = (unsigned)(Rb * K + C) * 2u; }
    const size_t kstep = (size_t)(BK * 2);
    const size_t hstep = (size_t)HALF * K * 2;
    const size_t tstep = 2 * hstep;
    const unsigned ldsw = (unsigned)wid * 1024u;
    const int aoff = lds_byte(wr * 64 + fr, fq * 8), boff = lds_byte(wc * 32 + fr, fq * 8);
#define PG8_SA(b, h) (((b) * 2 + (h)) * HTB)
#define PG8_SB(b, h) ((4 + (b) * 2 + (h)) * HTB)
#define PG8_STAGE(bufoff, gbase, voff) do { _Pragma("unroll") for (int _i = 0; _i < 2; ++_i) \
        __builtin_amdgcn_global_load_lds((const unsigned*)((const char*)(gbase) + (voff)[_i]), (PG8_LAS unsigned*)(lds + (bufoff) + ldsw + _i * 8192), 16, 0, 0); } while (0)
#define PG8_LDA(dst, b, h) do { _Pragma("unroll") for (int m = 0; m < 4; ++m) _Pragma("unroll") for (int k = 0; k < 2; ++k) dst[m][k] = *(const PG8_LAS bf16x8*)(lds + PG8_SA(b, h) + aoff + m * 2048 + k * 1024); } while (0)
#define PG8_LDB(dst, b, h) do { _Pragma("unroll") for (int n = 0; n < 2; ++n) _Pragma("unroll") for (int k = 0; k < 2; ++k) dst[n][k] = *(const PG8_LAS bf16x8*)(lds + PG8_SB(b, h) + boff + n * 2048 + k * 1024); } while (0)
#define PG8_MMA(ai, bj, At, Bt) do { __builtin_amdgcn_s_setprio(1); _Pragma("unroll") for (int m = 0; m < 4; ++m) _Pragma("unroll") for (int n = 0; n < 2; ++n) _Pragma("unroll") for (int k = 0; k < 2; ++k) \
        acc[ai][bj][m][n] = __builtin_amdgcn_mfma_f32_16x16x32_bf16(Bt[n][k], At[m][k], acc[ai][bj][m][n], 0, 0, 0); __builtin_amdgcn_s_setprio(0); } while (0)
#define PG8_WAIT_V(n) asm volatile("s_waitcnt vmcnt(" #n ")" ::: "memory")
#define PG8_WAIT_L(n) asm volatile("s_waitcnt lgkmcnt(" #n ")" ::: "memory")
#define PG8_BAR __builtin_amdgcn_s_barrier()
#define PG8_SCHED __builtin_amdgcn_sched_barrier(0)
    Unit cur, nxt; int ui = 0;
    if (!S.next(0, cur)) return;
    f32x4 acc[2][2][4][2];
#pragma unroll
    for (int a = 0; a < 2; ++a)
#pragma unroll
        for (int b = 0; b < 2; ++b)
#pragma unroll
            for (int m = 0; m < 4; ++m)
#pragma unroll
                for (int n = 0; n < 2; ++n) acc[a][b][m][n] = (f32x4){0.f, 0.f, 0.f, 0.f};
    bf16x8 At[4][2], B0[2][2], B1[2][2];
    const char* cA = (const char*)g.A + (size_t)cur.pm * tstep; const char* cB = (const char*)g.Bt + (size_t)cur.pn * tstep;
    S.a_ready(cur);
    if constexpr (SP2) {
        PG8_STAGE(PG8_SB(0, 0), cB, voffB); PG8_STAGE(PG8_SB(0, 1), cB + hstep, voffB); PG8_STAGE(PG8_SA(0, 0), cA, voffA); PG8_STAGE(PG8_SA(0, 1), cA + hstep, voffA);
        if (wr == 1) PG8_BAR;
        PG8_WAIT_V(2); PG8_BAR;
        PG8_STAGE(PG8_SB(1, 0), cB + kstep, voffB); PG8_STAGE(PG8_SA(1, 0), cA + kstep, voffA); PG8_STAGE(PG8_SB(1, 1), cB + hstep + kstep, voffB);
        PG8_WAIT_V(6); PG8_BAR;
    } else {
        PG8_STAGE(PG8_SB(0, 0), cB, voffB); PG8_STAGE(PG8_SA(0, 0), cA, voffA); PG8_STAGE(PG8_SB(0, 1), cB + hstep, voffB); PG8_STAGE(PG8_SA(0, 1), cA + hstep, voffA);
        if (wr == 1) PG8_BAR;
        PG8_WAIT_V(4); PG8_BAR;
        PG8_STAGE(PG8_SB(1, 0), cB + kstep, voffB); PG8_STAGE(PG8_SA(1, 0), cA + kstep, voffA); PG8_STAGE(PG8_SB(1, 1), cB + hstep + kstep, voffB);
        PG8_WAIT_V(6); PG8_BAR;
    }
    for (;;) {
        const bool has_next = S.next(ui + 1, nxt);
        const char* nA = has_next ? (const char*)g.A + (size_t)nxt.pm * tstep : cA; const char* nB = has_next ? (const char*)g.Bt + (size_t)nxt.pn * tstep : cB;
        for (int t = 0; t < nt; t += 2) {
            const bool last = (t == nt - 2);
            const char* a1 = cA + (size_t)(t + 1) * kstep;
            const char* a2 = last ? nA : cA + (size_t)(t + 2) * kstep; const char* b2 = last ? nB : cB + (size_t)(t + 2) * kstep;
            const char* a3 = a2 + kstep; const char* b3 = b2 + kstep;
            if (last && has_next) S.a_ready(nxt);
            if constexpr (SP2) {
            PG8_LDB(B0, 0, 0); PG8_LDB(B1, 0, 1); PG8_SCHED; PG8_LDA(At, 0, 0); PG8_STAGE(PG8_SA(1, 1), a1 + hstep, voffA);
            PG8_WAIT_V(8); PG8_WAIT_L(0); PG8_BAR; PG8_MMA(0, 0, At, B0); PG8_MMA(0, 1, At, B1); PG8_BAR; PG8_SCHED;
            PG8_LDA(At, 0, 1); PG8_STAGE(PG8_SB(0, 0), b2, voffB); PG8_STAGE(PG8_SB(0, 1), b2 + hstep, voffB); PG8_STAGE(PG8_SA(0, 0), a2, voffA);
            PG8_WAIT_V(8); PG8_WAIT_L(0); PG8_BAR; PG8_MMA(1, 0, At, B0); PG8_MMA(1, 1, At, B1); PG8_BAR; PG8_SCHED;
            PG8_LDB(B0, 1, 0); PG8_LDB(B1, 1, 1); PG8_SCHED; PG8_LDA(At, 1, 0); PG8_STAGE(PG8_SA(0, 1), a2 + hstep, voffA);
            PG8_WAIT_V(8); PG8_WAIT_L(0); PG8_BAR; PG8_MMA(0, 0, At, B0); PG8_MMA(0, 1, At, B1); PG8_BAR; PG8_SCHED;
            PG8_LDA(At, 1, 1); PG8_STAGE(PG8_SB(1, 0), b3, voffB); PG8_STAGE(PG8_SB(1, 1), b3 + hstep, voffB); PG8_STAGE(PG8_SA(1, 0), a3, voffA);
            PG8_WAIT_V(8); PG8_WAIT_L(0); PG8_BAR; PG8_MMA(1, 0, At, B0); PG8_MMA(1, 1, At, B1); PG8_BAR; PG8_SCHED;
            } else {
            PG8_LDB(B0, 0, 0); PG8_SCHED; PG8_LDA(At, 0, 0); PG8_STAGE(PG8_SA(1, 1), a1 + hstep, voffA);
            PG8_WAIT_L(8); PG8_BAR; PG8_WAIT_L(0); PG8_MMA(0, 0, At, B0); PG8_BAR; PG8_SCHED;
            PG8_LDB(B1, 0, 1); PG8_STAGE(PG8_SB(0, 0), b2, voffB);
            PG8_BAR; PG8_WAIT_L(0); PG8_MMA(0, 1, At, B1); PG8_BAR;
            PG8_LDA(At, 0, 1); PG8_STAGE(PG8_SA(0, 0), a2, voffA);
            PG8_BAR; PG8_WAIT_L(0); PG8_MMA(1, 0, At, B0); PG8_BAR; PG8_SCHED;
            PG8_STAGE(PG8_SB(0, 1), b2 + hstep, voffB);
            PG8_WAIT_V(6); PG8_BAR; PG8_MMA(1, 1, At, B1); PG8_BAR;
            PG8_LDB(B0, 1, 0); PG8_SCHED; PG8_LDA(At, 1, 0); PG8_STAGE(PG8_SA(0, 1), a2 + hstep, voffA);
            PG8_WAIT_L(8); PG8_BAR; PG8_WAIT_L(0); PG8_MMA(0, 0, At, B0); PG8_BAR; PG8_SCHED;
            PG8_LDB(B1, 1, 1); PG8_STAGE(PG8_SB(1, 0), b3, voffB);
            PG8_BAR; PG8_WAIT_L(0); PG8_MMA(0, 1, At, B1); PG8_BAR;
            PG8_LDA(At, 1, 1); PG8_STAGE(PG8_SA(1, 0), a3, voffA);
            PG8_BAR; PG8_WAIT_L(0); PG8_MMA(1, 0, At, B0); PG8_BAR; PG8_SCHED;
            PG8_STAGE(PG8_SB(1, 1), b3 + hstep, voffB);
            PG8_WAIT_V(6); PG8_BAR; PG8_MMA(1, 1, At, B1); PG8_BAR;
            }
        }
        if constexpr (ALIGN_EPI) { if (wr == 0) PG8_BAR; }
        if constexpr (!Epi::AFTER_DRAIN) { E(acc, cur, wr, wc, fr, fq); S.done(cur); }
        if (!has_next) break;
#pragma unroll
        for (int a = 0; a < 2; ++a)
#pragma unroll
            for (int b = 0; b < 2; ++b)
#pragma unroll
                for (int m = 0; m < 4; ++m)
#pragma unroll
                    for (int n = 0; n < 2; ++n) acc[a][b][m][n] = (f32x4){0.f, 0.f, 0.f, 0.f};
        cur = nxt; cA = nA; cB = nB; ++ui;
        if constexpr (ALIGN_EPI) { if (wr == 1) PG8_BAR; }
    }
    PG8_WAIT_V(0);
    if constexpr (!ALIGN_EPI) { if (wr == 0) PG8_BAR; }
    PG8_BAR;
    if constexpr (Epi::AFTER_DRAIN) { E.fused(acc, cur, wr, wc, fr, fq, lds, wid, lane); S.done(cur); }
#undef PG8_SA
#undef PG8_SB
#undef PG8_STAGE
#undef PG8_LDA
#undef PG8_LDB
#undef PG8_MMA
#undef PG8_WAIT_V
#undef PG8_WAIT_L
#undef PG8_BAR
#undef PG8_SCHED
}
}

#define LAS __attribute__((address_space(3)))
#define DI __device__ __forceinline__
typedef unsigned short bf16;
typedef short bf16x8 __attribute__((ext_vector_type(8)));
typedef float f32x4 __attribute__((ext_vector_type(4)));
typedef float f32x16 __attribute__((ext_vector_type(16)));
typedef unsigned u32x4 __attribute__((ext_vector_type(4)));
typedef unsigned u32x2 __attribute__((ext_vector_type(2)));
#define MFMA32(a, b, c) __builtin_amdgcn_mfma_f32_32x32x16_bf16((a), (b), (c), 0, 0, 0)
#define LDS_WAIT() asm volatile("s_waitcnt lgkmcnt(0)" ::: "memory")

constexpr int NTHREADS = 512, NWAVES = 8;
constexpr int LDS_BYTES = 155648;
constexpr int WQ_OFF = LDS_BYTES - 64;
constexpr int HGW = 512, NATT_UNITS = NSEQ * 2 * (SEQ / 64), NSCAN_UNITS = NSEQ * 16;
constexpr size_t MiB = 1u << 20;
constexpr size_t WS_WI1 = 0, WS_WO1 = 12 * MiB, WS_WIN = 18 * MiB, WS_WOUT = 25 * MiB, WS_WI2 = 27 * MiB, WS_WO2 = 39 * MiB;
constexpr size_t WS_ROPE = 45 * MiB;
constexpr size_t WS_RSTD = 48 * MiB;
constexpr size_t WS_SSQ = 49 * MiB;
constexpr size_t WS_LB = 55 * MiB;
constexpr size_t WS_CNT = 56 * MiB;
constexpr size_t WS_BARW = 57 * MiB;
constexpr size_t WS_XB = 64 * MiB;
constexpr size_t WS_BIG = 224 * MiB;
constexpr size_t WS_O = 744 * MiB;
constexpr size_t WS_VEC = 904 * MiB;
constexpr size_t WS_PF = 920 * MiB;
constexpr size_t WS_END = 1000 * MiB;
static_assert((size_t)DM * 2 * DFF * 2 <= 12 * MiB && (size_t)DFF * DM * 2 <= 6 * MiB && (size_t)NIN * DM * 2 <= 7 * MiB, "weight map");
static_assert((size_t)MTOK * 16 * 4 <= 6 * MiB && (size_t)MTOK * DM * 2 == 160 * MiB && (size_t)MTOK * NIN * 2 <= 520 * MiB, "ws map");

struct Params {
    const float* xp; const float* xs; const float* ffn1_norm; const float* ffn1_wi; const float* ffn1_wo; const float* mix_norm; const float* w_in;
    const float* lb_fwd; const float* lb_bwd; const float* out_norm; const float* q_norm; const float* k_norm; const float* sink; const float* w_out;
    const float* ffn2_norm; const float* ffn2_wi; const float* ffn2_wo;
    float* out; unsigned char* ws;
    double inv_freq_rev[32];
    int ph_lo, ph_hi, coop, pad;
};

DI float bf2f(unsigned short b) { return __builtin_bit_cast(float, (unsigned)b << 16); }
DI float bflo(unsigned w) { return __builtin_bit_cast(float, w << 16); }
DI float bfhi(unsigned w) { return __builtin_bit_cast(float, w & 0xffff0000u); }
DI unsigned pk2(float lo, float hi) { return pg8::cvt_pk_bf16(lo, hi); }
DI unsigned short f2bf(float f) { unsigned u = __builtin_bit_cast(unsigned, f); u += 0x7fffu + ((u >> 16) & 1u); return (unsigned short)(u >> 16); }
DI float h2f(unsigned short h) { return (float)__builtin_bit_cast(_Float16, h); }
DI int crow(int reg, int h) { return (reg & 3) + 8 * (reg >> 2) + 4 * h; }
DI bf16x8 frag(const LAS unsigned char* base, int ld, int row0, int k0, int lane) { return *(const LAS bf16x8*)(base + ((row0 + (lane & 31)) * ld + k0 + 8 * (lane >> 5)) * 2); }
DI f32x16 zero16() { f32x16 z; for (int i = 0; i < 16; ++i) z[i] = 0.f; return z; }

DI void p0_transpose_item(const float* W, int K, int N, bf16* Wt, const float* gain, int perm, int item, LAS float* scr, int lane) {
    const int ntile = N / 64, nt = item % ntile, kt = item / ntile, k0 = kt * 64, n0 = nt * 64;
    int src = n0 + lane;
    if (perm == 1) { const int pn = n0 >> 8, bj = (n0 >> 7) & 1, i = n0 & 127; src = bj * DFF + pn * 128 + i + lane; }
    if (perm == 2 && n0 >= 2560) {
        const int np = n0 + lane - 2560, t = np >> 8, r = np & 255, bj = r >> 7, wc = (r >> 5) & 3, dd = r & 31;
        const int base = (t == 0) ? 2560 + wc * 64 : (t == 1) ? 2560 + (4 + wc) * 64 : (wc < 2 ? 3072 + wc * 64 : 3200 + (wc - 2) * 64);
        src = base + bj * 32 + dd; }
    float wv[64];
#pragma unroll
    for (int kk = 0; kk < 64; ++kk) wv[kk] = W[(size_t)(k0 + kk) * N + src];
    if (gain) {
#pragma unroll
        for (int kk = 0; kk < 64; kk += 4) { const f32x4 g4 = *(const f32x4*)(gain + k0 + kk); wv[kk] *= g4[0]; wv[kk + 1] *= g4[1]; wv[kk + 2] *= g4[2]; wv[kk + 3] *= g4[3]; } }
#pragma unroll
    for (int kk = 0; kk < 64; ++kk) scr[lane * 65 + kk] = wv[kk];
    LDS_WAIT();
    const int c = lane & 7;
#pragma unroll
    for (int j = 0; j < 8; ++j) { const int n = (lane >> 3) + 8 * j; const LAS float* s = scr + n * 65 + 8 * c;
        u32x4 o; o.x = pk2(s[0], s[1]); o.y = pk2(s[2], s[3]); o.z = pk2(s[4], s[5]); o.w = pk2(s[6], s[7]);
        *(u32x4*)(Wt + (size_t)(n0 + n) * K + k0 + 8 * c) = o; }
    LDS_WAIT();
}
DI void p0_prologue(const Params& p, LAS unsigned char* lds, int tid, int G, int bid) {
    const int lane = tid & 63, wave = tid >> 6, gw = bid * NWAVES + wave, NGW = G * NWAVES;
    unsigned char* ws = p.ws;
    LAS float* scr = (LAS float*)(lds + wave * 16640);
    constexpr int I_WI = (DM / 64) * (2 * DFF / 64), I_WO = (DFF / 64) * (DM / 64), I_IN = (DM / 64) * (NIN / 64), I_OUT = (DM / 64) * (DM / 64);
    constexpr int NITEMS = 2 * I_WI + 2 * I_WO + I_IN + I_OUT;
    for (int it = gw; it < NITEMS; it += NGW) {
        int r = it;
        if (r < I_WI) { p0_transpose_item(p.ffn1_wi, DM, 2 * DFF, (bf16*)(ws + WS_WI1), p.ffn1_norm, 1, r, scr, lane); continue; } r -= I_WI;
        if (r < I_WI) { p0_transpose_item(p.ffn2_wi, DM, 2 * DFF, (bf16*)(ws + WS_WI2), p.ffn2_norm, 1, r, scr, lane); continue; } r -= I_WI;
        if (r < I_WO) { p0_transpose_item(p.ffn1_wo, DFF, DM, (bf16*)(ws + WS_WO1), nullptr, 0, r, scr, lane); continue; } r -= I_WO;
        if (r < I_WO) { p0_transpose_item(p.ffn2_wo, DFF, DM, (bf16*)(ws + WS_WO2), nullptr, 0, r, scr, lane); continue; } r -= I_WO;
        if (r < I_IN) { p0_transpose_item(p.w_in, DM, NIN, (bf16*)(ws + WS_WIN), p.mix_norm, 2, r, scr, lane); continue; } r -= I_IN;
        p0_transpose_item(p.w_out, DM, DM, (bf16*)(ws + WS_WOUT), nullptr, 0, r, scr, lane);
    }
    bf16* XB = (bf16*)(ws + WS_XB); float* RSTD = (float*)(ws + WS_RSTD);
    const int RPW = (MTOK + NGW - 1) / NGW;
    for (int row0_ = gw * RPW; row0_ < min((gw + 1) * RPW, MTOK); row0_ += 8) {
        f32x4 v[8][4]; bool on[8];
#pragma unroll
        for (int u = 0; u < 8; ++u) { const int row = row0_ + u; on[u] = row < min((gw + 1) * RPW, MTOK); const int rr = on[u] ? row : row0_;
            const float* xr = (rr < NPROMPT) ? p.xp + (size_t)rr * DM : p.xs + (size_t)(rr - NPROMPT) * DM;
#pragma unroll
            for (int j = 0; j < 4; ++j) v[u][j] = *(const f32x4*)(xr + 4 * lane + 256 * j); }
#pragma unroll
        for (int u = 0; u < 8; ++u) { if (!on[u]) continue; const int row = row0_ + u; float s = 0.f;
#pragma unroll
            for (int j = 0; j < 4; ++j) s += (v[u][j][0] * v[u][j][0] + v[u][j][1] * v[u][j][1]) + (v[u][j][2] * v[u][j][2] + v[u][j][3] * v[u][j][3]);
#pragma unroll
            for (int o = 32; o >= 1; o >>= 1) s += __shfl_xor(s, o);
            const float rsx = 1.0f / sqrtf(s * (1.0f / DM) + EPSV);
#pragma unroll
            for (int j = 0; j < 4; ++j) { u32x2 w; w.x = pk2(v[u][j][0] * rsx, v[u][j][1] * rsx); w.y = pk2(v[u][j][2] * rsx, v[u][j][3] * rsx); *(u32x2*)(XB + (size_t)row * DM + 4 * lane + 256 * j) = w; } }
    }
    float* ROPE = (float*)(ws + WS_ROPE);
    for (int i = bid * NTHREADS + tid; i < SEQ * 32; i += G * NTHREADS) { const int pos = i >> 5, fi = i & 31;
        const double rev = (double)pos * p.inv_freq_rev[fi]; const float fr = (float)(rev - rint(rev));
        ROPE[pos * 64 + fi] = __builtin_amdgcn_cosf(fr); ROPE[pos * 64 + 32 + fi] = __builtin_amdgcn_sinf(fr); }
    if (bid == 0) { float* LB = (float*)(ws + WS_LB);
        for (int c = tid; c < 2 * HGW; c += NTHREADS) { const float* a = (c < HGW) ? p.lb_fwd : p.lb_bwd; const int cc = c & (HGW - 1); LB[c] = 1.0f / (1.0f + expf(a[HGW + cc] - a[cc])); }
        if (tid < 8) *((unsigned*)(ws + WS_CNT) + 64 * tid) = 0u; }
}

typedef short s16x4 __attribute__((ext_vector_type(4)));
DI bf16x8 frag_tr(unsigned img, int ld, int s0, int c0, int lane) {
    const int i16 = lane & 15, q = i16 >> 2, pp = i16 & 3, blk = (lane >> 4) & 1, h = lane >> 5;
    const unsigned a0 = img + (unsigned)(((s0 + 8 * h + q) * ld + c0 + 16 * blk + 4 * pp) * 2), a1 = a0 + (unsigned)(8 * ld);
    s16x4 lo, hi;
    asm volatile("ds_read_b64_tr_b16 %0, %2\n\tds_read_b64_tr_b16 %1, %3\n\ts_waitcnt lgkmcnt(0)" : "=&v"(lo), "=&v"(hi) : "v"(a0), "v"(a1) : "memory");
    return __builtin_shufflevector(lo, hi, 0, 1, 2, 3, 4, 5, 6, 7);
}
template <int LD> DI void frag_tr4(bf16x8 (&f)[4], unsigned img, int s0, int c0, int lane) {
    const int i16 = lane & 15, q = i16 >> 2, pp = i16 & 3, blk = (lane >> 4) & 1, h = lane >> 5;
    const unsigned a0 = img + (unsigned)(((s0 + 8 * h + q) * LD + c0 + 16 * blk + 4 * pp) * 2);
    s16x4 r0, r1, r2, r3, r4, r5, r6, r7;
    asm volatile("ds_read_b64_tr_b16 %0, %8\n\tds_read_b64_tr_b16 %1, %8 offset:%9\n\tds_read_b64_tr_b16 %2, %8 offset:%10\n\tds_read_b64_tr_b16 %3, %8 offset:%11\n\t"
                 "ds_read_b64_tr_b16 %4, %8 offset:%12\n\tds_read_b64_tr_b16 %5, %8 offset:%13\n\tds_read_b64_tr_b16 %6, %8 offset:%14\n\tds_read_b64_tr_b16 %7, %8 offset:%15\n\ts_waitcnt lgkmcnt(0)"
                 : "=&v"(r0), "=&v"(r1), "=&v"(r2), "=&v"(r3), "=&v"(r4), "=&v"(r5), "=&v"(r6), "=&v"(r7)
                 : "v"(a0), "i"(8 * LD), "i"(32 * LD), "i"(40 * LD), "i"(64 * LD), "i"(72 * LD), "i"(96 * LD), "i"(104 * LD) : "memory");
    f[0] = __builtin_shufflevector(r0, r1, 0, 1, 2, 3, 4, 5, 6, 7); f[1] = __builtin_shufflevector(r2, r3, 0, 1, 2, 3, 4, 5, 6, 7);
    f[2] = __builtin_shufflevector(r4, r5, 0, 1, 2, 3, 4, 5, 6, 7); f[3] = __builtin_shufflevector(r6, r7, 0, 1, 2, 3, 4, 5, 6, 7);
}
constexpr int PP_Q = 0, PP_LF = 17408, PP_LB = 34816, PP_QB = 52224, PP_TOT = 69632, PP_PF = 73728, PP_PB = 82944;
DI void hgrn_prepass(const Params& p, LAS unsigned char* lds, int tid, int G, int bid) {
    bf16* PR = (bf16*)(p.ws + WS_BIG); bf16* QEB = (bf16*)p.out + (size_t)MTOK * DM; float* VEC = (float*)(p.ws + WS_VEC);
    const int r_a = tid >> 4, c_a = tid & 15, k = tid & 127, tq = tid >> 7;
    LAS float* TOT = (LAS float*)(lds + PP_TOT);
    u32x4 q0, q1, f0, f1, b0, b1;
#define PP_LOAD(u) do { const size_t rb = (size_t)((u) >> 2) * 64; const int hc = ((u) & 3) * 128 + 8 * c_a; const bf16* ra = PR + (rb + r_a) * NIN + hc; const bf16* rc = PR + (rb + r_a + 32) * NIN + hc; \
        q0 = *(const u32x4*)(ra); f0 = *(const u32x4*)(ra + 512); b0 = *(const u32x4*)(ra + 1024); q1 = *(const u32x4*)(rc); f1 = *(const u32x4*)(rc + 512); b1 = *(const u32x4*)(rc + 1024); } while (0)
    int unit = bid;
    if (unit < NSEQ * 128 * 4) PP_LOAD(unit);
    for (; unit < NSEQ * 128 * 4; unit += G) {
        { const int o0 = (r_a * 136 + 8 * c_a) * 2, o1 = ((r_a + 32) * 136 + 8 * c_a) * 2;
          *(LAS u32x4*)(lds + PP_Q + o0) = q0; *(LAS u32x4*)(lds + PP_Q + o1) = q1; *(LAS u32x4*)(lds + PP_LF + o0) = f0; *(LAS u32x4*)(lds + PP_LF + o1) = f1; *(LAS u32x4*)(lds + PP_LB + o0) = b0; *(LAS u32x4*)(lds + PP_LB + o1) = b1; }
        if (unit + G < NSEQ * 128 * 4) PP_LOAD(unit + G);
        __syncthreads();
        float q[16], lff[16], lfb[16], blf[16], blb[16];
#pragma unroll
        for (int i = 0; i < 16; ++i) { const int o = ((16 * tq + i) * 136 + k) * 2; q[i] = bf2f(*(const LAS unsigned short*)(lds + PP_Q + o)); lff[i] = h2f(*(const LAS unsigned short*)(lds + PP_LF + o)); lfb[i] = h2f(*(const LAS unsigned short*)(lds + PP_LB + o)); }
        { float run = 0.f;
#pragma unroll
          for (int i = 0; i < 16; ++i) { run += lff[i]; blf[i] = run; }
          TOT[tq * 128 + k] = run; run = 0.f;
#pragma unroll
          for (int i = 15; i >= 0; --i) { run += lfb[i]; blb[i] = run; }
          TOT[512 + tq * 128 + k] = run; }
        __syncthreads();
        { const float t0 = TOT[k], t1 = TOT[128 + k], t2 = TOT[256 + k], t3 = TOT[384 + k], u0 = TOT[512 + k], u1 = TOT[640 + k], u2 = TOT[768 + k], u3 = TOT[896 + k];
          const float offf = (tq > 0 ? t0 : 0.f) + (tq > 1 ? t1 : 0.f) + (tq > 2 ? t2 : 0.f), offb = (tq < 3 ? u3 : 0.f) + (tq < 2 ? u2 : 0.f) + (tq < 1 ? u1 : 0.f);
          const float bmid = t0 + t1, bmidb = u2 + u3;
#pragma unroll
          for (int i = 0; i < 16; ++i) { const int o = ((16 * tq + i) * 136 + k) * 2;
              const float bbf = blf[i] + offf, bbb = blb[i] + offb;
              const float qef = q[i] * __expf(bbf - bmid), kef = (1.0f - __expf(lff[i])) * __expf(bmid - bbf), qeb = q[i] * __expf(bbb - bmidb), keb = (1.0f - __expf(lfb[i])) * __expf(bmidb - bbb);
              const unsigned w1 = pk2(qef, kef), w2 = pk2(keb, qeb);
              *(LAS unsigned short*)(lds + PP_Q + o) = (unsigned short)(w1 & 0xffffu); *(LAS unsigned short*)(lds + PP_LF + o) = (unsigned short)(w1 >> 16); *(LAS unsigned short*)(lds + PP_LB + o) = (unsigned short)(w2 & 0xffffu); *(LAS unsigned short*)(lds + PP_QB + o) = (unsigned short)(w2 >> 16); }
          if (tq == 0) { float* vf = VEC + (size_t)(unit * 2) * 384; vf[k] = __expf(bmid); vf[128 + k] = __expf((t0 + t1) + (t2 + t3)); vf[256 + k] = __expf(t2 + t3);
                         vf[384 + k] = __expf(bmidb); vf[512 + k] = __expf((u0 + u1) + (u2 + u3)); vf[640 + k] = __expf(u0 + u1); } }
        __syncthreads();
        { const int wv_ = tid >> 6, ln_ = tid & 63, hh_ = ln_ >> 5, lr_ = ln_ & 31;
          if (wv_ < 6) { const int d_ = wv_ >= 3, w_ = wv_ - 3 * d_; const int ati = d_ ? (w_ > 1) : (w_ > 0), asi = d_ ? (w_ > 0) : (w_ > 1);
              const LAS unsigned char* qi_ = lds + (d_ ? PP_QB : PP_Q); const LAS unsigned char* ki_ = lds + (d_ ? PP_LB : PP_LF); f32x16 a_ = zero16();
#pragma unroll
              for (int ks = 0; ks < 8; ++ks) a_ = MFMA32(frag(ki_, 136, asi * 32, ks * 16, ln_), frag(qi_, 136, ati * 32, ks * 16, ln_), a_);
              const int t_ = ati * 32 + lr_;
#pragma unroll
              for (int g = 0; g < 4; ++g) { float v_[4];
#pragma unroll
                  for (int j = 0; j < 4; ++j) { const int s_ = asi * 32 + 8 * g + 4 * hh_ + j; const bool keep = d_ ? (s_ >= t_) : (s_ <= t_); v_[j] = keep ? a_[4 * g + j] : 0.f; }
                  u32x2 w_2; w_2.x = pk2(v_[0], v_[1]); w_2.y = pk2(v_[2], v_[3]); *(LAS u32x2*)(lds + (d_ ? PP_PB : PP_PF) + (t_ * 72 + asi * 32 + 8 * g + 4 * hh_) * 2) = w_2; } } }
        __syncthreads();
        { const size_t rb = (size_t)(unit >> 2) * 64; const int hh = unit & 3, hc = hh * 128 + 8 * c_a; const int o0 = (r_a * 136 + 8 * c_a) * 2, o1 = ((r_a + 32) * 136 + 8 * c_a) * 2;
          bf16* ra = PR + (rb + r_a) * NIN + hc; bf16* rc = PR + (rb + r_a + 32) * NIN + hc;
          *(u32x4*)(ra) = *(const LAS u32x4*)(lds + PP_Q + o0); *(u32x4*)(rc) = *(const LAS u32x4*)(lds + PP_Q + o1);
          *(u32x4*)(ra + 512) = *(const LAS u32x4*)(lds + PP_LF + o0); *(u32x4*)(rc + 512) = *(const LAS u32x4*)(lds + PP_LF + o1);
          *(u32x4*)(ra + 1024) = *(const LAS u32x4*)(lds + PP_LB + o0); *(u32x4*)(rc + 1024) = *(const LAS u32x4*)(lds + PP_LB + o1);
          *(u32x4*)(QEB + (rb + r_a) * HGW + hc) = *(const LAS u32x4*)(lds + PP_QB + o0); *(u32x4*)(QEB + (rb + r_a + 32) * HGW + hc) = *(const LAS u32x4*)(lds + PP_QB + o1);
          { const int pr_ = tid >> 3, pc_ = tid & 7; bf16* PF_ = (bf16*)(p.ws + WS_PF) + (size_t)unit * 4096; bf16* PB_ = (bf16*)p.out + (size_t)MTOK * DM + (size_t)MTOK * HGW + (size_t)unit * 4096;
            *(u32x4*)(PF_ + pr_ * 64 + 8 * pc_) = *(const LAS u32x4*)(lds + PP_PF + (pr_ * 72 + 8 * pc_) * 2); *(u32x4*)(PB_ + pr_ * 64 + 8 * pc_) = *(const LAS u32x4*)(lds + PP_PB + (pr_ * 72 + 8 * pc_) * 2); } }
        __syncthreads();
    }
#undef PP_LOAD
}

constexpr int S2_QE = 0, S2_KE = 17408, S2_V = 34816, S2_PB = 44032, S2_BUF = 53248, S2_ST = 106496  , S2_VECR = 141312  ;
DI void scan_unit2(const Params& p, LAS unsigned char* lds, unsigned lds32, int unit, int tid) {
    const int lane = tid & 63, wave = tid >> 6, h = lane >> 5, lr = lane & 31;
    const int b = unit >> 4, rem = unit & 15, hh = rem >> 2, dir = (rem >> 1) & 1, vh = rem & 1;
    const bf16* PR = (const bf16*)(p.ws + WS_BIG); const bf16* QEB = (const bf16*)p.out + (size_t)MTOK * DM; const float* VEC = (const float*)(p.ws + WS_VEC);
    const bf16* PIM = dir ? (const bf16*)p.out + (size_t)MTOK * DM + (size_t)MTOK * HGW : (const bf16*)(p.ws + WS_PF);
    bf16* OUT = (bf16*)(p.ws + WS_O) + (dir ? (size_t)MTOK * HGW : 0);
    const int colo = hh * 128 + vh * 64;
    const bf16* qsrc = dir ? QEB + hh * 128 : PR + hh * 128; const size_t qstride = dir ? HGW : NIN;
    const bf16* ksrc = PR + (dir ? 1024 : 512) + hh * 128; const bf16* vsrc = PR + 1536 + hh * 128 + vh * 64;
    for (int i = tid; i < 2 * 17408 / 4; i += NTHREADS) ((LAS unsigned*)(lds + S2_ST))[i] = 0u;
    f32x16 st = zero16();
    const int r_a = tid >> 4, c_a = tid & 15, r_v = tid >> 3, c_v = tid & 7;
    const int vi2 = wave >> 2, ki = wave & 3, kc = ki * 32 + lr, ti = (wave - 4) >> 1, vi = (wave - 4) & 1;
    u32x4 pq0, pq1, pk0, pk1, pv, pp, pvec = (u32x4){0u, 0u, 0u, 0u};
#define S2_CH(i) (dir ? (SEQ / 64 - 1 - (i)) : (i))
#define S2_ROW0(i) ((size_t)b * SEQ + (size_t)S2_CH(i) * 64)
#define S2_VEC(i) (VEC + (size_t)((((b * 128 + S2_CH(i)) * 4 + hh) * 2 + dir)) * 384)
#define S2_LOAD(i) do { const size_t rb = S2_ROW0(i); pq0 = *(const u32x4*)(qsrc + (rb + r_a) * qstride + 8 * c_a); pq1 = *(const u32x4*)(qsrc + (rb + r_a + 32) * qstride + 8 * c_a); \
        pk0 = *(const u32x4*)(ksrc + (rb + r_a) * NIN + 8 * c_a); pk1 = *(const u32x4*)(ksrc + (rb + r_a + 32) * NIN + 8 * c_a); pv = *(const u32x4*)(vsrc + (rb + r_v) * NIN + 8 * c_v); \
        pp = *(const u32x4*)(PIM + (size_t)((b * 128 + S2_CH(i)) * 4 + hh) * 4096 + r_v * 64 + 8 * c_v); } while (0)
#define S2_STASH(bf) do { LAS unsigned char* bb_ = lds + (bf) * S2_BUF; *(LAS u32x4*)(bb_ + S2_QE + (r_a * 136 + 8 * c_a) * 2) = pq0; *(LAS u32x4*)(bb_ + S2_QE + ((r_a + 32) * 136 + 8 * c_a) * 2) = pq1; \
        *(LAS u32x4*)(bb_ + S2_KE + (r_a * 136 + 8 * c_a) * 2) = pk0; *(LAS u32x4*)(bb_ + S2_KE + ((r_a + 32) * 136 + 8 * c_a) * 2) = pk1; *(LAS u32x4*)(bb_ + S2_V + (r_v * 72 + 8 * c_v) * 2) = pv; \
        *(LAS u32x4*)(bb_ + S2_PB + (r_v * 72 + 8 * c_v) * 2) = pp; } while (0)
#define S2_VLOAD(i) do { if (tid < 96) pvec = *(const u32x4*)(S2_VEC(i) + 4 * tid); } while (0)
#define S2_VSTASH(slot) do { if (tid < 96) *(LAS u32x4*)(lds + S2_VECR + (slot) * 1536 + 16 * tid) = pvec; } while (0)
    S2_LOAD(0); S2_VLOAD(0); S2_STASH(0); S2_VSTASH(0); S2_VLOAD(1); S2_VSTASH(1); S2_LOAD(1); S2_VLOAD(2);
    int sl0 = 0, sl1 = 1, sl2 = 2;
    for (int i = 0; i < SEQ / 64; ++i) {
        const int cur = i & 1; const LAS unsigned char* bufc = lds + cur * S2_BUF; const unsigned buf32 = lds32 + (unsigned)(cur * S2_BUF);
        const LAS unsigned char* stc = lds + S2_ST + cur * 17408; LAS unsigned char* stn = lds + S2_ST + (cur ^ 1) * 17408;
        __syncthreads();
        if (i + 1 < SEQ / 64) S2_STASH(cur ^ 1);
        if (i + 2 < SEQ / 64) { S2_VSTASH(sl2); S2_LOAD(i + 2); }
        if (i + 3 < SEQ / 64) S2_VLOAD(i + 3);
        if (wave >= 4) { f32x16 oacc = zero16(), o2 = zero16();
            { bf16x8 fa[8], fb[8];
#pragma unroll
              for (int ks = 0; ks < 8; ++ks) { fa[ks] = frag(stc, 136, vi * 32, ks * 16, lane); fb[ks] = frag(bufc + S2_QE, 136, ti * 32, ks * 16, lane); }
              __builtin_amdgcn_sched_barrier(0);
#pragma unroll
              for (int ks = 0; ks < 8; ks += 2) { oacc = MFMA32(fa[ks], fb[ks], oacc); o2 = MFMA32(fa[ks + 1], fb[ks + 1], o2); } }
            bf16x8 vf[4]; frag_tr4<72>(vf, buf32 + S2_V, 0, vi * 32, lane);
            const int ks0 = dir ? 2 * ti : 0, ks1 = dir ? 4 : 2 * (ti + 1); u32x4 pfr[4];
#pragma unroll
            for (int ks = 0; ks < 4; ++ks) { pfr[ks] = __builtin_bit_cast(u32x4, frag(bufc + S2_PB, 72, ti * 32, ks * 16, lane)); }
            __builtin_amdgcn_sched_barrier(0);
#pragma unroll
            for (int ks = 0; ks < 4; ks += 2) {
#pragma unroll
                for (int kk = 0; kk < 2; ++kk) { const bool on = (ks + kk >= ks0 && ks + kk < ks1); u32x4 pw_ = pfr[ks + kk]; pw_.x = on ? pw_.x : 0u; pw_.y = on ? pw_.y : 0u; pw_.z = on ? pw_.z : 0u; pw_.w = on ? pw_.w : 0u;
                    if (kk == 0) oacc = MFMA32(vf[ks + kk], __builtin_bit_cast(bf16x8, pw_), oacc); else o2 = MFMA32(vf[ks + kk], __builtin_bit_cast(bf16x8, pw_), o2); } }
#pragma unroll
            for (int r = 0; r < 16; ++r) oacc[r] += o2[r];
            bf16* op = OUT + (S2_ROW0(i) + ti * 32 + lr) * HGW + colo + vi * 32 + 4 * h;
#pragma unroll
            for (int g = 0; g < 4; ++g) { u32x2 w; w.x = (unsigned)f2bf(oacc[4 * g]) | ((unsigned)f2bf(oacc[4 * g + 1]) << 16); w.y = (unsigned)f2bf(oacc[4 * g + 2]) | ((unsigned)f2bf(oacc[4 * g + 3]) << 16); *(u32x2*)(op + 8 * g) = w; }
        }
        { const LAS float* vc_ = (const LAS float*)(lds + S2_VECR + sl0 * 1536); const float dk_c = vc_[128 + kc], c2_c = vc_[256 + kc], em_n = ((const LAS float*)(lds + S2_VECR + sl1 * 1536))[kc];
          bf16x8 kf[4], v0[4]; frag_tr4<136>(kf, buf32 + S2_KE, 0, ki * 32, lane); frag_tr4<72>(v0, buf32 + S2_V, 0, vi2 * 32, lane); f32x16 u0 = zero16();
#pragma unroll
          for (int ks = 0; ks < 4; ++ks) u0 = MFMA32(v0[ks], kf[ks], u0);
#pragma unroll
          for (int r = 0; r < 16; ++r) { st[r] = st[r] * dk_c + c2_c * u0[r]; *(LAS unsigned short*)(stn + ((vi2 * 32 + crow(r, h)) * 136 + kc) * 2) = f2bf(st[r] * em_n); } }
        { const int t_ = sl0; sl0 = sl1; sl1 = sl2; sl2 = t_; }
    }
    __syncthreads();
#undef S2_CH
#undef S2_ROW0
#undef S2_VEC
#undef S2_LOAD
#undef S2_VLOAD
#undef S2_VSTASH
#undef S2_STASH
}

DI void attn_prepass(const Params& p, int tid, int G, int bid) {
    bf16* PR = (bf16*)(p.ws + WS_BIG); const float* ROPE = (const float*)(p.ws + WS_ROPE);
    const int c = tid & 7; const unsigned total = (unsigned)MTOK * 10u * 8u, stride = (unsigned)G * NTHREADS;
    const f32x4 qg0 = *(const f32x4*)(p.q_norm + 8 * c), qg1 = *(const f32x4*)(p.q_norm + 8 * c + 4), kg0 = *(const f32x4*)(p.k_norm + 8 * c), kg1 = *(const f32x4*)(p.k_norm + 8 * c + 4);
    for (unsigned base = (unsigned)bid * NTHREADS; base < total; base += 4u * stride) {
        bf16* ptr[4]; u32x4 w[4]; f32x4 c0[4], c1[4], s0[4], s1[4]; int hvv[4]; bool on[4];
#pragma unroll
        for (int u = 0; u < 4; ++u) { const unsigned bu = base + (unsigned)u * stride; on[u] = bu < total; const unsigned hvi = ((on[u] ? bu : base) + (unsigned)tid) >> 3;
            const int row = (int)(hvi / 10u), hv = (int)(hvi - (unsigned)row * 10u), pos = row & (SEQ - 1); hvv[u] = hv;
            ptr[u] = PR + (size_t)row * NIN + (hv < 8 ? 2560 + hv * 64 : 3072 + (hv - 8) * 64) + 8 * c; w[u] = *(const u32x4*)ptr[u];
            const float* rt = ROPE + pos * 64 + 8 * (c & 3); c0[u] = *(const f32x4*)(rt); c1[u] = *(const f32x4*)(rt + 4); s0[u] = *(const f32x4*)(rt + 32); s1[u] = *(const f32x4*)(rt + 36); }
#pragma unroll
        for (int u = 0; u < 4; ++u) { if (!on[u]) continue;
            const int hv = hvv[u];
            float x[8] = {bflo(w[u].x), bfhi(w[u].x), bflo(w[u].y), bfhi(w[u].y), bflo(w[u].z), bfhi(w[u].z), bflo(w[u].w), bfhi(w[u].w)};
            float ss = 0.f;
#pragma unroll
            for (int j = 0; j < 8; ++j) ss += x[j] * x[j];
            ss += __shfl_xor(ss, 1); ss += __shfl_xor(ss, 2); ss += __shfl_xor(ss, 4);
            const float rs = __builtin_amdgcn_rsqf(ss * (1.0f / 64.0f) + EPSV) * (hv < 8 ? 0.125f : 1.0f);
            float y[8];
#pragma unroll
            for (int j = 0; j < 8; ++j) { const float gq = (j < 4 ? qg0[j] : qg1[j - 4]), gk = (j < 4 ? kg0[j] : kg1[j - 4]); x[j] = x[j] * rs * (hv < 8 ? gq : gk); }
#pragma unroll
            for (int j = 0; j < 8; ++j) { const float pr = __shfl_xor(x[j], 4); const float cs = (j < 4 ? c0[u][j] : c1[u][j - 4]), sn = (j < 4 ? s0[u][j] : s1[u][j - 4]); y[j] = (c < 4) ? (x[j] * cs - pr * sn) : (x[j] * cs + pr * sn); }
            u32x4 o; o.x = pk2(y[0], y[1]); o.y = pk2(y[2], y[3]); o.z = pk2(y[4], y[5]); o.w = pk2(y[6], y[7]);
            *(u32x4*)ptr[u] = o; }
    }
}
constexpr int AT_KS = 0, AT_VS = 46080, AT_PW = 92160;
struct AttnRegs { u32x4 kw[5], vw[5]; };
DI void attn_load(const Params& p, int unit, int tid, AttnRegs& r) {
    const int b = unit >> 8, g = (unit >> 7) & 1, qb = unit & 127, key0 = qb * 64 - 128;
    const bf16* PR = (const bf16*)(p.ws + WS_BIG);
#pragma unroll
    for (int it = 0; it < 5; ++it) { const int item = tid + it * NTHREADS, kk = item >> 3, c = item & 7, pos = key0 + kk; const bool valid = pos >= 0 && pos < SEQ; const int pc = valid ? pos : 0;
        const bf16* rp = PR + ((size_t)b * SEQ + pc) * NIN + g * 64 + 8 * c; r.kw[it] = *(const u32x4*)(rp + 3072); r.vw[it] = *(const u32x4*)(rp + 3200);
        if (!valid) { r.kw[it] = (u32x4){0u, 0u, 0u, 0u}; r.vw[it] = r.kw[it]; } }
}
DI void attn_stash(LAS unsigned char* lds, int tid, const AttnRegs& r) {
#pragma unroll
    for (int it = 0; it < 5; ++it) { const int item = tid + it * NTHREADS, kk = item >> 3, c = item & 7;
        *(LAS u32x4*)(lds + AT_KS + (kk * 72 + 8 * c) * 2) = r.kw[it]; *(LAS u32x4*)(lds + AT_VS + (kk * 72 + 8 * c) * 2) = r.vw[it]; }
}
DI void attn_unit(const Params& p, LAS unsigned char* lds, unsigned lds32, int unit, int tid) {
    const int lane = tid & 63, wave = tid >> 6, h = lane >> 5, lr = lane & 31;
    const int b = unit >> 8, g = (unit >> 7) & 1, qb = unit & 127, q0 = qb * 64, key0 = q0 - 128;
    const bf16* PR = (const bf16*)(p.ws + WS_BIG);
    bf16* MIX = (bf16*)p.out;
    const int hd = wave >> 1, qs = wave & 1, head = g * 4 + hd, qpos = q0 + 32 * qs + lr; const size_t qrow = (size_t)b * SEQ + qpos;
    bf16x8 qf[4];
#pragma unroll
    for (int s = 0; s < 4; ++s) qf[s] = __builtin_bit_cast(bf16x8, *(const u32x4*)(PR + qrow * NIN + 2560 + head * 64 + 8 * h + 16 * s));
    float m = p.sink[head], l = 1.0f; f32x16 o0 = zero16(), o1 = zero16();
    const LAS unsigned char* pw = lds + AT_PW + wave * 4608;
    for (int c = 0; c < 5; ++c) { const int kb = 64 * c, kp0 = key0 + kb;
        if (kp0 + 63 < 0 || kp0 >= SEQ) continue;
        f32x16 s0 = zero16(), s1 = zero16(); bf16x8 ka_[4], kb_[4];
#pragma unroll
        for (int s = 0; s < 4; ++s) { ka_[s] = frag(lds + AT_KS, 72, kb, 16 * s, lane); kb_[s] = frag(lds + AT_KS, 72, kb + 32, 16 * s, lane); }
        __builtin_amdgcn_sched_barrier(0);
#pragma unroll
        for (int s = 0; s < 4; ++s) { s0 = MFMA32(ka_[s], qf[s], s0); s1 = MFMA32(kb_[s], qf[s], s1); }
        float cmax = -INFINITY;
        if (c == 0 || c == 4 || kp0 < 0 || kp0 + 63 >= SEQ) {
#pragma unroll
            for (int i = 0; i < 16; ++i) { const int ka = kp0 + crow(i, h), kc = ka + 32;
                const bool va = ka >= 0 && ka < SEQ && ka >= qpos - 128 && ka <= qpos + 128, vc = kc >= 0 && kc < SEQ && kc >= qpos - 128 && kc <= qpos + 128;
                s0[i] = va ? s0[i] : -INFINITY; s1[i] = vc ? s1[i] : -INFINITY; }
        }
#pragma unroll
        for (int i = 0; i < 16; ++i) cmax = fmaxf(cmax, fmaxf(s0[i], s1[i]));
        cmax = fmaxf(cmax, __shfl_xor(cmax, 32));
        const float mn = fmaxf(m, cmax), alpha = __expf(m - mn); m = mn;
        float ps = 0.f;
#pragma unroll
        for (int i = 0; i < 16; ++i) { s0[i] = __expf(s0[i] - mn); s1[i] = __expf(s1[i] - mn); ps += s0[i] + s1[i]; }
        ps += __shfl_xor(ps, 32); l = l * alpha + ps;
#pragma unroll
        for (int i = 0; i < 16; ++i) { o0[i] *= alpha; o1[i] *= alpha; }
#pragma unroll
        for (int gq = 0; gq < 4; ++gq) { u32x2 w; w.x = pk2(s0[4 * gq], s0[4 * gq + 1]); w.y = pk2(s0[4 * gq + 2], s0[4 * gq + 3]); *(LAS u32x2*)(pw + (lr * 72 + 8 * gq + 4 * h) * 2) = w;
            w.x = pk2(s1[4 * gq], s1[4 * gq + 1]); w.y = pk2(s1[4 * gq + 2], s1[4 * gq + 3]); *(LAS u32x2*)(pw + (lr * 72 + 32 + 8 * gq + 4 * h) * 2) = w; }
        LDS_WAIT();
        bf16x8 pf[4], va_[4], vb_[4];
#pragma unroll
        for (int ks = 0; ks < 4; ++ks) pf[ks] = frag(pw, 72, 0, 16 * ks, lane);
        frag_tr4<72>(va_, lds32 + AT_VS, kb, 0, lane); frag_tr4<72>(vb_, lds32 + AT_VS, kb, 32, lane);
#pragma unroll
        for (int ks = 0; ks < 4; ++ks) { o0 = MFMA32(va_[ks], pf[ks], o0); o1 = MFMA32(vb_[ks], pf[ks], o1); }
        LDS_WAIT();
    }
    { const float inv = 1.0f / l; bf16* op = MIX + qrow * DM + 512 + head * 64;
#pragma unroll
      for (int gq = 0; gq < 4; ++gq) { u32x2 w; w.x = pk2(o0[4 * gq] * inv, o0[4 * gq + 1] * inv); w.y = pk2(o0[4 * gq + 2] * inv, o0[4 * gq + 3] * inv); *(u32x2*)(op + 8 * gq + 4 * h) = w;
          w.x = pk2(o1[4 * gq] * inv, o1[4 * gq + 1] * inv); w.y = pk2(o1[4 * gq + 2] * inv, o1[4 * gq + 3] * inv); *(u32x2*)(op + 32 + 8 * gq + 4 * h) = w; } }
}

DI void combine_phase(const Params& p, int tid, int G, int bid) {
    const int lane = tid & 63, wave = tid >> 6, gw = bid * NWAVES + wave, NGW = G * NWAVES;
    const bf16* OF = (const bf16*)(p.ws + WS_O); const bf16* OB = OF + (size_t)MTOK * HGW; const bf16* PR = (const bf16*)(p.ws + WS_BIG); bf16* MIX = (bf16*)p.out;
    const int c0 = 8 * lane; const f32x4 n0 = *(const f32x4*)(p.out_norm + (c0 & 127)), n1 = *(const f32x4*)(p.out_norm + (c0 & 127) + 4);
    const int RPW = (MTOK + NGW - 1) / NGW;
    for (int row0_ = gw * RPW; row0_ < min((gw + 1) * RPW, MTOK); row0_ += 4) {
        u32x4 av[4], bv[4], gv4[4]; bool on[4];
#pragma unroll
        for (int u = 0; u < 4; ++u) { const int row = row0_ + u; on[u] = row < min((gw + 1) * RPW, MTOK); const size_t rr = on[u] ? row : row0_;
            av[u] = *(const u32x4*)(OF + rr * HGW + c0); bv[u] = *(const u32x4*)(OB + rr * HGW + c0); gv4[u] = *(const u32x4*)(PR + rr * NIN + 2048 + c0); }
#pragma unroll
        for (int u = 0; u < 4; ++u) { if (!on[u]) continue; const int row = row0_ + u; const u32x4 a = av[u], bq = bv[u], gg = gv4[u];
            float o[8] = {bflo(a.x) + bflo(bq.x), bfhi(a.x) + bfhi(bq.x), bflo(a.y) + bflo(bq.y), bfhi(a.y) + bfhi(bq.y), bflo(a.z) + bflo(bq.z), bfhi(a.z) + bfhi(bq.z), bflo(a.w) + bflo(bq.w), bfhi(a.w) + bfhi(bq.w)};
            const float gv[8] = {bflo(gg.x), bfhi(gg.x), bflo(gg.y), bfhi(gg.y), bflo(gg.z), bfhi(gg.z), bflo(gg.w), bfhi(gg.w)};
            float ss = 0.f;
#pragma unroll
            for (int j = 0; j < 8; ++j) ss += o[j] * o[j];
            ss += __shfl_xor(ss, 1); ss += __shfl_xor(ss, 2); ss += __shfl_xor(ss, 4); ss += __shfl_xor(ss, 8);
            const float rs = __builtin_amdgcn_rsqf(ss * (1.0f / 128.0f) + EPSV);
#pragma unroll
            for (int j = 0; j < 8; ++j) o[j] = o[j] * rs * (j < 4 ? n0[j] : n1[j - 4]) * gv[j];
            u32x4 w; w.x = pk2(o[0], o[1]); w.y = pk2(o[2], o[3]); w.z = pk2(o[4], o[5]); w.w = pk2(o[6], o[7]);
            *(u32x4*)(MIX + (size_t)row * DM + c0) = w; }
    }
}

#define XB_TMO      128
#define XB_XCNT(j)  (256  + 64 * (j))
#define XB_XSUB(j)  (1280 + 64 * (j))
#define XB_XGEN(j)  (2304 + 64 * (j))
#define XB_TOP      3328
#define XB_TOPGEN   3392
#define XCD_BAR_WORDS 3456
#define XB_SPIN_CAP (1u << 22)

__device__ __forceinline__ unsigned xb_ld(unsigned* p)              { return __hip_atomic_load(p, __ATOMIC_RELAXED, __HIP_MEMORY_SCOPE_AGENT); }
__device__ __forceinline__ unsigned xb_add(unsigned* p, unsigned v) { return __hip_atomic_fetch_add(p, v, __ATOMIC_RELAXED, __HIP_MEMORY_SCOPE_AGENT); }
__device__ __forceinline__ unsigned xb_xcc_id() { return (unsigned)__builtin_amdgcn_s_getreg((3 << 11) | 20) & 0xFu; }
#define XB_SPIN(cond, bar) do { unsigned _sp = 0; while (cond) { __builtin_amdgcn_s_sleep(1); \
    if ((++_sp & 255u) == 0u) { if (xb_ld(&(bar)[XB_TMO])) break; if (_sp > XB_SPIN_CAP) { atomicAdd(&(bar)[XB_TMO], 1u); break; } } } } while (0)

struct XcdBarrier {
    unsigned* bar; unsigned x;
    volatile LAS unsigned* st;
};

__device__ __forceinline__ XcdBarrier xcd_barrier_post(unsigned* bar, volatile LAS unsigned* st) {
    XcdBarrier b; b.bar = bar; b.x = xb_xcc_id(); b.st = st;
    if (threadIdx.x == 0) (void)xb_add(&bar[XB_XCNT(b.x)], 1u);
    return b;
}
__device__ __forceinline__ void xcd_barrier_complete(unsigned* bar, unsigned x, unsigned& nloc, unsigned& nx) {
    const unsigned G = gridDim.x * gridDim.y * gridDim.z;
    unsigned sum, cnt, mine, sp = 0u;
    for (;;) {
        sum = 0u; cnt = 0u; mine = 0u;
#pragma unroll
        for (unsigned j = 0; j < 16; ++j) { const unsigned c = xb_ld(&bar[XB_XCNT(j)]); sum += c; cnt += (c > 0u) ? 1u : 0u; mine = (j == x) ? c : mine; }
        if (sum == G) break;
        __builtin_amdgcn_s_sleep(1);
        if ((++sp & 255u) == 0u) { if (xb_ld(&bar[XB_TMO])) break; if (sp > XB_SPIN_CAP) { atomicAdd(&bar[XB_TMO], 1u); break; } }
    }
    nloc = mine > 0u ? mine : 1u; nx = cnt > 0u ? cnt : 1u;
}

__device__ __forceinline__ void xcd_barrier(const XcdBarrier& b) {
    asm volatile("s_waitcnt vmcnt(0)" ::: "memory");
    __syncthreads();
    if (threadIdx.x == 0) {
        unsigned* bar = b.bar;
        __builtin_amdgcn_s_waitcnt(0);
        unsigned nloc = b.st[0], nx = b.st[1];
        if (nloc == 0u) { xcd_barrier_complete(bar, b.x, nloc, nx); b.st[0] = nloc; b.st[1] = nx; }
        const unsigned old = xb_add(&bar[XB_XSUB(b.x)], 1u);
        const unsigned gen = old / nloc;
        if (old + 1u == (gen + 1u) * nloc) {
            __builtin_amdgcn_fence(__ATOMIC_RELEASE, "agent");
            asm volatile("s_waitcnt vmcnt(0)" ::: "memory");
            const unsigned og = xb_add(&bar[XB_TOP], 1u);
            const unsigned tg = og / nx;
            if (og + 1u == (tg + 1u) * nx) xb_add(&bar[XB_TOPGEN], 1u);
            else XB_SPIN(xb_ld(&bar[XB_TOPGEN]) == tg, bar);
            __builtin_amdgcn_fence(__ATOMIC_ACQUIRE, "agent");
            xb_add(&bar[XB_XGEN(b.x)], 1u);
            asm volatile("s_waitcnt vmcnt(0)" ::: "memory");
        } else {
            XB_SPIN(xb_ld(&bar[XB_XGEN(b.x)]) == gen, bar);
            __builtin_amdgcn_fence(__ATOMIC_ACQUIRE, "agent");
            asm volatile("s_waitcnt vmcnt(0)" ::: "memory");
        }
    }
    __syncthreads();
}


DI unsigned attn_dequeue(unsigned* heads, unsigned xcc) {
    constexpr unsigned PER = (unsigned)NATT_UNITS / 8u;
    for (unsigned t = 0; t < 8u; ++t) { const unsigned x = (xcc + t) & 7u; const unsigned u = atomicAdd(heads + 64 * x, 1u); if (u < PER) return x * PER + u; }
    return (unsigned)NATT_UNITS;
}
__global__ void __launch_bounds__(NTHREADS, 2) hymba_fwd(Params p) {
    extern __shared__ __attribute__((aligned(16))) unsigned char lds_raw[];
    LAS unsigned char* lds = (LAS unsigned char*)lds_raw;
    const int tid = threadIdx.x, G = gridDim.x, bid = blockIdx.x;
    unsigned char* ws = p.ws;
    const int lo = p.ph_lo, hi = p.ph_hi;
#ifndef PH_MASK
#define PH_MASK 0x1ff
#endif
#define IN(k) (lo <= (k) && (k) < hi)
#define SEAM(k) do { if (IN(k) && IN((k) + 1)) { xcd_barrier(xbar); } } while (0)
    volatile LAS unsigned* xst = (volatile LAS unsigned*)(lds + WQ_OFF + 16);
    if (tid == 0) { xst[0] = 0u; xst[1] = 0u; }
    __syncthreads();
    XcdBarrier xbar = xcd_barrier_post((unsigned*)(p.ws + WS_BARW), xst);
    if (p.coop == 2) cg::this_grid().sync();
    bf16* XB = (bf16*)(ws + WS_XB); bf16* BIG = (bf16*)(ws + WS_BIG); bf16* X2B = (bf16*)(ws + WS_O);
    float* RSTD = (float*)(ws + WS_RSTD); float* SSQ = (float*)(ws + WS_SSQ); const float* LB = (const float*)(ws + WS_LB);
    if (((PH_MASK >> 0) & 1) && IN(0)) { p0_prologue(p, lds, tid, G, bid); }
    SEAM(0);
    if (((PH_MASK >> 1) & 1) && IN(1)) {
        pg8::Gemm g{XB, (const bf16*)(ws + WS_WI1), MTOK, 2 * DFF, DM}; pg8::StaticOrder S; S.init(MTOK, 2 * DFF, G, bid);
        pg8::EpiSwiglu<true> E{BIG, nullptr};
        pg8::gemm_phase<pg8::EpiSwiglu<true>, pg8::StaticOrder, true, true>(lds, g, S, E); }
    SEAM(1);
    if (((PH_MASK >> 2) & 1) && IN(2)) {
        pg8::Gemm g{BIG, (const bf16*)(ws + WS_WO1), MTOK, DM, DFF}; pg8::StaticOrder S; S.init(MTOK, DM, G, bid);
        pg8::EpiRes<0, false, true, true> E{nullptr, p.xp, p.xs, nullptr, XB, SSQ};
        pg8::gemm_phase<pg8::EpiRes<0, false, true, true>, pg8::StaticOrder, true, true>(lds, g, S, E); }
    SEAM(2);
    if (((PH_MASK >> 3) & 1) && IN(3)) {
        for (int row = bid * NTHREADS + tid; row < MTOK; row += G * NTHREADS) { const f32x4* sp = (const f32x4*)(SSQ + (size_t)row * 16); const f32x4 a = sp[0], b = sp[1], c = sp[2], d = sp[3];
            const float tot = ((a[0] + a[1]) + (a[2] + a[3])) + ((b[0] + b[1]) + (b[2] + b[3])) + ((c[0] + c[1]) + (c[2] + c[3])) + ((d[0] + d[1]) + (d[2] + d[3]));
            RSTD[row] = 1.0f / sqrtf(tot * (1.0f / DM) + EPSV); }
        xcd_barrier(xbar);
        pg8::Gemm g{XB, (const bf16*)(ws + WS_WIN), MTOK, NIN, DM}; pg8::StaticOrder S; S.init(MTOK, NIN, G, bid);
        pg8::EpiProj E{BIG, RSTD, LB, LB + HGW, p.q_norm, p.k_norm, (const float*)(ws + WS_ROPE)};
        pg8::gemm_phase<pg8::EpiProj, pg8::StaticOrder, true, true>(lds, g, S, E); }
    SEAM(3);
    if (((PH_MASK >> 4) & 1) && IN(4)) {
        hgrn_prepass(p, lds, tid, G, bid);
        xcd_barrier(xbar);
        const unsigned lds32 = (unsigned)(size_t)lds_raw;
        for (int u = bid; u < NSCAN_UNITS; u += G) scan_unit2(p, lds, lds32, u, tid);
        unsigned* cnt = (unsigned*)(ws + WS_CNT); LAS unsigned* wq = (LAS unsigned*)(lds + WQ_OFF);
        const unsigned myx = xb_xcc_id() & 7u;
        __syncthreads(); if (tid == 0) *wq = attn_dequeue(cnt, myx); __syncthreads();
        unsigned u = *wq; AttnRegs ar; if (u < (unsigned)NATT_UNITS) attn_load(p, (int)u, tid, ar);
        while (u < (unsigned)NATT_UNITS) {
            __syncthreads();
            attn_stash(lds, tid, ar);
            if (tid == 0) *wq = attn_dequeue(cnt, myx);
            __syncthreads();
            const unsigned un = *wq; if (un < (unsigned)NATT_UNITS) attn_load(p, (int)un, tid, ar);
            attn_unit(p, lds, lds32, (int)u, tid);
            u = un; } }
    SEAM(4);
    if (((PH_MASK >> 5) & 1) && IN(5)) { combine_phase(p, tid, G, bid); }
    SEAM(5);
    if (((PH_MASK >> 6) & 1) && IN(6)) {
        pg8::Gemm g{(const bf16*)p.out, (const bf16*)(ws + WS_WOUT), MTOK, DM, DM}; pg8::StaticOrder S; S.init(MTOK, DM, G, bid);
        pg8::EpiRes<1, false, true, false> E{nullptr, nullptr, nullptr, XB, X2B, SSQ};
        pg8::gemm_phase<pg8::EpiRes<1, false, true, false>, pg8::StaticOrder, true, true>(lds, g, S, E); }
    SEAM(6);
    if (((PH_MASK >> 7) & 1) && IN(7)) {
        for (int row = bid * NTHREADS + tid; row < MTOK; row += G * NTHREADS) { const f32x4* sp = (const f32x4*)(SSQ + (size_t)row * 16); const f32x4 a = sp[0], b = sp[1], c = sp[2], d = sp[3];
            const float tot = ((a[0] + a[1]) + (a[2] + a[3])) + ((b[0] + b[1]) + (b[2] + b[3])) + ((c[0] + c[1]) + (c[2] + c[3])) + ((d[0] + d[1]) + (d[2] + d[3]));
            RSTD[row] = 1.0f / sqrtf(tot * (1.0f / DM) + EPSV); }
        xcd_barrier(xbar);
        pg8::Gemm g{X2B, (const bf16*)(ws + WS_WI2), MTOK, 2 * DFF, DM}; pg8::StaticOrder S; S.init(MTOK, 2 * DFF, G, bid);
        pg8::EpiSwiglu<false> E{BIG, RSTD};
        pg8::gemm_phase<pg8::EpiSwiglu<false>, pg8::StaticOrder, true, true>(lds, g, S, E); }
    SEAM(7);
    if (((PH_MASK >> 8) & 1) && IN(8)) {
        pg8::Gemm g{BIG, (const bf16*)(ws + WS_WO2), MTOK, DM, DFF}; pg8::StaticOrder S; S.init(MTOK, DM, G, bid);
        pg8::EpiRes<1, true, false, true> E{p.out, nullptr, nullptr, X2B, nullptr, nullptr};
        pg8::gemm_phase<pg8::EpiRes<1, true, false, true>, pg8::StaticOrder, true, true>(lds, g, S, E); }
#undef IN
#undef SEAM
}

#ifndef MK_MULTI
#define MK_MULTI 0
#endif
constexpr int NPHASES = 9;
extern "C" void kernel_launch(void* const* d_in, const int* in_sizes, int n_in, void* d_out, int out_size, void* d_ws, size_t ws_size, hipStream_t stream) {
    static int grid = 0;
    if (grid == 0) {
        int dev = 0, cus = 0;
        if (hipGetDevice(&dev) != hipSuccess || hipDeviceGetAttribute(&cus, hipDeviceAttributeMultiprocessorCount, dev) != hipSuccess) { fprintf(stderr, "kernel_launch: device query failed\n"); grid = -1; return; }
        if (hipFuncSetAttribute((const void*)hymba_fwd, hipFuncAttributeMaxDynamicSharedMemorySize, LDS_BYTES) != hipSuccess) { fprintf(stderr, "kernel_launch: hipFuncSetAttribute failed\n"); grid = -1; return; }
        int per_cu = 0;
        if (hipOccupancyMaxActiveBlocksPerMultiprocessor(&per_cu, (const void*)hymba_fwd, NTHREADS, LDS_BYTES) != hipSuccess || per_cu < 1) { fprintf(stderr, "kernel_launch: occupancy query says %d blocks per CU\n", per_cu); }
        (void)hipGetLastError();
        grid = cus;
        if (n_in != 17 || ws_size < WS_END) { fprintf(stderr, "kernel_launch: unexpected n_in %d or ws_size %zu (< %zu)\n", n_in, ws_size, (size_t)WS_END); }
    }
    if (grid < 0) return;
    Params p{};
    p.xp = (const float*)d_in[0]; p.xs = (const float*)d_in[1]; p.ffn1_norm = (const float*)d_in[2]; p.ffn1_wi = (const float*)d_in[3]; p.ffn1_wo = (const float*)d_in[4];
    p.mix_norm = (const float*)d_in[5]; p.w_in = (const float*)d_in[6]; p.lb_fwd = (const float*)d_in[7]; p.lb_bwd = (const float*)d_in[8]; p.out_norm = (const float*)d_in[9];
    p.q_norm = (const float*)d_in[10]; p.k_norm = (const float*)d_in[11]; p.sink = (const float*)d_in[12]; p.w_out = (const float*)d_in[13]; p.ffn2_norm = (const float*)d_in[14];
    p.ffn2_wi = (const float*)d_in[15]; p.ffn2_wo = (const float*)d_in[16];
    p.out = (float*)d_out; p.ws = (unsigned char*)d_ws;
    for (int i = 0; i < 32; ++i) p.inv_freq_rev[i] = pow(10000.0, -(double)(2 * i) / 64.0) / 6.283185307179586476925286766559;
#if MK_MULTI
    for (int ph = 0; ph < NPHASES; ++ph) { p.ph_lo = ph; p.ph_hi = ph + 1; p.coop = 0;
        hipLaunchKernelGGL(hymba_fwd, dim3(grid), dim3(NTHREADS), LDS_BYTES, stream, p);
        const hipError_t le = hipPeekAtLastError(); if (le != hipSuccess) { fprintf(stderr, "kernel_launch: launch %d failed: %s\n", ph, hipGetErrorName(le)); break; } }
#else
    if (hipMemsetAsync((unsigned char*)d_ws + WS_BARW, 0, 16384, stream) != hipSuccess) { fprintf(stderr, "kernel_launch: hipMemsetAsync failed\n"); return; }
    p.ph_lo = 0; p.ph_hi = NPHASES; p.coop = 1;
    void* args[] = {&p};
    const hipError_t le = hipLaunchCooperativeKernel((const void*)hymba_fwd, dim3(grid), dim3(NTHREADS), args, LDS_BYTES, stream);
    if (le != hipSuccess) fprintf(stderr, "kernel_launch: cooperative launch failed: %s (grid %d)\n", hipGetErrorName(le), grid);
#endif
}
```

```cpp
#include <hip/hip_runtime.h>
#include <hip/hip_cooperative_groups.h>
#include <cstdio>
#include <cmath>
namespace cg = cooperative_groups;
constexpr int DM = 1024, SEQ = 8192, NSEQ = 10, MTOK = NSEQ * SEQ, NPROMPT = 2 * SEQ, DFF = 2816, NIN = 3328;
constexpr float EPSV = 1e-6f;
#include <hip/hip_runtime.h>
#include <cstdio>
#include <cstdint>
namespace pg8 {
#define PG8_LAS __attribute__((address_space(3)))
typedef unsigned short bf16_t;
typedef short bf16x8 __attribute__((ext_vector_type(8)));
typedef float f32x4 __attribute__((ext_vector_type(4)));
typedef unsigned u32x4 __attribute__((ext_vector_type(4)));
constexpr int BM = 256, BK = 64, HALF = 128, HTB = HALF * BK * 2  , STAGE_BYTES = 8 * HTB, NXCD = 8, WGM = 8;

__host__ __device__ __forceinline__ int lds_byte(int r, int c) { const int st = (r >> 4) * 2 + (c >> 5), rr = r & 15, cc = c & 31, ob = rr * 64 + cc * 2; return st * 1024 + (ob ^ (((ob >> 9) & 1) << 5)); }
__host__ __device__ __forceinline__ void stage_rc(int b, int& R, int& C) { const int st = b / 1024, sb = b % 1024, swz = sb ^ (((sb >> 9) & 1) << 5); R = (st >> 1) * 16 + swz / 64; C = (st & 1) * 32 + (swz % 64) / 2; }
__host__ __device__ __forceinline__ int perm32(int rho) { const int n = rho >> 4, i = rho & 15; return 8 * (i >> 2) + 4 * n + (i & 3); }

struct Unit { int pm, pn; };
struct Gemm { const bf16_t* A; const bf16_t* Bt; int M, N, K; };

struct StaticOrder {
    int nM, nN, nwg, G, c;
    __host__ __device__ void init(int M, int N, int G_, int c_) { nM = M / BM; nN = N / BM; nwg = nM * nN; G = G_; c = c_; }
    __host__ __device__ bool next(int i, Unit& u) const {
        const long L = (long)i * G + c; if (L >= nwg) return false;
        int wgid = (int)L; { const int q = nwg / NXCD, r = nwg % NXCD, xcd = wgid % NXCD, off = wgid / NXCD; wgid = (xcd < r ? xcd * (q + 1) : r * (q + 1) + (xcd - r) * q) + off; }
        const int nig = WGM * nN, gid = wgid / nig, fm = gid * WGM, gsz = (nM - fm) < WGM ? (nM - fm) : WGM;
        u.pm = fm + ((wgid % nig) % gsz); u.pn = (wgid % nig) / gsz; return true;
    }
    __device__ __forceinline__ void a_ready(const Unit&) const {}
    __device__ __forceinline__ void done(const Unit&) const {}
};

__device__ __forceinline__ unsigned cvt_pk_bf16(float lo, float hi) { unsigned r; asm volatile("v_cvt_pk_bf16_f32 %0, %1, %2" : "=v"(r) : "v"(lo), "v"(hi)); return r; }
__device__ __forceinline__ float sigmoidf_(float v) { return __builtin_amdgcn_rcpf(1.0f + __expf(-v)); }
__device__ __forceinline__ float siluf_(float v) { return v * sigmoidf_(v); }

template <bool NORMED> struct EpiSwiglu {
    static constexpr bool PERM = true, AFTER_DRAIN = false;
    bf16_t* H; const float* rstd;
    __device__ __forceinline__ void operator()(const f32x4 (&acc)[2][2][4][2], const Unit& u, int wr, int wc, int fr, int fq) const {
        const int row0 = u.pm * BM + wr * 64 + fr, col0 = u.pn * 128 + wc * 32 + 8 * fq;
        float rsv[2][4];
#pragma unroll
        for (int ai = 0; ai < 2; ++ai)
#pragma unroll
            for (int m = 0; m < 4; ++m) rsv[ai][m] = NORMED ? 1.0f : rstd[row0 + ai * HALF + m * 16];
#pragma unroll
        for (int ai = 0; ai < 2; ++ai)
#pragma unroll
            for (int m = 0; m < 4; ++m) { const int row = row0 + ai * HALF + m * 16; const float rs = rsv[ai][m];
                float hv[8];
#pragma unroll
                for (int n = 0; n < 2; ++n)
#pragma unroll
                    for (int j = 0; j < 4; ++j) { const float g = acc[ai][0][m][n][j] * rs, uu = acc[ai][1][m][n][j] * rs; hv[4 * n + j] = siluf_(g) * uu; }
                u32x4 w; w.x = cvt_pk_bf16(hv[0], hv[1]); w.y = cvt_pk_bf16(hv[2], hv[3]); w.z = cvt_pk_bf16(hv[4], hv[5]); w.w = cvt_pk_bf16(hv[6], hv[7]);
                *(u32x4*)(H + (size_t)row * DFF + col0) = w; }
    }
};
template <int RESMODE, bool OUT_F32, bool AUX, bool HALFSCALE> struct EpiRes {
    static constexpr bool PERM = true, AFTER_DRAIN = false;
    float* out; const float* xp; const float* xs; const bf16_t* resb; bf16_t* xb; float* ssq;
    __device__ __forceinline__ void operator()(const f32x4 (&acc)[2][2][4][2], const Unit& u, int wr, int wc, int fr, int fq) const {
        const int row0 = u.pm * BM + wr * 64 + fr, col0 = u.pn * BM + wc * 32 + 8 * fq;
#pragma unroll
        for (int ai = 0; ai < 2; ++ai)
#pragma unroll
            for (int m = 0; m < 4; ++m) { const int row = row0 + ai * HALF + m * 16;
                const float* resrow = (row < NPROMPT ? xp + (size_t)row * DM : xs + (size_t)(row - NPROMPT) * DM);
                float ss = 0.f;
#pragma unroll
                for (int bj = 0; bj < 2; ++bj) { const int col = col0 + bj * HALF; f32x4 r0, r1;
                    if (RESMODE == 0) { r0 = *(const f32x4*)(resrow + col); r1 = *(const f32x4*)(resrow + col + 4); }
                    else { const u32x4 w = *(const u32x4*)(resb + (size_t)row * DM + col);
                        r0 = (f32x4){__builtin_bit_cast(float, w.x << 16), __builtin_bit_cast(float, w.x & 0xffff0000u), __builtin_bit_cast(float, w.y << 16), __builtin_bit_cast(float, w.y & 0xffff0000u)};
                        r1 = (f32x4){__builtin_bit_cast(float, w.z << 16), __builtin_bit_cast(float, w.z & 0xffff0000u), __builtin_bit_cast(float, w.w << 16), __builtin_bit_cast(float, w.w & 0xffff0000u)}; }
                    const f32x4 o0 = r0 + acc[ai][bj][m][0] * (HALFSCALE ? 0.5f : 1.0f), o1 = r1 + acc[ai][bj][m][1] * (HALFSCALE ? 0.5f : 1.0f);
                    if (OUT_F32) { *(f32x4*)(out + (size_t)row * DM + col) = o0; *(f32x4*)(out + (size_t)row * DM + col + 4) = o1; }
                    else { u32x4 w; w.x = cvt_pk_bf16(o0[0], o0[1]); w.y = cvt_pk_bf16(o0[2], o0[3]); w.z = cvt_pk_bf16(o1[0], o1[1]); w.w = cvt_pk_bf16(o1[2], o1[3]); *(u32x4*)(xb + (size_t)row * DM + col) = w; }
                    if (AUX) ss += ((o0[0] * o0[0] + o0[1] * o0[1]) + (o0[2] * o0[2] + o0[3] * o0[3])) + ((o1[0] * o1[0] + o1[1] * o1[1]) + (o1[2] * o1[2] + o1[3] * o1[3])); }
                if (AUX) { ss += __shfl_xor(ss, 16); ss += __shfl_xor(ss, 32); if (fq == 0) ssq[(size_t)row * 16 + u.pn * 4 + wc] = ss; } }
    }
};
struct EpiProj {
    static constexpr bool PERM = true, AFTER_DRAIN = false;
    bf16_t* P; const float* ssq; const float* lbf; const float* lbb; const float* qn; const float* kn; const float* rope;
    __device__ __forceinline__ void operator()(const f32x4 (&acc)[2][2][4][2], const Unit& u, int wr, int wc, int fr, int fq) const {
        const int row0 = u.pm * BM + wr * 64 + fr, colw = wc * 32 + 8 * fq; const int pn = u.pn;
        float rsv[2][4];
#pragma unroll
        for (int ai = 0; ai < 2; ++ai)
#pragma unroll
            for (int m = 0; m < 4; ++m) rsv[ai][m] = ssq[row0 + ai * HALF + m * 16];
        if (pn >= 10) {
            const bool isv = (pn == 12 && wc >= 2), isq = pn < 12;
            const int cbase = isq ? 2560 + ((pn - 10) * 4 + wc) * 64 : (wc < 2 ? 3072 + wc * 64 : 3200 + (wc - 2) * 64);
            const float* gn = isq ? qn : kn; float glo[8], ghi[8];
#pragma unroll
            for (int j = 0; j < 8; ++j) { glo[j] = gn[8 * fq + j]; ghi[j] = gn[32 + 8 * fq + j]; }
#pragma unroll
            for (int ai = 0; ai < 2; ++ai)
#pragma unroll
                for (int m = 0; m < 4; ++m) { const int row = row0 + ai * HALF + m * 16;
                    const float rs = rsv[ai][m];
                    float lo[8], hi[8];
#pragma unroll
                    for (int n = 0; n < 2; ++n)
#pragma unroll
                        for (int j = 0; j < 4; ++j) { lo[4 * n + j] = acc[ai][0][m][n][j] * rs; hi[4 * n + j] = acc[ai][1][m][n][j] * rs; }
                    if (!isv) {
                        float ss = 0.f;
#pragma unroll
                        for (int j = 0; j < 8; ++j) ss += lo[j] * lo[j] + hi[j] * hi[j];
                        ss += __shfl_xor(ss, 16); ss += __shfl_xor(ss, 32);
                        const float rn = __builtin_amdgcn_rsqf(ss * (1.0f / 64.0f) + EPSV) * (isq ? 0.125f : 1.0f);
                        const float* rt = rope + (size_t)(row & (SEQ - 1)) * 64 + 8 * fq;
                        const f32x4 c0 = *(const f32x4*)(rt), c1 = *(const f32x4*)(rt + 4), n0 = *(const f32x4*)(rt + 32), n1 = *(const f32x4*)(rt + 36);
#pragma unroll
                        for (int j = 0; j < 8; ++j) { const float a = lo[j] * rn * glo[j], bb = hi[j] * rn * ghi[j], cs = (j < 4 ? c0[j] : c1[j - 4]), sn = (j < 4 ? n0[j] : n1[j - 4]); lo[j] = a * cs - bb * sn; hi[j] = bb * cs + a * sn; }
                    }
                    u32x4 w0, w1; w0.x = cvt_pk_bf16(lo[0], lo[1]); w0.y = cvt_pk_bf16(lo[2], lo[3]); w0.z = cvt_pk_bf16(lo[4], lo[5]); w0.w = cvt_pk_bf16(lo[6], lo[7]);
                    w1.x = cvt_pk_bf16(hi[0], hi[1]); w1.y = cvt_pk_bf16(hi[2], hi[3]); w1.z = cvt_pk_bf16(hi[4], hi[5]); w1.w = cvt_pk_bf16(hi[6], hi[7]);
                    *(u32x4*)(P + (size_t)row * NIN + cbase + 8 * fq) = w0; *(u32x4*)(P + (size_t)row * NIN + cbase + 32 + 8 * fq) = w1; }
            return;
        }
        const int kind = (pn < 2 || pn == 8 || pn == 9) ? 1 : ((pn >= 2 && pn < 6) ? 2 : 0);
        float lbv[2][8];
        if (kind == 2) { const float* lb = (pn < 4) ? lbf + (pn - 2) * 256 : lbb + (pn - 4) * 256;
#pragma unroll
            for (int bj = 0; bj < 2; ++bj)
#pragma unroll
                for (int j = 0; j < 8; ++j) lbv[bj][j] = lb[bj * HALF + colw + j]; }
#pragma unroll
        for (int ai = 0; ai < 2; ++ai)
#pragma unroll
            for (int m = 0; m < 4; ++m) { const int row = row0 + ai * HALF + m * 16;
                const float rs = rsv[ai][m];
#pragma unroll
                for (int bj = 0; bj < 2; ++bj) { float v[8];
#pragma unroll
                    for (int n = 0; n < 2; ++n)
#pragma unroll
                        for (int j = 0; j < 4; ++j) v[4 * n + j] = acc[ai][bj][m][n][j] * rs;
                    u32x4 w;
                    if (kind == 2) {
#pragma unroll
                        for (int j = 0; j < 8; ++j) { const float lb = lbv[bj][j]; v[j] = __logf(lb + (1.0f - lb) * sigmoidf_(v[j])); }
                        w.x = __builtin_bit_cast(unsigned, __builtin_amdgcn_cvt_pkrtz(v[0], v[1])); w.y = __builtin_bit_cast(unsigned, __builtin_amdgcn_cvt_pkrtz(v[2], v[3]));
                        w.z = __builtin_bit_cast(unsigned, __builtin_amdgcn_cvt_pkrtz(v[4], v[5])); w.w = __builtin_bit_cast(unsigned, __builtin_amdgcn_cvt_pkrtz(v[6], v[7]));
                    } else {
                        if (kind == 1) {
#pragma unroll
                            for (int j = 0; j < 8; ++j) v[j] = siluf_(v[j]); }
                        w.x = cvt_pk_bf16(v[0], v[1]); w.y = cvt_pk_bf16(v[2], v[3]); w.z = cvt_pk_bf16(v[4], v[5]); w.w = cvt_pk_bf16(v[6], v[7]); }
                    *(u32x4*)(P + (size_t)row * NIN + pn * BM + bj * HALF + colw) = w; } }
    }
};

template <class Epi, class Sched, bool ALIGN_EPI = false, bool SP2 = false>
__device__ __forceinline__ void gemm_phase(PG8_LAS unsigned char* lds, const Gemm g, const Sched& S, const Epi& E) {
    const int tid = threadIdx.x, wid = __builtin_amdgcn_readfirstlane(tid >> 6), lane = tid & 63, wr = wid >> 2, wc = wid & 3, fr = lane & 15, fq = lane >> 4;
    const int K = g.K, nt = K / BK;
    unsigned voffA[2], voffB[2];
#pragma unroll
    for (int i = 0; i < 2; ++i) { int R, C; stage_rc(tid * 16 + i * 8192, R, C); const int Rb = Epi::PERM ? ((R & ~31) + perm32(R & 31)) : R;
        voffA[i] = (unsigned)(R * K + C) * 2u; voffB[i] = (unsigned)(Rb * K + C) * 2u; }
    const size_t kstep = (size_t)(BK * 2);
    const size_t hstep = (size_t)HALF * K * 2;
    const size_t tstep = 2 * hstep;
    const unsigned ldsw = (unsigned)wid * 1024u;
    const int aoff = lds_byte(wr * 64 + fr, fq * 8), boff = lds_byte(wc * 32 + fr, fq * 8);
#define PG8_SA(b, h) (((b) * 2 + (h)) * HTB)
#define PG8_SB(b, h) ((4 + (b) * 2 + (h)) * HTB)
#define PG8_STAGE(bufoff, gbase, voff) do { _Pragma("unroll") for (int _i = 0; _i < 2; ++_i) \
        __builtin_amdgcn_global_load_lds((const unsigned*)((const char*)(gbase) + (voff)[_i]), (PG8_LAS unsigned*)(lds + (bufoff) + ldsw + _i * 8192), 16, 0, 0); } while (0)
#define PG8_LDA(dst, b, h) do { _Pragma("unroll") for (int m = 0; m < 4; ++m) _Pragma("unroll") for (int k = 0; k < 2; ++k) dst[m][k] = *(const PG8_LAS bf16x8*)(lds + PG8_SA(b, h) + aoff + m * 2048 + k * 1024); } while (0)
#define PG8_LDB(dst, b, h) do { _Pragma("unroll") for (int n = 0; n < 2; ++n) _Pragma("unroll") for (int k = 0; k < 2; ++k) dst[n][k] = *(const PG8_LAS bf16x8*)(lds + PG8_SB(b, h) + boff + n * 2048 + k * 1024); } while (0)
#define PG8_MMA(ai, bj, At, Bt) do { __builtin_amdgcn_s_setprio(1); _Pragma("unroll") for (int m = 0; m < 4; ++m) _Pragma("unroll") for (int n = 0; n < 2; ++n) _Pragma("unroll") for (int k = 0; k < 2; ++k) \
        acc[ai][bj][m][n] = __builtin_amdgcn_mfma_f32_16x16x32_bf16(Bt[n][k], At[m][k], acc[ai][bj][m][n], 0, 0, 0); __builtin_amdgcn_s_setprio(0); } while (0)
#define PG8_WAIT_V(n) asm volatile("s_waitcnt vmcnt(" #n ")" ::: "memory")
#define PG8_WAIT_L(n) asm volatile("s_waitcnt lgkmcnt(" #n ")" ::: "memory")
#define PG8_BAR __builtin_amdgcn_s_barrier()
#define PG8_SCHED __builtin_amdgcn_sched_barrier(0)
    Unit cur, nxt; int ui = 0;
    if (!S.next(0, cur)) return;
    f32x4 acc[2][2][4][2];
#pragma unroll
    for (int a = 0; a < 2; ++a)
#pragma unroll
        for (int b = 0; b < 2; ++b)
#pragma unroll
            for (int m = 0; m < 4; ++m)
#pragma unroll
                for (int n = 0; n < 2; ++n) acc[a][b][m][n] = (f32x4){0.f, 0.f, 0.f, 0.f};
    bf16x8 At[4][2], B0[2][2], B1[2][2];
    const char* cA = (const char*)g.A + (size_t)cur.pm * tstep; const char* cB = (const char*)g.Bt + (size_t)cur.pn * tstep;
    S.a_ready(cur);
    if constexpr (SP2) {
        PG8_STAGE(PG8_SB(0, 0), cB, voffB); PG8_STAGE(PG8_SB(0, 1), cB + hstep, voffB); PG8_STAGE(PG8_SA(0, 0), cA, voffA); PG8_STAGE(PG8_SA(0, 1), cA + hstep, voffA);
        if (wr == 1) PG8_BAR;
        PG8_WAIT_V(2); PG8_BAR;
        PG8_STAGE(PG8_SB(1, 0), cB + kstep, voffB); PG8_STAGE(PG8_SA(1, 0), cA + kstep, voffA); PG8_STAGE(PG8_SB(1, 1), cB + hstep + kstep, voffB);
        PG8_WAIT_V(6); PG8_BAR;
    } else {
        PG8_STAGE(PG8_SB(0, 0), cB, voffB); PG8_STAGE(PG8_SA(0, 0), cA, voffA); PG8_STAGE(PG8_SB(0, 1), cB + hstep, voffB); PG8_STAGE(PG8_SA(0, 1), cA + hstep, voffA);
        if (wr == 1) PG8_BAR;
        PG8_WAIT_V(4); PG8_BAR;
        PG8_STAGE(PG8_SB(1, 0), cB + kstep, voffB); PG8_STAGE(PG8_SA(1, 0), cA + kstep, voffA); PG8_STAGE(PG8_SB(1, 1), cB + hstep + kstep, voffB);
        PG8_WAIT_V(6); PG8_BAR;
    }
    for (;;) {
        const bool has_next = S.next(ui + 1, nxt);
        const char* nA = has_next ? (const char*)g.A + (size_t)nxt.pm * tstep : cA; const char* nB = has_next ? (const char*)g.Bt + (size_t)nxt.pn * tstep : cB;
        for (int t = 0; t < nt; t += 2) {
            const bool last = (t == nt - 2);
            const char* a1 = cA + (size_t)(t + 1) * kstep;
            const char* a2 = last ? nA : cA + (size_t)(t + 2) * kstep; const char* b2 = last ? nB : cB + (size_t)(t + 2) * kstep;
            const char* a3 = a2 + kstep; const char* b3 = b2 + kstep;
            if (last && has_next) S.a_ready(nxt);
            if constexpr (SP2) {
            PG8_LDB(B0, 0, 0); PG8_LDB(B1, 0, 1); PG8_SCHED; PG8_LDA(At, 0, 0); PG8_STAGE(PG8_SA(1, 1), a1 + hstep, voffA);
            PG8_WAIT_V(8); PG8_WAIT_L(0); PG8_BAR; PG8_MMA(0, 0, At, B0); PG8_MMA(0, 1, At, B1); PG8_BAR; PG8_SCHED;
            PG8_LDA(At, 0, 1); PG8_STAGE(PG8_SB(0, 0), b2, voffB); PG8_STAGE(PG8_SB(0, 1), b2 + hstep, voffB); PG8_STAGE(PG8_SA(0, 0), a2, voffA);
            PG8_WAIT_V(8); PG8_WAIT_L(0); PG8_BAR; PG8_MMA(1, 0, At, B0); PG8_MMA(1, 1, At, B1); PG8_BAR; PG8_SCHED;
            PG8_LDB(B0, 1, 0); PG8_LDB(B1, 1, 1); PG8_SCHED; PG8_LDA(At, 1, 0); PG8_STAGE(PG8_SA(0, 1), a2 + hstep, voffA);
            PG8_WAIT_V(8); PG8_WAIT_L(0); PG8_BAR; PG8_MMA(0, 0, At, B0); PG8_MMA(0, 1, At, B1); PG8_BAR; PG8_SCHED;
            PG8_LDA(At, 1, 1); PG8_STAGE(PG8_SB(1, 0), b3, voffB); PG8_STAGE(PG8_SB(1, 1), b3 + hstep, voffB); PG8_STAGE(PG8_SA(1, 0), a3, voffA);
            PG8_WAIT_V(8); PG8_WAIT_L(0); PG8_BAR; PG8_MMA(1, 0, At, B0); PG8_MMA(1, 1, At, B1); PG8_BAR; PG8_SCHED;
            } else {
            PG8_LDB(B0, 0, 0); PG8_SCHED; PG8_LDA(At, 0, 0); PG8_STAGE(PG8_SA(1, 1), a1 + hstep, voffA);
            PG8_WAIT_L(8); PG8_BAR; PG8_WAIT_L(0); PG8_MMA(0, 0, At, B0); PG8_BAR; PG8_SCHED;
            PG8_LDB(B1, 0, 1); PG8_STAGE(PG8_SB(0, 0), b2, voffB);
            PG8_BAR; PG8_WAIT_L(0); PG8_MMA(0, 1, At, B1); PG8_BAR;
            PG8_LDA(At, 0, 1); PG8_STAGE(PG8_SA(0, 0), a2, voffA);
            PG8_BAR; PG8_WAIT_L(0); PG8_MMA(1, 0, At, B0); PG8_BAR; PG8_SCHED;
            PG8_STAGE(PG8_SB(0, 1), b2 + hstep, voffB);
            PG8_WAIT_V(6); PG8_BAR; PG8_MMA(1, 1, At, B1); PG8_BAR;
            PG8_LDB(B0, 1, 0); PG8_SCHED; PG8_LDA(At, 1, 0); PG8_STAGE(PG8_SA(0, 1), a2 + hstep, voffA);
            PG8_WAIT_L(8); PG8_BAR; PG8_WAIT_L(0); PG8_MMA(0, 0, At, B0); PG8_BAR; PG8_SCHED;
            PG8_LDB(B1, 1, 1); PG8_STAGE(PG8_SB(1, 0), b3, voffB);
            PG8_BAR; PG8_WAIT_L(0); PG8_MMA(0, 1, At, B1); PG8_BAR;
            PG8_LDA(At, 1, 1); PG8_STAGE(PG8_SA(1, 0), a3, voffA);
            PG8_BAR; PG8_WAIT_L(0); PG8_MMA(1, 0, At, B0); PG8_BAR; PG8_SCHED;
            PG8_STAGE(PG8_SB(1, 1), b3 + hstep, voffB);
            PG8_WAIT_V(6); PG8_BAR; PG8_MMA(1, 1, At, B1); PG8_BAR;
            }
        }
        if constexpr (ALIGN_EPI) { if (wr == 0) PG8_BAR; }
        if constexpr (!Epi::AFTER_DRAIN) { E(acc, cur, wr, wc, fr, fq); S.done(cur); }
        if (!has_next) break;
#pragma unroll
        for (int a = 0; a < 2; ++a)
#pragma unroll
            for (int b = 0; b < 2; ++b)
#pragma unroll
                for (int m = 0; m < 4; ++m)
#pragma unroll
                    for (int n = 0; n < 2; ++n) acc[a][b][m][n] = (f32x4){0.f, 0.f, 0.f, 0.f};
        cur = nxt; cA = nA; cB = nB; ++ui;
        if constexpr (ALIGN_EPI) { if (wr == 1) PG8_BAR; }
    }
    PG8_WAIT_V(0);
    if constexpr (!ALIGN_EPI) { if (wr == 0) PG8_BAR; }
    PG8_BAR;
    if constexpr (Epi::AFTER_DRAIN) { E.fused(acc, cur, wr, wc, fr, fq, lds, wid, lane); S.done(cur); }
#undef PG8_SA
#undef PG8_SB
#undef PG8_STAGE
#undef PG8_LDA
#undef PG8_LDB
#undef PG8_MMA
#undef PG8_WAIT_V
#undef PG8_WAIT_L
#undef PG8_BAR
#undef PG8_SCHED
}
}

#define LAS __attribute__((address_space(3)))
#define DI __device__ __forceinline__
typedef unsigned short bf16;
typedef short bf16x8 __attribute__((ext_vector_type(8)));
typedef float f32x4 __attribute__((ext_vector_type(4)));
typedef float f32x16 __attribute__((ext_vector_type(16)));
typedef unsigned u32x4 __attribute__((ext_vector_type(4)));
typedef unsigned u32x2 __attribute__((ext_vector_type(2)));
#define MFMA32(a, b, c) __builtin_amdgcn_mfma_f32_32x32x16_bf16((a), (b), (c), 0, 0, 0)
#define LDS_WAIT() asm volatile("s_waitcnt lgkmcnt(0)" ::: "memory")

constexpr int NTHREADS = 512, NWAVES = 8;
constexpr int LDS_BYTES = 155648;
constexpr int WQ_OFF = LDS_BYTES - 64;
constexpr int HGW = 512, NATT_UNITS = NSEQ * 2 * (SEQ / 64), NSCAN_UNITS = NSEQ * 16;
constexpr size_t MiB = 1u << 20;
constexpr size_t WS_WI1 = 0, WS_WO1 = 12 * MiB, WS_WIN = 18 * MiB, WS_WOUT = 25 * MiB, WS_WI2 = 27 * MiB, WS_WO2 = 39 * MiB;
constexpr size_t WS_ROPE = 45 * MiB;
constexpr size_t WS_RSTD = 48 * MiB;
constexpr size_t WS_SSQ = 49 * MiB;
constexpr size_t WS_LB = 55 * MiB;
constexpr size_t WS_CNT = 56 * MiB;
constexpr size_t WS_BARW = 57 * MiB;
constexpr size_t WS_XB = 64 * MiB;
constexpr size_t WS_BIG = 224 * MiB;
constexpr size_t WS_O = 744 * MiB;
constexpr size_t WS_VEC = 904 * MiB;
constexpr size_t WS_PF = 920 * MiB;
constexpr size_t WS_END = 1000 * MiB;
static_assert((size_t)DM * 2 * DFF * 2 <= 12 * MiB && (size_t)DFF * DM * 2 <= 6 * MiB && (size_t)NIN * DM * 2 <= 7 * MiB, "weight map");
static_assert((size_t)MTOK * 16 * 4 <= 6 * MiB && (size_t)MTOK * DM * 2 == 160 * MiB && (size_t)MTOK * NIN * 2 <= 520 * MiB, "ws map");

struct Params {
    const float* xp; const float* xs; const float* ffn1_norm; const float* ffn1_wi; const float* ffn1_wo; const float* mix_norm; const float* w_in;
    const float* lb_fwd; const float* lb_bwd; const float* out_norm; const float* q_norm; const float* k_norm; const float* sink; const float* w_out;
    const float* ffn2_norm; const float* ffn2_wi; const float* ffn2_wo;
    float* out; unsigned char* ws;
    double inv_freq_rev[32];
    int ph_lo, ph_hi, coop, pad;
};

DI float bf2f(unsigned short b) { return __builtin_bit_cast(float, (unsigned)b << 16); }
DI float bflo(unsigned w) { return __builtin_bit_cast(float, w << 16); }
DI float bfhi(unsigned w) { return __builtin_bit_cast(float, w & 0xffff0000u); }
DI unsigned pk2(float lo, float hi) { return pg8::cvt_pk_bf16(lo, hi); }
DI unsigned short f2bf(float f) { unsigned u = __builtin_bit_cast(unsigned, f); u += 0x7fffu + ((u >> 16) & 1u); return (unsigned short)(u >> 16); }
DI float h2f(unsigned short h) { return (float)__builtin_bit_cast(_Float16, h); }
DI int crow(int reg, int h) { return (reg & 3) + 8 * (reg >> 2) + 4 * h; }
DI bf16x8 frag(const LAS unsigned char* base, int ld, int row0, int k0, int lane) { return *(const LAS bf16x8*)(base + ((row0 + (lane & 31)) * ld + k0 + 8 * (lane >> 5)) * 2); }
DI f32x16 zero16() { f32x16 z; for (int i = 0; i < 16; ++i) z[i] = 0.f; return z; }

DI void p0_transpose_item(const float* W, int K, int N, bf16* Wt, const float* gain, int perm, int item, LAS float* scr, int lane) {
    const int ntile = N / 64, nt = item % ntile, kt = item / ntile, k0 = kt * 64, n0 = nt * 64;
    int src = n0 + lane;
    if (perm == 1) { const int pn = n0 >> 8, bj = (n0 >> 7) & 1, i = n0 & 127; src = bj * DFF + pn * 128 + i + lane; }
    if (perm == 2 && n0 >= 2560) {
        const int np = n0 + lane - 2560, t = np >> 8, r = np & 255, bj = r >> 7, wc = (r >> 5) & 3, dd = r & 31;
        const int base = (t == 0) ? 2560 + wc * 64 : (t == 1) ? 2560 + (4 + wc) * 64 : (wc < 2 ? 3072 + wc * 64 : 3200 + (wc - 2) * 64);
        src = base + bj * 32 + dd; }
    float wv[64];
#pragma unroll
    for (int kk = 0; kk < 64; ++kk) wv[kk] = W[(size_t)(k0 + kk) * N + src];
    if (gain) {
#pragma unroll
        for (int kk = 0; kk < 64; kk += 4) { const f32x4 g4 = *(const f32x4*)(gain + k0 + kk); wv[kk] *= g4[0]; wv[kk + 1] *= g4[1]; wv[kk + 2] *= g4[2]; wv[kk + 3] *= g4[3]; } }
#pragma unroll
    for (int kk = 0; kk < 64; ++kk) scr[lane * 65 + kk] = wv[kk];
    LDS_WAIT();
    const int c = lane & 7;
#pragma unroll
    for (int j = 0; j < 8; ++j) { const int n = (lane >> 3) + 8 * j; const LAS float* s = scr + n * 65 + 8 * c;
        u32x4 o; o.x = pk2(s[0], s[1]); o.y = pk2(s[2], s[3]); o.z = pk2(s[4], s[5]); o.w = pk2(s[6], s[7]);
        *(u32x4*)(Wt + (size_t)(n0 + n) * K + k0 + 8 * c) = o; }
    LDS_WAIT();
}
DI void p0_prologue(const Params& p, LAS unsigned char* lds, int tid, int G, int bid) {
    const int lane = tid & 63, wave = tid >> 6, gw = bid * NWAVES + wave, NGW = G * NWAVES;
    unsigned char* ws = p.ws;
    LAS float* scr = (LAS float*)(lds + wave * 16640);
    constexpr int I_WI = (DM / 64) * (2 * DFF / 64), I_WO = (DFF / 64) * (DM / 64), I_IN = (DM / 64) * (NIN / 64), I_OUT = (DM / 64) * (DM / 64);
    constexpr int NITEMS = 2 * I_WI + 2 * I_WO + I_IN + I_OUT;
    for (int it = gw; it < NITEMS; it += NGW) {
        int r = it;
        if (r < I_WI) { p0_transpose_item(p.ffn1_wi, DM, 2 * DFF, (bf16*)(ws + WS_WI1), p.ffn1_norm, 1, r, scr, lane); continue; } r -= I_WI;
        if (r < I_WI) { p0_transpose_item(p.ffn2_wi, DM, 2 * DFF, (bf16*)(ws + WS_WI2), p.ffn2_norm, 1, r, scr, lane); continue; } r -= I_WI;
        if (r < I_WO) { p0_transpose_item(p.ffn1_wo, DFF, DM, (bf16*)(ws + WS_WO1), nullptr, 0, r, scr, lane); continue; } r -= I_WO;
        if (r < I_WO) { p0_transpose_item(p.ffn2_wo, DFF, DM, (bf16*)(ws + WS_WO2), nullptr, 0, r, scr, lane); continue; } r -= I_WO;
        if (r < I_IN) { p0_transpose_item(p.w_in, DM, NIN, (bf16*)(ws + WS_WIN), p.mix_norm, 2, r, scr, lane); continue; } r -= I_IN;
        p0_transpose_item(p.w_out, DM, DM, (bf16*)(ws + WS_WOUT), nullptr, 0, r, scr, lane);
    }
    bf16* XB = (bf16*)(ws + WS_XB); float* RSTD = (float*)(ws + WS_RSTD);
    const int RPW = (MTOK + NGW - 1) / NGW;
    for (int row0_ = gw * RPW; row0_ < min((gw + 1) * RPW, MTOK); row0_ += 8) {
        f32x4 v[8][4]; bool on[8];
#pragma unroll
        for (int u = 0; u < 8; ++u) { const int row = row0_ + u; on[u] = row < min((gw + 1) * RPW, MTOK); const int rr = on[u] ? row : row0_;
            const float* xr = (rr < NPROMPT) ? p.xp + (size_t)rr * DM : p.xs + (size_t)(rr - NPROMPT) * DM;
#pragma unroll
            for (int j = 0; j < 4; ++j) v[u][j] = *(const f32x4*)(xr + 4 * lane + 256 * j); }
#pragma unroll
        for (int u = 0; u < 8; ++u) { if (!on[u]) continue; const int row = row0_ + u; float s = 0.f;
#pragma unroll
            for (int j = 0; j < 4; ++j) s += (v[u][j][0] * v[u][j][0] + v[u][j][1] * v[u][j][1]) + (v[u][j][2] * v[u][j][2] + v[u][j][3] * v[u][j][3]);
#pragma unroll
            for (int o = 32; o >= 1; o >>= 1) s += __shfl_xor(s, o);
            const float rsx = 1.0f / sqrtf(s * (1.0f / DM) + EPSV);
#pragma unroll
            for (int j = 0; j < 4; ++j) { u32x2 w; w.x = pk2(v[u][j][0] * rsx, v[u][j][1] * rsx); w.y = pk2(v[u][j][2] * rsx, v[u][j][3] * rsx); *(u32x2*)(XB + (size_t)row * DM + 4 * lane + 256 * j) = w; } }
    }
    float* ROPE = (float*)(ws + WS_ROPE);
    for (int i = bid * NTHREADS + tid; i < SEQ * 32; i += G * NTHREADS) { const int pos = i >> 5, fi = i & 31;
        const double rev = (double)pos * p.inv_freq_rev[fi]; const float fr = (float)(rev - rint(rev));
        ROPE[pos * 64 + fi] = __builtin_amdgcn_cosf(fr); ROPE[pos * 64 + 32 + fi] = __builtin_amdgcn_sinf(fr); }
    if (bid == 0) { float* LB = (float*)(ws + WS_LB);
        for (int c = tid; c < 2 * HGW; c += NTHREADS) { const float* a = (c < HGW) ? p.lb_fwd : p.lb_bwd; const int cc = c & (HGW - 1); LB[c] = 1.0f / (1.0f + expf(a[HGW + cc] - a[cc])); }
        if (tid < 8) *((unsigned*)(ws + WS_CNT) + 64 * tid) = 0u; }
}

typedef short s16x4 __attribute__((ext_vector_type(4)));
DI bf16x8 frag_tr(unsigned img, int ld, int s0, int c0, int lane) {
    const int i16 = lane & 15, q = i16 >> 2, pp = i16 & 3, blk = (lane >> 4) & 1, h = lane >> 5;
    const unsigned a0 = img + (unsigned)(((s0 + 8 * h + q) * ld + c0 + 16 * blk + 4 * pp) * 2), a1 = a0 + (unsigned)(8 * ld);
    s16x4 lo, hi;
    asm volatile("ds_read_b64_tr_b16 %0, %2\n\tds_read_b64_tr_b16 %1, %3\n\ts_waitcnt lgkmcnt(0)" : "=&v"(lo), "=&v"(hi) : "v"(a0), "v"(a1) : "memory");
    return __builtin_shufflevector(lo, hi, 0, 1, 2, 3, 4, 5, 6, 7);
}
template <int LD> DI void frag_tr4(bf16x8 (&f)[4], unsigned img, int s0, int c0, int lane) {
    const int i16 = lane & 15, q = i16 >> 2, pp = i16 & 3, blk = (lane >> 4) & 1, h = lane >> 5;
    const unsigned a0 = img + (unsigned)(((s0 + 8 * h + q) * LD + c0 + 16 * blk + 4 * pp) * 2);
    s16x4 r0, r1, r2, r3, r4, r5, r6, r7;
    asm volatile("ds_read_b64_tr_b16 %0, %8\n\tds_read_b64_tr_b16 %1, %8 offset:%9\n\tds_read_b64_tr_b16 %2, %8 offset:%10\n\tds_read_b64_tr_b16 %3, %8 offset:%11\n\t"
                 "ds_read_b64_tr_b16 %4, %8 offset:%12\n\tds_read_b64_tr_b16 %5, %8 offset:%13\n\tds_read_b64_tr_b16 %6, %8 offset:%14\n\tds_read_b64_tr_b16 %7, %8 offset:%15\n\ts_waitcnt lgkmcnt(0)"
                 : "=&v"(r0), "=&v"(r1), "=&v"(r2), "=&v"(r3), "=&v"(r4), "=&v"(r5), "=&v"(r6), "=&v"(r7)
                 : "v"(a0), "i"(8 * LD), "i"(32 * LD), "i"(40 * LD), "i"(64 * LD), "i"(72 * LD), "i"(96 * LD), "i"(104 * LD) : "memory");
    f[0] = __builtin_shufflevector(r0, r1, 0, 1, 2, 3, 4, 5, 6, 7); f[1] = __builtin_shufflevector(r2, r3, 0, 1, 2, 3, 4, 5, 6, 7);
    f[2] = __builtin_shufflevector(r4, r5, 0, 1, 2, 3, 4, 5, 6, 7); f[3] = __builtin_shufflevector(r6, r7, 0, 1, 2, 3, 4, 5, 6, 7);
}
constexpr int PP_Q = 0, PP_LF = 17408, PP_LB = 34816, PP_QB = 52224, PP_TOT = 69632, PP_PF = 73728, PP_PB = 82944;
DI void hgrn_prepass(const Params& p, LAS unsigned char* lds, int tid, int G, int bid) {
    bf16* PR = (bf16*)(p.ws + WS_BIG); bf16* QEB = (bf16*)p.out + (size_t)MTOK * DM; float* VEC = (float*)(p.ws + WS_VEC);
    const int r_a = tid >> 4, c_a = tid & 15, k = tid & 127, tq = tid >> 7;
    LAS float* TOT = (LAS float*)(lds + PP_TOT);
    u32x4 q0, q1, f0, f1, b0, b1;
#define PP_LOAD(u) do { const size_t rb = (size_t)((u) >> 2) * 64; const int hc = ((u) & 3) * 128 + 8 * c_a; const bf16* ra = PR + (rb + r_a) * NIN + hc; const bf16* rc = PR + (rb + r_a + 32) * NIN + hc; \
        q0 = *(const u32x4*)(ra); f0 = *(const u32x4*)(ra + 512); b0 = *(const u32x4*)(ra + 1024); q1 = *(const u32x4*)(rc); f1 = *(const u32x4*)(rc + 512); b1 = *(const u32x4*)(rc + 1024); } while (0)
    int unit = bid;
    if (unit < NSEQ * 128 * 4) PP_LOAD(unit);
    for (; unit < NSEQ * 128 * 4; unit += G) {
        { const int o0 = (r_a * 136 + 8 * c_a) * 2, o1 = ((r_a + 32) * 136 + 8 * c_a) * 2;
          *(LAS u32x4*)(lds + PP_Q + o0) = q0; *(LAS u32x4*)(lds + PP_Q + o1) = q1; *(LAS u32x4*)(lds + PP_LF + o0) = f0; *(LAS u32x4*)(lds + PP_LF + o1) = f1; *(LAS u32x4*)(lds + PP_LB + o0) = b0; *(LAS u32x4*)(lds + PP_LB + o1) = b1; }
        if (unit + G < NSEQ * 128 * 4) PP_LOAD(unit + G);
        __syncthreads();
        float q[16], lff[16], lfb[16], blf[16], blb[16];
#pragma unroll
        for (int i = 0; i < 16; ++i) { const int o = ((16 * tq + i) * 136 + k) * 2; q[i] = bf2f(*(const LAS unsigned short*)(lds + PP_Q + o)); lff[i] = h2f(*(const LAS unsigned short*)(lds + PP_LF + o)); lfb[i] = h2f(*(const LAS unsigned short*)(lds + PP_LB + o)); }
        { float run = 0.f;
#pragma unroll
          for (int i = 0; i < 16; ++i) { run += lff[i]; blf[i] = run; }
          TOT[tq * 128 + k] = run; run = 0.f;
#pragma unroll
          for (int i = 15; i >= 0; --i) { run += lfb[i]; blb[i] = run; }
          TOT[512 + tq * 128 + k] = run; }
        __syncthreads();
        { const float t0 = TOT[k], t1 = TOT[128 + k], t2 = TOT[256 + k], t3 = TOT[384 + k], u0 = TOT[512 + k], u1 = TOT[640 + k], u2 = TOT[768 + k], u3 = TOT[896 + k];
          const float offf = (tq > 0 ? t0 : 0.f) + (tq > 1 ? t1 : 0.f) + (tq > 2 ? t2 : 0.f), offb = (tq < 3 ? u3 : 0.f) + (tq < 2 ? u2 : 0.f) + (tq < 1 ? u1 : 0.f);
          const float bmid = t0 + t1, bmidb = u2 + u3;
#pragma unroll
          for (int i = 0; i < 16; ++i) { const int o = ((16 * tq + i) * 136 + k) * 2;
              const float bbf = blf[i] + offf, bbb = blb[i] + offb;
              const float qef = q[i] * __expf(bbf - bmid), kef = (1.0f - __expf(lff[i])) * __expf(bmid - bbf), qeb = q[i] * __expf(bbb - bmidb), keb = (1.0f - __expf(lfb[i])) * __expf(bmidb - bbb);
              const unsigned w1 = pk2(qef, kef), w2 = pk2(keb, qeb);
              *(LAS unsigned short*)(lds + PP_Q + o) = (unsigned short)(w1 & 0xffffu); *(LAS unsigned short*)(lds + PP_LF + o) = (unsigned short)(w1 >> 16); *(LAS unsigned short*)(lds + PP_LB + o) = (unsigned short)(w2 & 0xffffu); *(LAS unsigned short*)(lds + PP_QB + o) = (unsigned short)(w2 >> 16); }
          if (tq == 0) { float* vf = VEC + (size_t)(unit * 2) * 384; vf[k] = __expf(bmid); vf[128 + k] = __expf((t0 + t1) + (t2 + t3)); vf[256 + k] = __expf(t2 + t3);
                         vf[384 + k] = __expf(bmidb); vf[512 + k] = __expf((u0 + u1) + (u2 + u3)); vf[640 + k] = __expf(u0 + u1); } }
        __syncthreads();
        { const int wv_ = tid >> 6, ln_ = tid & 63, hh_ = ln_ >> 5, lr_ = ln_ & 31;
          if (wv_ < 6) { const int d_ = wv_ >= 3, w_ = wv_ - 3 * d_; const int ati = d_ ? (w_ > 1) : (w_ > 0), asi = d_ ? (w_ > 0) : (w_ > 1);
              const LAS unsigned char* qi_ = lds + (d_ ? PP_QB : PP_Q); const LAS unsigned char* ki_ = lds + (d_ ? PP_LB : PP_LF); f32x16 a_ = zero16();
#pragma unroll
              for (int ks = 0; ks < 8; ++ks) a_ = MFMA32(frag(ki_, 136, asi * 32, ks * 16, ln_), frag(qi_, 136, ati * 32, ks * 16, ln_), a_);
              const int t_ = ati * 32 + lr_;
#pragma unroll
              for (int g = 0; g < 4; ++g) { float v_[4];
#pragma unroll
                  for (int j = 0; j < 4; ++j) { const int s_ = asi * 32 + 8 * g + 4 * hh_ + j; const bool keep = d_ ? (s_ >= t_) : (s_ <= t_); v_[j] = keep ? a_[4 * g + j] : 0.f; }
                  u32x2 w_2; w_2.x = pk2(v_[0], v_[1]); w_2.y = pk2(v_[2], v_[3]); *(LAS u32x2*)(lds + (d_ ? PP_PB : PP_PF) + (t_ * 72 + asi * 32 + 8 * g + 4 * hh_) * 2) = w_2; } } }
        __syncthreads();
        { const size_t rb = (size_t)(unit >> 2) * 64; const int hh = unit & 3, hc = hh * 128 + 8 * c_a; const int o0 = (r_a * 136 + 8 * c_a) * 2, o1 = ((r_a + 32) * 136 + 8 * c_a) * 2;
          bf16* ra = PR + (rb + r_a) * NIN + hc; bf16* rc = PR + (rb + r_a + 32) * NIN + hc;
          *(u32x4*)(ra) = *(const LAS u32x4*)(lds + PP_Q + o0); *(u32x4*)(rc) = *(const LAS u32x4*)(lds + PP_Q + o1);
          *(u32x4*)(ra + 512) = *(const LAS u32x4*)(lds + PP_LF + o0); *(u32x4*)(rc + 512) = *(const LAS u32x4*)(lds + PP_LF + o1);
          *(u32x4*)(ra + 1024) = *(const LAS u32x4*)(lds + PP_LB + o0); *(u32x4*)(rc + 1024) = *(const LAS u32x4*)(lds + PP_LB + o1);
          *(u32x4*)(QEB + (rb + r_a) * HGW + hc) = *(const LAS u32x4*)(lds + PP_QB + o0); *(u32x4*)(QEB + (rb + r_a + 32) * HGW + hc) = *(const LAS u32x4*)(lds + PP_QB + o1);
          { const int pr_ = tid >> 3, pc_ = tid & 7; bf16* PF_ = (bf16*)(p.ws + WS_PF) + (size_t)unit * 4096; bf16* PB_ = (bf16*)p.out + (size_t)MTOK * DM + (size_t)MTOK * HGW + (size_t)unit * 4096;
            *(u32x4*)(PF_ + pr_ * 64 + 8 * pc_) = *(const LAS u32x4*)(lds + PP_PF + (pr_ * 72 + 8 * pc_) * 2); *(u32x4*)(PB_ + pr_ * 64 + 8 * pc_) = *(const LAS u32x4*)(lds + PP_PB + (pr_ * 72 + 8 * pc_) * 2); } }
        __syncthreads();
    }
#undef PP_LOAD
}

constexpr int S2_QE = 0, S2_KE = 17408, S2_V = 34816, S2_PB = 44032, S2_BUF = 53248, S2_ST = 106496  , S2_VECR = 141312  ;
DI void scan_unit2(const Params& p, LAS unsigned char* lds, unsigned lds32, int unit, int tid) {
    const int lane = tid & 63, wave = tid >> 6, h = lane >> 5, lr = lane & 31;
    const int b = unit >> 4, rem = unit & 15, hh = rem >> 2, dir = (rem >> 1) & 1, vh = rem & 1;
    const bf16* PR = (const bf16*)(p.ws + WS_BIG); const bf16* QEB = (const bf16*)p.out + (size_t)MTOK * DM; const float* VEC = (const float*)(p.ws + WS_VEC);
    const bf16* PIM = dir ? (const bf16*)p.out + (size_t)MTOK * DM + (size_t)MTOK * HGW : (const bf16*)(p.ws + WS_PF);
    bf16* OUT = (bf16*)(p.ws + WS_O) + (dir ? (size_t)MTOK * HGW : 0);
    const int colo = hh * 128 + vh * 64;
    const bf16* qsrc = dir ? QEB + hh * 128 : PR + hh * 128; const size_t qstride = dir ? HGW : NIN;
    const bf16* ksrc = PR + (dir ? 1024 : 512) + hh * 128; const bf16* vsrc = PR + 1536 + hh * 128 + vh * 64;
    for (int i = tid; i < 2 * 17408 / 4; i += NTHREADS) ((LAS unsigned*)(lds + S2_ST))[i] = 0u;
    f32x16 st0 = zero16(), st1 = zero16();
    const int r_a = tid >> 4, c_a = tid & 15, r_v = tid >> 3, c_v = tid & 7;
    const int ki = wave & 3, kc = ki * 32 + lr, ti = (wave - 4) >> 1, vi = (wave - 4) & 1;
    u32x4 pq0, pq1, pk0, pk1, pv, pp, pvec = (u32x4){0u, 0u, 0u, 0u};
#define S2_CH(i) (dir ? (SEQ / 64 - 1 - (i)) : (i))
#define S2_ROW0(i) ((size_t)b * SEQ + (size_t)S2_CH(i) * 64)
#define S2_VEC(i) (VEC + (size_t)((((b * 128 + S2_CH(i)) * 4 + hh) * 2 + dir)) * 384)
#define S2_LOAD(i) do { const size_t rb = S2_ROW0(i); pq0 = *(const u32x4*)(qsrc + (rb + r_a) * qstride + 8 * c_a); pq1 = *(const u32x4*)(qsrc + (rb + r_a + 32) * qstride + 8 * c_a); \
        pk0 = *(const u32x4*)(ksrc + (rb + r_a) * NIN + 8 * c_a); pk1 = *(const u32x4*)(ksrc + (rb + r_a + 32) * NIN + 8 * c_a); pv = *(const u32x4*)(vsrc + (rb + r_v) * NIN + 8 * c_v); \
        pp = *(const u32x4*)(PIM + (size_t)((b * 128 + S2_CH(i)) * 4 + hh) * 4096 + r_v * 64 + 8 * c_v); } while (0)
#define S2_STASH(bf) do { LAS unsigned char* bb_ = lds + (bf) * S2_BUF; *(LAS u32x4*)(bb_ + S2_QE + (r_a * 136 + 8 * c_a) * 2) = pq0; *(LAS u32x4*)(bb_ + S2_QE + ((r_a + 32) * 136 + 8 * c_a) * 2) = pq1; \
        *(LAS u32x4*)(bb_ + S2_KE + (r_a * 136 + 8 * c_a) * 2) = pk0; *(LAS u32x4*)(bb_ + S2_KE + ((r_a + 32) * 136 + 8 * c_a) * 2) = pk1; *(LAS u32x4*)(bb_ + S2_V + (r_v * 72 + 8 * c_v) * 2) = pv; \
        *(LAS u32x4*)(bb_ + S2_PB + (r_v * 72 + 8 * c_v) * 2) = pp; } while (0)
#define S2_VLOAD(i) do { if (tid < 96) pvec = *(const u32x4*)(S2_VEC(i) + 4 * tid); } while (0)
#define S2_VSTASH(slot) do { if (tid < 96) *(LAS u32x4*)(lds + S2_VECR + (slot) * 1536 + 16 * tid) = pvec; } while (0)
    S2_LOAD(0); S2_VLOAD(0); S2_STASH(0); S2_VSTASH(0); S2_VLOAD(1); S2_VSTASH(1); S2_LOAD(1); S2_VLOAD(2);
    int sl0 = 0, sl1 = 1, sl2 = 2;
    for (int i = 0; i < SEQ / 64; ++i) {
        const int cur = i & 1; const LAS unsigned char* bufc = lds + cur * S2_BUF; const unsigned buf32 = lds32 + (unsigned)(cur * S2_BUF);
        const LAS unsigned char* stc = lds + S2_ST + cur * 17408; LAS unsigned char* stn = lds + S2_ST + (cur ^ 1) * 17408;
        __syncthreads();
        if (i + 1 < SEQ / 64) S2_STASH(cur ^ 1);
        if (i + 2 < SEQ / 64) { S2_VSTASH(sl2); S2_LOAD(i + 2); }
        if (i + 3 < SEQ / 64) S2_VLOAD(i + 3);
        if (wave >= 4) { f32x16 oacc = zero16(), o2 = zero16();
            { bf16x8 fa[8], fb[8];
#pragma unroll
              for (int ks = 0; ks < 8; ++ks) { fa[ks] = frag(stc, 136, vi * 32, ks * 16, lane); fb[ks] = frag(bufc + S2_QE, 136, ti * 32, ks * 16, lane); }
              __builtin_amdgcn_sched_barrier(0);
#pragma unroll
              for (int ks = 0; ks < 8; ks += 2) { oacc = MFMA32(fa[ks], fb[ks], oacc); o2 = MFMA32(fa[ks + 1], fb[ks + 1], o2); } }
            bf16x8 vf[4]; frag_tr4<72>(vf, buf32 + S2_V, 0, vi * 32, lane);
            const int ks0 = dir ? 2 * ti : 0, ks1 = dir ? 4 : 2 * (ti + 1); u32x4 pfr[4];
#pragma unroll
            for (int ks = 0; ks < 4; ++ks) { pfr[ks] = __builtin_bit_cast(u32x4, frag(bufc + S2_PB, 72, ti * 32, ks * 16, lane)); }
            __builtin_amdgcn_sched_barrier(0);
#pragma unroll
            for (int ks = 0; ks < 4; ks += 2) {
#pragma unroll
                for (int kk = 0; kk < 2; ++kk) { const bool on = (ks + kk >= ks0 && ks + kk < ks1); u32x4 pw_ = pfr[ks + kk]; pw_.x = on ? pw_.x : 0u; pw_.y = on ? pw_.y : 0u; pw_.z = on ? pw_.z : 0u; pw_.w = on ? pw_.w : 0u;
                    if (kk == 0) oacc = MFMA32(vf[ks + kk], __builtin_bit_cast(bf16x8, pw_), oacc); else o2 = MFMA32(vf[ks + kk], __builtin_bit_cast(bf16x8, pw_), o2); } }
#pragma unroll
            for (int r = 0; r < 16; ++r) oacc[r] += o2[r];
            bf16* op = OUT + (S2_ROW0(i) + ti * 32 + lr) * HGW + colo + vi * 32 + 4 * h;
#pragma unroll
            for (int g = 0; g < 4; ++g) { u32x2 w; w.x = (unsigned)f2bf(oacc[4 * g]) | ((unsigned)f2bf(oacc[4 * g + 1]) << 16); w.y = (unsigned)f2bf(oacc[4 * g + 2]) | ((unsigned)f2bf(oacc[4 * g + 3]) << 16); *(u32x2*)(op + 8 * g) = w; }
        }
        else { const LAS float* vc_ = (const LAS float*)(lds + S2_VECR + sl0 * 1536); const float dk_c = vc_[128 + kc], c2_c = vc_[256 + kc], em_n = ((const LAS float*)(lds + S2_VECR + sl1 * 1536))[kc];
          bf16x8 kf[4], v0[4]; frag_tr4<136>(kf, buf32 + S2_KE, 0, ki * 32, lane); frag_tr4<72>(v0, buf32 + S2_V, 0, 0, lane);
          { f32x16 u0 = zero16();
#pragma unroll
            for (int ks = 0; ks < 4; ++ks) u0 = MFMA32(v0[ks], kf[ks], u0);
            frag_tr4<72>(v0, buf32 + S2_V, 0, 32, lane);
#pragma unroll
            for (int r = 0; r < 16; ++r) { st0[r] = st0[r] * dk_c + c2_c * u0[r]; *(LAS unsigned short*)(stn + (crow(r, h) * 136 + kc) * 2) = f2bf(st0[r] * em_n); } }
          { f32x16 u1 = zero16();
#pragma unroll
            for (int ks = 0; ks < 4; ++ks) u1 = MFMA32(v0[ks], kf[ks], u1);
#pragma unroll
            for (int r = 0; r < 16; ++r) { st1[r] = st1[r] * dk_c + c2_c * u1[r]; *(LAS unsigned short*)(stn + ((32 + crow(r, h)) * 136 + kc) * 2) = f2bf(st1[r] * em_n); } } }
        { const int t_ = sl0; sl0 = sl1; sl1 = sl2; sl2 = t_; }
    }
    __syncthreads();
#undef S2_CH
#undef S2_ROW0
#undef S2_VEC
#undef S2_LOAD
#undef S2_VLOAD
#undef S2_VSTASH
#undef S2_STASH
}

DI void attn_prepass(const Params& p, int tid, int G, int bid) {
    bf16* PR = (bf16*)(p.ws + WS_BIG); const float* ROPE = (const float*)(p.ws + WS_ROPE);
    const int c = tid & 7; const unsigned total = (unsigned)MTOK * 10u * 8u, stride = (unsigned)G * NTHREADS;
    const f32x4 qg0 = *(const f32x4*)(p.q_norm + 8 * c), qg1 = *(const f32x4*)(p.q_norm + 8 * c + 4), kg0 = *(const f32x4*)(p.k_norm + 8 * c), kg1 = *(const f32x4*)(p.k_norm + 8 * c + 4);
    for (unsigned base = (unsigned)bid * NTHREADS; base < total; base += 4u * stride) {
        bf16* ptr[4]; u32x4 w[4]; f32x4 c0[4], c1[4], s0[4], s1[4]; int hvv[4]; bool on[4];
#pragma unroll
        for (int u = 0; u < 4; ++u) { const unsigned bu = base + (unsigned)u * stride; on[u] = bu < total; const unsigned hvi = ((on[u] ? bu : base) + (unsigned)tid) >> 3;
            const int row = (int)(hvi / 10u), hv = (int)(hvi - (unsigned)row * 10u), pos = row & (SEQ - 1); hvv[u] = hv;
            ptr[u] = PR + (size_t)row * NIN + (hv < 8 ? 2560 + hv * 64 : 3072 + (hv - 8) * 64) + 8 * c; w[u] = *(const u32x4*)ptr[u];
            const float* rt = ROPE + pos * 64 + 8 * (c & 3); c0[u] = *(const f32x4*)(rt); c1[u] = *(const f32x4*)(rt + 4); s0[u] = *(const f32x4*)(rt + 32); s1[u] = *(const f32x4*)(rt + 36); }
#pragma unroll
        for (int u = 0; u < 4; ++u) { if (!on[u]) continue;
            const int hv = hvv[u];
            float x[8] = {bflo(w[u].x), bfhi(w[u].x), bflo(w[u].y), bfhi(w[u].y), bflo(w[u].z), bfhi(w[u].z), bflo(w[u].w), bfhi(w[u].w)};
            float ss = 0.f;
#pragma unroll
            for (int j = 0; j < 8; ++j) ss += x[j] * x[j];
            ss += __shfl_xor(ss, 1); ss += __shfl_xor(ss, 2); ss += __shfl_xor(ss, 4);
            const float rs = __builtin_amdgcn_rsqf(ss * (1.0f / 64.0f) + EPSV) * (hv < 8 ? 0.125f : 1.0f);
            float y[8];
#pragma unroll
            for (int j = 0; j < 8; ++j) { const float gq = (j < 4 ? qg0[j] : qg1[j - 4]), gk = (j < 4 ? kg0[j] : kg1[j - 4]); x[j] = x[j] * rs * (hv < 8 ? gq : gk); }
#pragma unroll
            for (int j = 0; j < 8; ++j) { const float pr = __shfl_xor(x[j], 4); const float cs = (j < 4 ? c0[u][j] : c1[u][j - 4]), sn = (j < 4 ? s0[u][j] : s1[u][j - 4]); y[j] = (c < 4) ? (x[j] * cs - pr * sn) : (x[j] * cs + pr * sn); }
            u32x4 o; o.x = pk2(y[0], y[1]); o.y = pk2(y[2], y[3]); o.z = pk2(y[4], y[5]); o.w = pk2(y[6], y[7]);
            *(u32x4*)ptr[u] = o; }
    }
}
constexpr int AT_KS = 0, AT_VS = 46080, AT_PW = 92160;
struct AttnRegs { u32x4 kw[5], vw[5]; };
DI void attn_load(const Params& p, int unit, int tid, AttnRegs& r) {
    const int b = unit >> 8, g = (unit >> 7) & 1, qb = unit & 127, key0 = qb * 64 - 128;
    const bf16* PR = (const bf16*)(p.ws + WS_BIG);
#pragma unroll
    for (int it = 0; it < 5; ++it) { const int item = tid + it * NTHREADS, kk = item >> 3, c = item & 7, pos = key0 + kk; const bool valid = pos >= 0 && pos < SEQ; const int pc = valid ? pos : 0;
        const bf16* rp = PR + ((size_t)b * SEQ + pc) * NIN + g * 64 + 8 * c; r.kw[it] = *(const u32x4*)(rp + 3072); r.vw[it] = *(const u32x4*)(rp + 3200);
        if (!valid) { r.kw[it] = (u32x4){0u, 0u, 0u, 0u}; r.vw[it] = r.kw[it]; } }
}
DI void attn_stash(LAS unsigned char* lds, int tid, const AttnRegs& r) {
#pragma unroll
    for (int it = 0; it < 5; ++it) { const int item = tid + it * NTHREADS, kk = item >> 3, c = item & 7;
        *(LAS u32x4*)(lds + AT_KS + (kk * 72 + 8 * c) * 2) = r.kw[it]; *(LAS u32x4*)(lds + AT_VS + (kk * 72 + 8 * c) * 2) = r.vw[it]; }
}
DI void attn_unit(const Params& p, LAS unsigned char* lds, unsigned lds32, int unit, int tid) {
    const int lane = tid & 63, wave = tid >> 6, h = lane >> 5, lr = lane & 31;
    const int b = unit >> 8, g = (unit >> 7) & 1, qb = unit & 127, q0 = qb * 64, key0 = q0 - 128;
    const bf16* PR = (const bf16*)(p.ws + WS_BIG);
    bf16* MIX = (bf16*)p.out;
    const int hd = wave >> 1, qs = wave & 1, head = g * 4 + hd, qpos = q0 + 32 * qs + lr; const size_t qrow = (size_t)b * SEQ + qpos;
    bf16x8 qf[4];
#pragma unroll
    for (int s = 0; s < 4; ++s) qf[s] = __builtin_bit_cast(bf16x8, *(const u32x4*)(PR + qrow * NIN + 2560 + head * 64 + 8 * h + 16 * s));
    float m = p.sink[head], l = 1.0f; f32x16 o0 = zero16(), o1 = zero16();
    const LAS unsigned char* pw = lds + AT_PW + wave * 4608;
    for (int c = 0; c < 5; ++c) { const int kb = 64 * c, kp0 = key0 + kb;
        if (kp0 + 63 < 0 || kp0 >= SEQ) continue;
        f32x16 s0 = zero16(), s1 = zero16(); bf16x8 ka_[4], kb_[4];
#pragma unroll
        for (int s = 0; s < 4; ++s) { ka_[s] = frag(lds + AT_KS, 72, kb, 16 * s, lane); kb_[s] = frag(lds + AT_KS, 72, kb + 32, 16 * s, lane); }
        __builtin_amdgcn_sched_barrier(0);
#pragma unroll
        for (int s = 0; s < 4; ++s) { s0 = MFMA32(ka_[s], qf[s], s0); s1 = MFMA32(kb_[s], qf[s], s1); }
        float cmax = -INFINITY;
        if (c == 0 || c == 4 || kp0 < 0 || kp0 + 63 >= SEQ) {
#pragma unroll
            for (int i = 0; i < 16; ++i) { const int ka = kp0 + crow(i, h), kc = ka + 32;
                const bool va = ka >= 0 && ka < SEQ && ka >= qpos - 128 && ka <= qpos + 128, vc = kc >= 0 && kc < SEQ && kc >= qpos - 128 && kc <= qpos + 128;
                s0[i] = va ? s0[i] : -INFINITY; s1[i] = vc ? s1[i] : -INFINITY; }
        }
#pragma unroll
        for (int i = 0; i < 16; ++i) cmax = fmaxf(cmax, fmaxf(s0[i], s1[i]));
        cmax = fmaxf(cmax, __shfl_xor(cmax, 32));
        const float mn = fmaxf(m, cmax), alpha = __expf(m - mn); m = mn;
        float ps = 0.f;
#pragma unroll
        for (int i = 0; i < 16; ++i) { s0[i] = __expf(s0[i] - mn); s1[i] = __expf(s1[i] - mn); ps += s0[i] + s1[i]; }
        ps += __shfl_xor(ps, 32); l = l * alpha + ps;
#pragma unroll
        for (int i = 0; i < 16; ++i) { o0[i] *= alpha; o1[i] *= alpha; }
#pragma unroll
        for (int gq = 0; gq < 4; ++gq) { u32x2 w; w.x = pk2(s0[4 * gq], s0[4 * gq + 1]); w.y = pk2(s0[4 * gq + 2], s0[4 * gq + 3]); *(LAS u32x2*)(pw + (lr * 72 + 8 * gq + 4 * h) * 2) = w;
            w.x = pk2(s1[4 * gq], s1[4 * gq + 1]); w.y = pk2(s1[4 * gq + 2], s1[4 * gq + 3]); *(LAS u32x2*)(pw + (lr * 72 + 32 + 8 * gq + 4 * h) * 2) = w; }
        LDS_WAIT();
        bf16x8 pf[4], va_[4], vb_[4];
#pragma unroll
        for (int ks = 0; ks < 4; ++ks) pf[ks] = frag(pw, 72, 0, 16 * ks, lane);
        frag_tr4<72>(va_, lds32 + AT_VS, kb, 0, lane); frag_tr4<72>(vb_, lds32 + AT_VS, kb, 32, lane);
#pragma unroll
        for (int ks = 0; ks < 4; ++ks) { o0 = MFMA32(va_[ks], pf[ks], o0); o1 = MFMA32(vb_[ks], pf[ks], o1); }
        LDS_WAIT();
    }
    { const float inv = 1.0f / l; bf16* op = MIX + qrow * DM + 512 + head * 64;
#pragma unroll
      for (int gq = 0; gq < 4; ++gq) { u32x2 w; w.x = pk2(o0[4 * gq] * inv, o0[4 * gq + 1] * inv); w.y = pk2(o0[4 * gq + 2] * inv, o0[4 * gq + 3] * inv); *(u32x2*)(op + 8 * gq + 4 * h) = w;
          w.x = pk2(o1[4 * gq] * inv, o1[4 * gq + 1] * inv); w.y = pk2(o1[4 * gq + 2] * inv, o1[4 * gq + 3] * inv); *(u32x2*)(op + 32 + 8 * gq + 4 * h) = w; } }
}

DI void combine_phase(const Params& p, int tid, int G, int bid) {
    const int lane = tid & 63, wave = tid >> 6, gw = bid * NWAVES + wave, NGW = G * NWAVES;
    const bf16* OF = (const bf16*)(p.ws + WS_O); const bf16* OB = OF + (size_t)MTOK * HGW; const bf16* PR = (const bf16*)(p.ws + WS_BIG); bf16* MIX = (bf16*)p.out;
    const int c0 = 8 * lane; const f32x4 n0 = *(const f32x4*)(p.out_norm + (c0 & 127)), n1 = *(const f32x4*)(p.out_norm + (c0 & 127) + 4);
    const int RPW = (MTOK + NGW - 1) / NGW;
    for (int row0_ = gw * RPW; row0_ < min((gw + 1) * RPW, MTOK); row0_ += 4) {
        u32x4 av[4], bv[4], gv4[4]; bool on[4];
#pragma unroll
        for (int u = 0; u < 4; ++u) { const int row = row0_ + u; on[u] = row < min((gw + 1) * RPW, MTOK); const size_t rr = on[u] ? row : row0_;
            av[u] = *(const u32x4*)(OF + rr * HGW + c0); bv[u] = *(const u32x4*)(OB + rr * HGW + c0); gv4[u] = *(const u32x4*)(PR + rr * NIN + 2048 + c0); }
#pragma unroll
        for (int u = 0; u < 4; ++u) { if (!on[u]) continue; const int row = row0_ + u; const u32x4 a = av[u], bq = bv[u], gg = gv4[u];
            float o[8] = {bflo(a.x) + bflo(bq.x), bfhi(a.x) + bfhi(bq.x), bflo(a.y) + bflo(bq.y), bfhi(a.y) + bfhi(bq.y), bflo(a.z) + bflo(bq.z), bfhi(a.z) + bfhi(bq.z), bflo(a.w) + bflo(bq.w), bfhi(a.w) + bfhi(bq.w)};
            const float gv[8] = {bflo(gg.x), bfhi(gg.x), bflo(gg.y), bfhi(gg.y), bflo(gg.z), bfhi(gg.z), bflo(gg.w), bfhi(gg.w)};
            float ss = 0.f;
#pragma unroll
            for (int j = 0; j < 8; ++j) ss += o[j] * o[j];
            ss += __shfl_xor(ss, 1); ss += __shfl_xor(ss, 2); ss += __shfl_xor(ss, 4); ss += __shfl_xor(ss, 8);
            const float rs = __builtin_amdgcn_rsqf(ss * (1.0f / 128.0f) + EPSV);
#pragma unroll
            for (int j = 0; j < 8; ++j) o[j] = o[j] * rs * (j < 4 ? n0[j] : n1[j - 4]) * gv[j];
            u32x4 w; w.x = pk2(o[0], o[1]); w.y = pk2(o[2], o[3]); w.z = pk2(o[4], o[5]); w.w = pk2(o[6], o[7]);
            *(u32x4*)(MIX + (size_t)row * DM + c0) = w; }
    }
}

#define XB_TMO      128
#define XB_XCNT(j)  (256  + 64 * (j))
#define XB_XSUB(j)  (1280 + 64 * (j))
#define XB_XGEN(j)  (2304 + 64 * (j))
#define XB_TOP      3328
#define XB_TOPGEN   3392
#define XCD_BAR_WORDS 3456
#define XB_SPIN_CAP (1u << 22)

__device__ __forceinline__ unsigned xb_ld(unsigned* p)              { return __hip_atomic_load(p, __ATOMIC_RELAXED, __HIP_MEMORY_SCOPE_AGENT); }
__device__ __forceinline__ unsigned xb_add(unsigned* p, unsigned v) { return __hip_atomic_fetch_add(p, v, __ATOMIC_RELAXED, __HIP_MEMORY_SCOPE_AGENT); }
__device__ __forceinline__ unsigned xb_xcc_id() { return (unsigned)__builtin_amdgcn_s_getreg((3 << 11) | 20) & 0xFu; }
#define XB_SPIN(cond, bar) do { unsigned _sp = 0; while (cond) { __builtin_amdgcn_s_sleep(1); \
    if ((++_sp & 255u) == 0u) { if (xb_ld(&(bar)[XB_TMO])) break; if (_sp > XB_SPIN_CAP) { atomicAdd(&(bar)[XB_TMO], 1u); break; } } } } while (0)

struct XcdBarrier {
    unsigned* bar; unsigned x;
    volatile LAS unsigned* st;
};

__device__ __forceinline__ XcdBarrier xcd_barrier_post(unsigned* bar, volatile LAS unsigned* st) {
    XcdBarrier b; b.bar = bar; b.x = xb_xcc_id(); b.st = st;
    if (threadIdx.x == 0) (void)xb_add(&bar[XB_XCNT(b.x)], 1u);
    return b;
}
__device__ __forceinline__ void xcd_barrier_complete(unsigned* bar, unsigned x, unsigned& nloc, unsigned& nx) {
    const unsigned G = gridDim.x * gridDim.y * gridDim.z;
    unsigned sum, cnt, mine, sp = 0u;
    for (;;) {
        sum = 0u; cnt = 0u; mine = 0u;
#pragma unroll
        for (unsigned j = 0; j < 16; ++j) { const unsigned c = xb_ld(&bar[XB_XCNT(j)]); sum += c; cnt += (c > 0u) ? 1u : 0u; mine = (j == x) ? c : mine; }
        if (sum == G) break;
        __builtin_amdgcn_s_sleep(1);
        if ((++sp & 255u) == 0u) { if (xb_ld(&bar[XB_TMO])) break; if (sp > XB_SPIN_CAP) { atomicAdd(&bar[XB_TMO], 1u); break; } }
    }
    nloc = mine > 0u ? mine : 1u; nx = cnt > 0u ? cnt : 1u;
}

__device__ __forceinline__ void xcd_barrier(const XcdBarrier& b) {
    asm volatile("s_waitcnt vmcnt(0)" ::: "memory");
    __syncthreads();
    if (threadIdx.x == 0) {
        unsigned* bar = b.bar;
        __builtin_amdgcn_s_waitcnt(0);
        unsigned nloc = b.st[0], nx = b.st[1];
        if (nloc == 0u) { xcd_barrier_complete(bar, b.x, nloc, nx); b.st[0] = nloc; b.st[1] = nx; }
        const unsigned old = xb_add(&bar[XB_XSUB(b.x)], 1u);
        const unsigned gen = old / nloc;
        if (old + 1u == (gen + 1u) * nloc) {
            __builtin_amdgcn_fence(__ATOMIC_RELEASE, "agent");
            asm volatile("s_waitcnt vmcnt(0)" ::: "memory");
            const unsigned og = xb_add(&bar[XB_TOP], 1u);
            const unsigned tg = og / nx;
            if (og + 1u == (tg + 1u) * nx) xb_add(&bar[XB_TOPGEN], 1u);
            else XB_SPIN(xb_ld(&bar[XB_TOPGEN]) == tg, bar);
            __builtin_amdgcn_fence(__ATOMIC_ACQUIRE, "agent");
            xb_add(&bar[XB_XGEN(b.x)], 1u);
            asm volatile("s_waitcnt vmcnt(0)" ::: "memory");
        } else {
            XB_SPIN(xb_ld(&bar[XB_XGEN(b.x)]) == gen, bar);
            __builtin_amdgcn_fence(__ATOMIC_ACQUIRE, "agent");
            asm volatile("s_waitcnt vmcnt(0)" ::: "memory");
        }
    }
    __syncthreads();
}


DI unsigned attn_dequeue(unsigned* heads, unsigned xcc) {
    constexpr unsigned PER = (unsigned)NATT_UNITS / 8u;
    for (unsigned t = 0; t < 8u; ++t) { const unsigned x = (xcc + t) & 7u; const unsigned u = atomicAdd(heads + 64 * x, 1u); if (u < PER) return x * PER + u; }
    return (unsigned)NATT_UNITS;
}
__global__ void __launch_bounds__(NTHREADS, 2) hymba_fwd(Params p) {
    extern __shared__ __attribute__((aligned(16))) unsigned char lds_raw[];
    LAS unsigned char* lds = (LAS unsigned char*)lds_raw;
    const int tid = threadIdx.x, G = gridDim.x, bid = blockIdx.x;
    unsigned char* ws = p.ws;
    const int lo = p.ph_lo, hi = p.ph_hi;
#ifndef PH_MASK
#define PH_MASK 0x1ff
#endif
#define IN(k) (lo <= (k) && (k) < hi)
#define SEAM(k) do { if (IN(k) && IN((k) + 1)) { xcd_barrier(xbar); } } while (0)
    volatile LAS unsigned* xst = (volatile LAS unsigned*)(lds + WQ_OFF + 16);
    if (tid == 0) { xst[0] = 0u; xst[1] = 0u; }
    __syncthreads();
    XcdBarrier xbar = xcd_barrier_post((unsigned*)(p.ws + WS_BARW), xst);
    if (p.coop == 2) cg::this_grid().sync();
    bf16* XB = (bf16*)(ws + WS_XB); bf16* BIG = (bf16*)(ws + WS_BIG); bf16* X2B = (bf16*)(ws + WS_O);
    float* RSTD = (float*)(ws + WS_RSTD); float* SSQ = (float*)(ws + WS_SSQ); const float* LB = (const float*)(ws + WS_LB);
    if (((PH_MASK >> 0) & 1) && IN(0)) { p0_prologue(p, lds, tid, G, bid); }
    SEAM(0);
    if (((PH_MASK >> 1) & 1) && IN(1)) {
        pg8::Gemm g{XB, (const bf16*)(ws + WS_WI1), MTOK, 2 * DFF, DM}; pg8::StaticOrder S; S.init(MTOK, 2 * DFF, G, bid);
        pg8::EpiSwiglu<true> E{BIG, nullptr};
        pg8::gemm_phase<pg8::EpiSwiglu<true>, pg8::StaticOrder, true, true>(lds, g, S, E); }
    SEAM(1);
    if (((PH_MASK >> 2) & 1) && IN(2)) {
        pg8::Gemm g{BIG, (const bf16*)(ws + WS_WO1), MTOK, DM, DFF}; pg8::StaticOrder S; S.init(MTOK, DM, G, bid);
        pg8::EpiRes<0, false, true, true> E{nullptr, p.xp, p.xs, nullptr, XB, SSQ};
        pg8::gemm_phase<pg8::EpiRes<0, false, true, true>, pg8::StaticOrder, true, true>(lds, g, S, E); }
    SEAM(2);
    if (((PH_MASK >> 3) & 1) && IN(3)) {
        for (int row = bid * NTHREADS + tid; row < MTOK; row += G * NTHREADS) { const f32x4* sp = (const f32x4*)(SSQ + (size_t)row * 16); const f32x4 a = sp[0], b = sp[1], c = sp[2], d = sp[3];
            const float tot = ((a[0] + a[1]) + (a[2] + a[3])) + ((b[0] + b[1]) + (b[2] + b[3])) + ((c[0] + c[1]) + (c[2] + c[3])) + ((d[0] + d[1]) + (d[2] + d[3]));
            RSTD[row] = 1.0f / sqrtf(tot * (1.0f / DM) + EPSV); }
        xcd_barrier(xbar);
        pg8::Gemm g{XB, (const bf16*)(ws + WS_WIN), MTOK, NIN, DM}; pg8::StaticOrder S; S.init(MTOK, NIN, G, bid);
        pg8::EpiProj E{BIG, RSTD, LB, LB + HGW, p.q_norm, p.k_norm, (const float*)(ws + WS_ROPE)};
        pg8::gemm_phase<pg8::EpiProj, pg8::StaticOrder, true, true>(lds, g, S, E); }
    SEAM(3);
    if (((PH_MASK >> 4) & 1) && IN(4)) {
        hgrn_prepass(p, lds, tid, G, bid);
        xcd_barrier(xbar);
        const unsigned lds32 = (unsigned)(size_t)lds_raw;
        for (int u = bid; u < NSCAN_UNITS; u += G) scan_unit2(p, lds, lds32, u, tid);
        unsigned* cnt = (unsigned*)(ws + WS_CNT); LAS unsigned* wq = (LAS unsigned*)(lds + WQ_OFF);
        const unsigned myx = xb_xcc_id() & 7u;
        __syncthreads(); if (tid == 0) *wq = attn_dequeue(cnt, myx); __syncthreads();
        unsigned u = *wq; AttnRegs ar; if (u < (unsigned)NATT_UNITS) attn_load(p, (int)u, tid, ar);
        while (u < (unsigned)NATT_UNITS) {
            __syncthreads();
            attn_stash(lds, tid, ar);
            if (tid == 0) *wq = attn_dequeue(cnt, myx);
            __syncthreads();
            const unsigned un = *wq; if (un < (unsigned)NATT_UNITS) attn_load(p, (int)un, tid, ar);
            attn_unit(p, lds, lds32, (int)u, tid);
            u = un; } }
    SEAM(4);
    if (((PH_MASK >> 5) & 1) && IN(5)) { combine_phase(p, tid, G, bid); }
    SEAM(5);
    if (((PH_MASK >> 6) & 1) && IN(6)) {
        pg8::Gemm g{(const bf16*)p.out, (const bf16*)(ws + WS_WOUT), MTOK, DM, DM}; pg8::StaticOrder S; S.init(MTOK, DM, G, bid);
        pg8::EpiRes<1, false, true, false> E{nullptr, nullptr, nullptr, XB, X2B, SSQ};
        pg8::gemm_phase<pg8::EpiRes<1, false, true, false>, pg8::StaticOrder, true, true>(lds, g, S, E); }
    SEAM(6);
    if (((PH_MASK >> 7) & 1) && IN(7)) {
        for (int row = bid * NTHREADS + tid; row < MTOK; row += G * NTHREADS) { const f32x4* sp = (const f32x4*)(SSQ + (size_t)row * 16); const f32x4 a = sp[0], b = sp[1], c = sp[2], d = sp[3];
            const float tot = ((a[0] + a[1]) + (a[2] + a[3])) + ((b[0] + b[1]) + (b[2] + b[3])) + ((c[0] + c[1]) + (c[2] + c[3])) + ((d[0] + d[1]) + (d[2] + d[3]));
            RSTD[row] = 1.0f / sqrtf(tot * (1.0f / DM) + EPSV); }
        xcd_barrier(xbar);
        pg8::Gemm g{X2B, (const bf16*)(ws + WS_WI2), MTOK, 2 * DFF, DM}; pg8::StaticOrder S; S.init(MTOK, 2 * DFF, G, bid);
        pg8::EpiSwiglu<false> E{BIG, RSTD};
        pg8::gemm_phase<pg8::EpiSwiglu<false>, pg8::StaticOrder, true, true>(lds, g, S, E); }
    SEAM(7);
    if (((PH_MASK >> 8) & 1) && IN(8)) {
        pg8::Gemm g{BIG, (const bf16*)(ws + WS_WO2), MTOK, DM, DFF}; pg8::StaticOrder S; S.init(MTOK, DM, G, bid);
        pg8::EpiRes<1, true, false, true> E{p.out, nullptr, nullptr, X2B, nullptr, nullptr};
        pg8::gemm_phase<pg8::EpiRes<1, true, false, true>, pg8::StaticOrder, true, true>(lds, g, S, E); }
#undef IN
#undef SEAM
}

#ifndef MK_MULTI
#define MK_MULTI 0
#endif
constexpr int NPHASES = 9;
extern "C" void kernel_launch(void* const* d_in, const int* in_sizes, int n_in, void* d_out, int out_size, void* d_ws, size_t ws_size, hipStream_t stream) {
    static int grid = 0;
    if (grid == 0) {
        int dev = 0, cus = 0;
        if (hipGetDevice(&dev) != hipSuccess || hipDeviceGetAttribute(&cus, hipDeviceAttributeMultiprocessorCount, dev) != hipSuccess) { fprintf(stderr, "kernel_launch: device query failed\n"); grid = -1; return; }
        if (hipFuncSetAttribute((const void*)hymba_fwd, hipFuncAttributeMaxDynamicSharedMemorySize, LDS_BYTES) != hipSuccess) { fprintf(stderr, "kernel_launch: hipFuncSetAttribute failed\n"); grid = -1; return; }
        int per_cu = 0;
        if (hipOccupancyMaxActiveBlocksPerMultiprocessor(&per_cu, (const void*)hymba_fwd, NTHREADS, LDS_BYTES) != hipSuccess || per_cu < 1) { fprintf(stderr, "kernel_launch: occupancy query says %d blocks per CU\n", per_cu); }
        (void)hipGetLastError();
        grid = cus;
        if (n_in != 17 || ws_size < WS_END) { fprintf(stderr, "kernel_launch: unexpected n_in %d or ws_size %zu (< %zu)\n", n_in, ws_size, (size_t)WS_END); }
    }
    if (grid < 0) return;
    Params p{};
    p.xp = (const float*)d_in[0]; p.xs = (const float*)d_in[1]; p.ffn1_norm = (const float*)d_in[2]; p.ffn1_wi = (const float*)d_in[3]; p.ffn1_wo = (const float*)d_in[4];
    p.mix_norm = (const float*)d_in[5]; p.w_in = (const float*)d_in[6]; p.lb_fwd = (const float*)d_in[7]; p.lb_bwd = (const float*)d_in[8]; p.out_norm = (const float*)d_in[9];
    p.q_norm = (const float*)d_in[10]; p.k_norm = (const float*)d_in[11]; p.sink = (const float*)d_in[12]; p.w_out = (const float*)d_in[13]; p.ffn2_norm = (const float*)d_in[14];
    p.ffn2_wi = (const float*)d_in[15]; p.ffn2_wo = (const float*)d_in[16];
    p.out = (float*)d_out; p.ws = (unsigned char*)d_ws;
    for (int i = 0; i < 32; ++i) p.inv_freq_rev[i] = pow(10000.0, -(double)(2 * i) / 64.0) / 6.283185307179586476925286766559;
#if MK_MULTI
    for (int ph = 0; ph < NPHASES; ++ph) { p.ph_lo = ph; p.ph_hi = ph + 1; p.coop = 0;
        hipLaunchKernelGGL(hymba_fwd, dim3(grid), dim3(NTHREADS), LDS_BYTES, stream, p);
        const hipError_t le = hipPeekAtLastError(); if (le != hipSuccess) { fprintf(stderr, "kernel_launch: launch %d failed: %s\n", ph, hipGetErrorName(le)); break; } }
#else
    if (hipMemsetAsync((unsigned char*)d_ws + WS_BARW, 0, 16384, stream) != hipSuccess) { fprintf(stderr, "kernel_launch: hipMemsetAsync failed\n"); return; }
    p.ph_lo = 0; p.ph_hi = NPHASES; p.coop = 1;
    void* args[] = {&p};
    const hipError_t le = hipLaunchCooperativeKernel((const void*)hymba_fwd, dim3(grid), dim3(NTHREADS), args, LDS_BYTES, stream);
    if (le != hipSuccess) fprintf(stderr, "kernel_launch: cooperative launch failed: %s (grid %d)\n", hipGetErrorName(le), grid);
#endif
}
```

```cpp
#include <hip/hip_runtime.h>
#include <hip/hip_cooperative_groups.h>
#include <cstdio>
#include <cmath>
namespace cg = cooperative_groups;
constexpr int DM = 1024, SEQ = 8192, NSEQ = 10, MTOK = NSEQ * SEQ, NPROMPT = 2 * SEQ, DFF = 2816, NIN = 3328;
constexpr float EPSV = 1e-6f;
#include <hip/hip_runtime.h>
#include <cstdio>
#include <cstdint>
namespace pg8 {
#define PG8_LAS __attribute__((address_space(3)))
typedef unsigned short bf16_t;
typedef short bf16x8 __attribute__((ext_vector_type(8)));
typedef float f32x4 __attribute__((ext_vector_type(4)));
typedef unsigned u32x4 __attribute__((ext_vector_type(4)));
constexpr int BM = 256, BK = 64, HALF = 128, HTB = HALF * BK * 2  , STAGE_BYTES = 8 * HTB, NXCD = 8, WGM = 8;

__host__ __device__ __forceinline__ int lds_byte(int r, int c) { const int st = (r >> 4) * 2 + (c >> 5), rr = r & 15, cc = c & 31, ob = rr * 64 + cc * 2; return st * 1024 + (ob ^ (((ob >> 9) & 1) << 5)); }
__host__ __device__ __forceinline__ void stage_rc(int b, int& R, int& C) { const int st = b / 1024, sb = b % 1024, swz = sb ^ (((sb >> 9) & 1) << 5); R = (st >> 1) * 16 + swz / 64; C = (st & 1) * 32 + (swz % 64) / 2; }
__host__ __device__ __forceinline__ int perm32(int rho) { const int n = rho >> 4, i = rho & 15; return 8 * (i >> 2) + 4 * n + (i & 3); }

struct Unit { int pm, pn; };
struct Gemm { const bf16_t* A; const bf16_t* Bt; int M, N, K; };

struct StaticOrder {
    int nM, nN, nwg, G, c;
    __host__ __device__ void init(int M, int N, int G_, int c_) { nM = M / BM; nN = N / BM; nwg = nM * nN; G = G_; c = c_; }
    __host__ __device__ bool next(int i, Unit& u) const {
        const long L = (long)i * G + c; if (L >= nwg) return false;
        int wgid = (int)L; { const int q = nwg / NXCD, r = nwg % NXCD, xcd = wgid % NXCD, off = wgid / NXCD; wgid = (xcd < r ? xcd * (q + 1) : r * (q + 1) + (xcd - r) * q) + off; }
        const int nig = WGM * nN, gid = wgid / nig, fm = gid * WGM, gsz = (nM - fm) < WGM ? (nM - fm) : WGM;
        u.pm = fm + ((wgid % nig) % gsz); u.pn = (wgid % nig) / gsz; return true;
    }
    __device__ __forceinline__ void a_ready(const Unit&) const {}
    __device__ __forceinline__ void done(const Unit&) const {}
};

__device__ __forceinline__ unsigned cvt_pk_bf16(float lo, float hi) { unsigned r; asm volatile("v_cvt_pk_bf16_f32 %0, %1, %2" : "=v"(r) : "v"(lo), "v"(hi)); return r; }
__device__ __forceinline__ float sigmoidf_(float v) { return __builtin_amdgcn_rcpf(1.0f + __expf(-v)); }
__device__ __forceinline__ float siluf_(float v) { return v * sigmoidf_(v); }

template <bool NORMED> struct EpiSwiglu {
    static constexpr bool PERM = true, AFTER_DRAIN = false;
    bf16_t* H; const float* rstd;
    __device__ __forceinline__ void operator()(const f32x4 (&acc)[2][2][4][2], const Unit& u, int wr, int wc, int fr, int fq) const {
        const int row0 = u.pm * BM + wr * 64 + fr, col0 = u.pn * 128 + wc * 32 + 8 * fq;
        float rsv[2][4];
#pragma unroll
        for (int ai = 0; ai < 2; ++ai)
#pragma unroll
            for (int m = 0; m < 4; ++m) rsv[ai][m] = NORMED ? 1.0f : rstd[row0 + ai * HALF + m * 16];
#pragma unroll
        for (int ai = 0; ai < 2; ++ai)
#pragma unroll
            for (int m = 0; m < 4; ++m) { const int row = row0 + ai * HALF + m * 16; const float rs = rsv[ai][m];
                float hv[8];
#pragma unroll
                for (int n = 0; n < 2; ++n)
#pragma unroll
                    for (int j = 0; j < 4; ++j) { const float g = acc[ai][0][m][n][j] * rs, uu = acc[ai][1][m][n][j] * rs; hv[4 * n + j] = siluf_(g) * uu; }
                u32x4 w; w.x = cvt_pk_bf16(hv[0], hv[1]); w.y = cvt_pk_bf16(hv[2], hv[3]); w.z = cvt_pk_bf16(hv[4], hv[5]); w.w = cvt_pk_bf16(hv[6], hv[7]);
                *(u32x4*)(H + (size_t)row * DFF + col0) = w; }
    }
};
template <int RESMODE, bool OUT_F32, bool AUX, bool HALFSCALE> struct EpiRes {
    static constexpr bool PERM = true, AFTER_DRAIN = false;
    float* out; const float* xp; const float* xs; const bf16_t* resb; bf16_t* xb; float* ssq;
    __device__ __forceinline__ void operator()(const f32x4 (&acc)[2][2][4][2], const Unit& u, int wr, int wc, int fr, int fq) const {
        const int row0 = u.pm * BM + wr * 64 + fr, col0 = u.pn * BM + wc * 32 + 8 * fq;
#pragma unroll
        for (int ai = 0; ai < 2; ++ai)
#pragma unroll
            for (int m = 0; m < 4; ++m) { const int row = row0 + ai * HALF + m * 16;
                const float* resrow = (row < NPROMPT ? xp + (size_t)row * DM : xs + (size_t)(row - NPROMPT) * DM);
                float ss = 0.f;
#pragma unroll
                for (int bj = 0; bj < 2; ++bj) { const int col = col0 + bj * HALF; f32x4 r0, r1;
                    if (RESMODE == 0) { r0 = *(const f32x4*)(resrow + col); r1 = *(const f32x4*)(resrow + col + 4); }
                    else { const u32x4 w = *(const u32x4*)(resb + (size_t)row * DM + col);
                        r0 = (f32x4){__builtin_bit_cast(float, w.x << 16), __builtin_bit_cast(float, w.x & 0xffff0000u), __builtin_bit_cast(float, w.y << 16), __builtin_bit_cast(float, w.y & 0xffff0000u)};
                        r1 = (f32x4){__builtin_bit_cast(float, w.z << 16), __builtin_bit_cast(float, w.z & 0xffff0000u), __builtin_bit_cast(float, w.w << 16), __builtin_bit_cast(float, w.w & 0xffff0000u)}; }
                    const f32x4 o0 = r0 + acc[ai][bj][m][0] * (HALFSCALE ? 0.5f : 1.0f), o1 = r1 + acc[ai][bj][m][1] * (HALFSCALE ? 0.5f : 1.0f);
                    if (OUT_F32) { *(f32x4*)(out + (size_t)row * DM + col) = o0; *(f32x4*)(out + (size_t)row * DM + col + 4) = o1; }
                    else { u32x4 w; w.x = cvt_pk_bf16(o0[0], o0[1]); w.y = cvt_pk_bf16(o0[2], o0[3]); w.z = cvt_pk_bf16(o1[0], o1[1]); w.w = cvt_pk_bf16(o1[2], o1[3]); *(u32x4*)(xb + (size_t)row * DM + col) = w; }
                    if (AUX) ss += ((o0[0] * o0[0] + o0[1] * o0[1]) + (o0[2] * o0[2] + o0[3] * o0[3])) + ((o1[0] * o1[0] + o1[1] * o1[1]) + (o1[2] * o1[2] + o1[3] * o1[3])); }
                if (AUX) { ss += __shfl_xor(ss, 16); ss += __shfl_xor(ss, 32); if (fq == 0) ssq[(size_t)row * 16 + u.pn * 4 + wc] = ss; } }
    }
};
struct EpiProj {
    static constexpr bool PERM = true, AFTER_DRAIN = false;
    bf16_t* P; const float* ssq; const float* lbf; const float* lbb; const float* qn; const float* kn; const float* rope;
    __device__ __forceinline__ void operator()(const f32x4 (&acc)[2][2][4][2], const Unit& u, int wr, int wc, int fr, int fq) const {
        const int row0 = u.pm * BM + wr * 64 + fr, colw = wc * 32 + 8 * fq; const int pn = u.pn;
        float rsv[2][4];
#pragma unroll
        for (int ai = 0; ai < 2; ++ai)
#pragma unroll
            for (int m = 0; m < 4; ++m) rsv[ai][m] = ssq[row0 + ai * HALF + m * 16];
        if (pn >= 10) {
            const bool isv = (pn == 12 && wc >= 2), isq = pn < 12;
            const int cbase = isq ? 2560 + ((pn - 10) * 4 + wc) * 64 : (wc < 2 ? 3072 + wc * 64 : 3200 + (wc - 2) * 64);
            const float* gn = isq ? qn : kn; float glo[8], ghi[8];
#pragma unroll
            for (int j = 0; j < 8; ++j) { glo[j] = gn[8 * fq + j]; ghi[j] = gn[32 + 8 * fq + j]; }
#pragma unroll
            for (int ai = 0; ai < 2; ++ai)
#pragma unroll
                for (int m = 0; m < 4; ++m) { const int row = row0 + ai * HALF + m * 16;
                    const float rs = rsv[ai][m];
                    float lo[8], hi[8];
#pragma unroll
                    for (int n = 0; n < 2; ++n)
#pragma unroll
                        for (int j = 0; j < 4; ++j) { lo[4 * n + j] = acc[ai][0][m][n][j] * rs; hi[4 * n + j] = acc[ai][1][m][n][j] * rs; }
                    if (!isv) {
                        float ss = 0.f;
#pragma unroll
                        for (int j = 0; j < 8; ++j) ss += lo[j] * lo[j] + hi[j] * hi[j];
                        ss += __shfl_xor(ss, 16); ss += __shfl_xor(ss, 32);
                        const float rn = __builtin_amdgcn_rsqf(ss * (1.0f / 64.0f) + EPSV) * (isq ? 0.125f : 1.0f);
                        const float* rt = rope + (size_t)(row & (SEQ - 1)) * 64 + 8 * fq;
                        const f32x4 c0 = *(const f32x4*)(rt), c1 = *(const f32x4*)(rt + 4), n0 = *(const f32x4*)(rt + 32), n1 = *(const f32x4*)(rt + 36);
#pragma unroll
                        for (int j = 0; j < 8; ++j) { const float a = lo[j] * rn * glo[j], bb = hi[j] * rn * ghi[j], cs = (j < 4 ? c0[j] : c1[j - 4]), sn = (j < 4 ? n0[j] : n1[j - 4]); lo[j] = a * cs - bb * sn; hi[j] = bb * cs + a * sn; }
                    }
                    u32x4 w0, w1; w0.x = cvt_pk_bf16(lo[0], lo[1]); w0.y = cvt_pk_bf16(lo[2], lo[3]); w0.z = cvt_pk_bf16(lo[4], lo[5]); w0.w = cvt_pk_bf16(lo[6], lo[7]);
                    w1.x = cvt_pk_bf16(hi[0], hi[1]); w1.y = cvt_pk_bf16(hi[2], hi[3]); w1.z = cvt_pk_bf16(hi[4], hi[5]); w1.w = cvt_pk_bf16(hi[6], hi[7]);
                    *(u32x4*)(P + (size_t)row * NIN + cbase + 8 * fq) = w0; *(u32x4*)(P + (size_t)row * NIN + cbase + 32 + 8 * fq) = w1; }
            return;
        }
        const int kind = (pn < 2 || pn == 8 || pn == 9) ? 1 : ((pn >= 2 && pn < 6) ? 2 : 0);
        float lbv[2][8];
        if (kind == 2) { const float* lb = (pn < 4) ? lbf + (pn - 2) * 256 : lbb + (pn - 4) * 256;
#pragma unroll
            for (int bj = 0; bj < 2; ++bj)
#pragma unroll
                for (int j = 0; j < 8; ++j) lbv[bj][j] = lb[bj * HALF + colw + j]; }
#pragma unroll
        for (int ai = 0; ai < 2; ++ai)
#pragma unroll
            for (int m = 0; m < 4; ++m) { const int row = row0 + ai * HALF + m * 16;
                const float rs = rsv[ai][m];
#pragma unroll
                for (int bj = 0; bj < 2; ++bj) { float v[8];
#pragma unroll
                    for (int n = 0; n < 2; ++n)
#pragma unroll
                        for (int j = 0; j < 4; ++j) v[4 * n + j] = acc[ai][bj][m][n][j] * rs;
                    u32x4 w;
                    if (kind == 2) {
#pragma unroll
                        for (int j = 0; j < 8; ++j) { const float lb = lbv[bj][j]; v[j] = __logf(lb + (1.0f - lb) * sigmoidf_(v[j])); }
                        w.x = __builtin_bit_cast(unsigned, __builtin_amdgcn_cvt_pkrtz(v[0], v[1])); w.y = __builtin_bit_cast(unsigned, __builtin_amdgcn_cvt_pkrtz(v[2], v[3]));
                        w.z = __builtin_bit_cast(unsigned, __builtin_amdgcn_cvt_pkrtz(v[4], v[5])); w.w = __builtin_bit_cast(unsigned, __builtin_amdgcn_cvt_pkrtz(v[6], v[7]));
                    } else {
                        if (kind == 1) {
#pragma unroll
                            for (int j = 0; j < 8; ++j) v[j] = siluf_(v[j]); }
                        w.x = cvt_pk_bf16(v[0], v[1]); w.y = cvt_pk_bf16(v[2], v[3]); w.z = cvt_pk_bf16(v[4], v[5]); w.w = cvt_pk_bf16(v[6], v[7]); }
                    *(u32x4*)(P + (size_t)row * NIN + pn * BM + bj * HALF + colw) = w; } }
    }
};

template <class Epi, class Sched, bool ALIGN_EPI = false, bool SP2 = false>
__device__ __forceinline__ void gemm_phase(PG8_LAS unsigned char* lds, const Gemm g, const Sched& S, const Epi& E) {
    const int tid = threadIdx.x, wid = __builtin_amdgcn_readfirstlane(tid >> 6), lane = tid & 63, wr = wid >> 2, wc = wid & 3, fr = lane & 15, fq = lane >> 4;
    const int K = g.K, nt = K / BK;
    unsigned voffA[2], voffB[2];
#pragma unroll
    for (int i = 0; i < 2; ++i) { int R, C; stage_rc(tid * 16 + i * 8192, R, C); const int Rb = Epi::PERM ? ((R & ~31) + perm32(R & 31)) : R;
        voffA[i] = (unsigned)(R * K + C) * 2u; voffB[i] = (unsigned)(Rb * K + C) * 2u; }
    const size_t kstep = (size_t)(BK * 2);
    const size_t hstep = (size_t)HALF * K * 2;
    const size_t tstep = 2 * hstep;
    const unsigned ldsw = (unsigned)wid * 1024u;
    const int aoff = lds_byte(wr * 64 + fr, fq * 8), boff = lds_byte(wc * 32 + fr, fq * 8);
#define PG8_SA(b, h) (((b) * 2 + (h)) * HTB)
#define PG8_SB(b, h) ((4 + (b) * 2 + (h)) * HTB)
#define PG8_STAGE(bufoff, gbase, voff) do { _Pragma("unroll") for (int _i = 0; _i < 2; ++_i) \
        __builtin_amdgcn_global_load_lds((const unsigned*)((const char*)(gbase) + (voff)[_i]), (PG8_LAS unsigned*)(lds + (bufoff) + ldsw + _i * 8192), 16, 0, 0); } while (0)
#define PG8_LDA(dst, b, h) do { _Pragma("unroll") for (int m = 0; m < 4; ++m) _Pragma("unroll") for (int k = 0; k < 2; ++k) dst[m][k] = *(const PG8_LAS bf16x8*)(lds + PG8_SA(b, h) + aoff + m * 2048 + k * 1024); } while (0)
#define PG8_LDB(dst, b, h) do { _Pragma("unroll") for (int n = 0; n < 2; ++n) _Pragma("unroll") for (int k = 0; k < 2; ++k) dst[n][k] = *(const PG8_LAS bf16x8*)(lds + PG8_SB(b, h) + boff + n * 2048 + k * 1024); } while (0)
#define PG8_MMA(ai, bj, At, Bt) do { __builtin_amdgcn_s_setprio(1); _Pragma("unroll") for (int m = 0; m < 4; ++m) _Pragma("unroll") for (int n = 0; n < 2; ++n) _Pragma("unroll") for (int k = 0; k < 2; ++k) \
        acc[ai][bj][m][n] = __builtin_amdgcn_mfma_f32_16x16x32_bf16(Bt[n][k], At[m][k], acc[ai][bj][m][n], 0, 0, 0); __builtin_amdgcn_s_setprio(0); } while (0)
#define PG8_WAIT_V(n) asm volatile("s_waitcnt vmcnt(" #n ")" ::: "memory")
#define PG8_WAIT_L(n) asm volatile("s_waitcnt lgkmcnt(" #n ")" ::: "memory")
#define PG8_BAR __builtin_amdgcn_s_barrier()
#define PG8_SCHED __builtin_amdgcn_sched_barrier(0)
    Unit cur, nxt; int ui = 0;
    if (!S.next(0, cur)) return;
    f32x4 acc[2][2][4][2];
#pragma unroll
    for (int a = 0; a < 2; ++a)
#pragma unroll
        for (int b = 0; b < 2; ++b)
#pragma unroll
            for (int m = 0; m < 4; ++m)
#pragma unroll
                for (int n = 0; n < 2; ++n) acc[a][b][m][n] = (f32x4){0.f, 0.f, 0.f, 0.f};
    bf16x8 At[4][2], B0[2][2], B1[2][2];
    const char* cA = (const char*)g.A + (size_t)cur.pm * tstep; const char* cB = (const char*)g.Bt + (size_t)cur.pn * tstep;
    S.a_ready(cur);
    if constexpr (SP2) {
        PG8_STAGE(PG8_SB(0, 0), cB, voffB); PG8_STAGE(PG8_SB(0, 1), cB + hstep, voffB); PG8_STAGE(PG8_SA(0, 0), cA, voffA); PG8_STAGE(PG8_SA(0, 1), cA + hstep, voffA);
        if (wr == 1) PG8_BAR;
        PG8_WAIT_V(2); PG8_BAR;
        PG8_STAGE(PG8_SB(1, 0), cB + kstep, voffB); PG8_STAGE(PG8_SA(1, 0), cA + kstep, voffA); PG8_STAGE(PG8_SB(1, 1), cB + hstep + kstep, voffB);
        PG8_WAIT_V(6); PG8_BAR;
    } else {
        PG8_STAGE(PG8_SB(0, 0), cB, voffB); PG8_STAGE(PG8_SA(0, 0), cA, voffA); PG8_STAGE(PG8_SB(0, 1), cB + hstep, voffB); PG8_STAGE(PG8_SA(0, 1), cA + hstep, voffA);
        if (wr == 1) PG8_BAR;
        PG8_WAIT_V(4); PG8_BAR;
        PG8_STAGE(PG8_SB(1, 0), cB + kstep, voffB); PG8_STAGE(PG8_SA(1, 0), cA + kstep, voffA); PG8_STAGE(PG8_SB(1, 1), cB + hstep + kstep, voffB);
        PG8_WAIT_V(6); PG8_BAR;
    }
    for (;;) {
        const bool has_next = S.next(ui + 1, nxt);
        const char* nA = has_next ? (const char*)g.A + (size_t)nxt.pm * tstep : cA; const char* nB = has_next ? (const char*)g.Bt + (size_t)nxt.pn * tstep : cB;
        for (int t = 0; t < nt; t += 2) {
            const bool last = (t == nt - 2);
            const char* a1 = cA + (size_t)(t + 1) * kstep;
            const char* a2 = last ? nA : cA + (size_t)(t + 2) * kstep; const char* b2 = last ? nB : cB + (size_t)(t + 2) * kstep;
            const char* a3 = a2 + kstep; const char* b3 = b2 + kstep;
            if (last && has_next) S.a_ready(nxt);
            if constexpr (SP2) {
            PG8_LDB(B0, 0, 0); PG8_LDB(B1, 0, 1); PG8_SCHED; PG8_LDA(At, 0, 0); PG8_STAGE(PG8_SA(1, 1), a1 + hstep, voffA);
            PG8_WAIT_V(8); PG8_WAIT_L(0); PG8_BAR; PG8_MMA(0, 0, At, B0); PG8_MMA(0, 1, At, B1); PG8_BAR; PG8_SCHED;
            PG8_LDA(At, 0, 1); PG8_STAGE(PG8_SB(0, 0), b2, voffB); PG8_STAGE(PG8_SB(0, 1), b2 + hstep, voffB); PG8_STAGE(PG8_SA(0, 0), a2, voffA);
            PG8_WAIT_V(8); PG8_WAIT_L(0); PG8_BAR; PG8_MMA(1, 0, At, B0); PG8_MMA(1, 1, At, B1); PG8_BAR; PG8_SCHED;
            PG8_LDB(B0, 1, 0); PG8_LDB(B1, 1, 1); PG8_SCHED; PG8_LDA(At, 1, 0); PG8_STAGE(PG8_SA(0, 1), a2 + hstep, voffA);
            PG8_WAIT_V(8); PG8_WAIT_L(0); PG8_BAR; PG8_MMA(0, 0, At, B0); PG8_MMA(0, 1, At, B1); PG8_BAR; PG8_SCHED;
            PG8_LDA(At, 1, 1); PG8_STAGE(PG8_SB(1, 0), b3, voffB); PG8_STAGE(PG8_SB(1, 1), b3 + hstep, voffB); PG8_STAGE(PG8_SA(1, 0), a3, voffA);
            PG8_WAIT_V(8); PG8_WAIT_L(0); PG8_BAR; PG8_MMA(1, 0, At, B0); PG8_MMA(1, 1, At, B1); PG8_BAR; PG8_SCHED;
            } else {
            PG8_LDB(B0, 0, 0); PG8_SCHED; PG8_LDA(At, 0, 0); PG8_STAGE(PG8_SA(1, 1), a1 + hstep, voffA);
            PG8_WAIT_L(8); PG8_BAR; PG8_WAIT_L(0); PG8_MMA(0, 0, At, B0); PG8_BAR; PG8_SCHED;
            PG8_LDB(B1, 0, 1); PG8_STAGE(PG8_SB(0, 0), b2, voffB);
            PG8_BAR; PG8_WAIT_L(0); PG8_MMA(0, 1, At, B1); PG8_BAR;
            PG8_LDA(At, 0, 1); PG8_STAGE(PG8_SA(0, 0), a2, voffA);
            PG8_BAR; PG8_WAIT_L(0); PG8_MMA(1, 0, At, B0); PG8_BAR; PG8_SCHED;
            PG8_STAGE(PG8_SB(0, 1), b2 + hstep, voffB);
            PG8_WAIT_V(6); PG8_BAR; PG8_MMA(1, 1, At, B1); PG8_BAR;
            PG8_LDB(B0, 1, 0); PG8_SCHED; PG8_LDA(At, 1, 0); PG8_STAGE(PG8_SA(0, 1), a2 + hstep, voffA);
            PG8_WAIT_L(8); PG8_BAR; PG8_WAIT_L(0); PG8_MMA(0, 0, At, B0); PG8_BAR; PG8_SCHED;
            PG8_LDB(B1, 1, 1); PG8_STAGE(PG8_SB(1, 0), b3, voffB);
            PG8_BAR; PG8_WAIT_L(0); PG8_MMA(0, 1, At, B1); PG8_BAR;
            PG8_LDA(At, 1, 1); PG8_STAGE(PG8_SA(1, 0), a3, voffA);
            PG8_BAR; PG8_WAIT_L(0); PG8_MMA(1, 0, At, B0); PG8_BAR; PG8_SCHED;
            PG8_STAGE(PG8_SB(1, 1), b3 + hstep, voffB);
            PG8_WAIT_V(6); PG8_BAR; PG8_MMA(1, 1, At, B1); PG8_BAR;
            }
        }
        if constexpr (ALIGN_EPI) { if (wr == 0) PG8_BAR; }
        if constexpr (!Epi::AFTER_DRAIN) { E(acc, cur, wr, wc, fr, fq); S.done(cur); }
        if (!has_next) break;
#pragma unroll
        for (int a = 0; a < 2; ++a)
#pragma unroll
            for (int b = 0; b < 2; ++b)
#pragma unroll
                for (int m = 0; m < 4; ++m)
#pragma unroll
                    for (int n = 0; n < 2; ++n) acc[a][b][m][n] = (f32x4){0.f, 0.f, 0.f, 0.f};
        cur = nxt; cA = nA; cB = nB; ++ui;
        if constexpr (ALIGN_EPI) { if (wr == 1) PG8_BAR; }
    }
    PG8_WAIT_V(0);
    if constexpr (!ALIGN_EPI) { if (wr == 0) PG8_BAR; }
    PG8_BAR;
    if constexpr (Epi::AFTER_DRAIN) { E.fused(acc, cur, wr, wc, fr, fq, lds, wid, lane); S.done(cur); }
#undef PG8_SA
#undef PG8_SB
#undef PG8_STAGE
#undef PG8_LDA
#undef PG8_LDB
#undef PG8_MMA
#undef PG8_WAIT_V
#undef PG8_WAIT_L
#undef PG8_BAR
#undef PG8_SCHED
}
}

#define LAS __attribute__((address_space(3)))
#define DI __device__ __forceinline__
typedef unsigned short bf16;
typedef short bf16x8 __attribute__((ext_vector_type(8)));
typedef float f32x4 __attribute__((ext_vector_type(4)));
typedef float f32x16 __attribute__((ext_vector_type(16)));
typedef unsigned u32x4 __attribute__((ext_vector_type(4)));
typedef unsigned u32x2 __attribute__((ext_vector_type(2)));
#define MFMA32(a, b, c) __builtin_amdgcn_mfma_f32_32x32x16_bf16((a), (b), (c), 0, 0, 0)
#define LDS_WAIT() asm volatile("s_waitcnt lgkmcnt(0)" ::: "memory")

constexpr int NTHREADS = 512, NWAVES = 8;
constexpr int LDS_BYTES = 155648;
constexpr int WQ_OFF = LDS_BYTES - 64;
constexpr int HGW = 512, NATT_UNITS = NSEQ * 2 * (SEQ / 64), NSCAN_UNITS = NSEQ * 16;
constexpr size_t MiB = 1u << 20;
constexpr size_t WS_WI1 = 0, WS_WO1 = 12 * MiB, WS_WIN = 18 * MiB, WS_WOUT = 25 * MiB, WS_WI2 = 27 * MiB, WS_WO2 = 39 * MiB;
constexpr size_t WS_ROPE = 45 * MiB;
constexpr size_t WS_RSTD = 48 * MiB;
constexpr size_t WS_SSQ = 49 * MiB;
constexpr size_t WS_LB = 55 * MiB;
constexpr size_t WS_CNT = 56 * MiB;
constexpr size_t WS_BARW = 57 * MiB;
constexpr size_t WS_XB = 64 * MiB;
constexpr size_t WS_BIG = 224 * MiB;
constexpr size_t WS_O = 744 * MiB;
constexpr size_t WS_VEC = 904 * MiB;
constexpr size_t WS_PF = 920 * MiB;
constexpr size_t WS_END = 1000 * MiB;
static_assert((size_t)DM * 2 * DFF * 2 <= 12 * MiB && (size_t)DFF * DM * 2 <= 6 * MiB && (size_t)NIN * DM * 2 <= 7 * MiB, "weight map");
static_assert((size_t)MTOK * 16 * 4 <= 6 * MiB && (size_t)MTOK * DM * 2 == 160 * MiB && (size_t)MTOK * NIN * 2 <= 520 * MiB, "ws map");

struct Params {
    const float* xp; const float* xs; const float* ffn1_norm; const float* ffn1_wi; const float* ffn1_wo; const float* mix_norm; const float* w_in;
    const float* lb_fwd; const float* lb_bwd; const float* out_norm; const float* q_norm; const float* k_norm; const float* sink; const float* w_out;
    const float* ffn2_norm; const float* ffn2_wi; const float* ffn2_wo;
    float* out; unsigned char* ws;
    double inv_freq_rev[32];
    int ph_lo, ph_hi, coop, pad;
};

DI float bf2f(unsigned short b) { return __builtin_bit_cast(float, (unsigned)b << 16); }
DI float bflo(unsigned w) { return __builtin_bit_cast(float, w << 16); }
DI float bfhi(unsigned w) { return __builtin_bit_cast(float, w & 0xffff0000u); }
DI unsigned pk2(float lo, float hi) { return pg8::cvt_pk_bf16(lo, hi); }
DI unsigned short f2bf(float f) { unsigned u = __builtin_bit_cast(unsigned, f); u += 0x7fffu + ((u >> 16) & 1u); return (unsigned short)(u >> 16); }
DI float h2f(unsigned short h) { return (float)__builtin_bit_cast(_Float16, h); }
DI int crow(int reg, int h) { return (reg & 3) + 8 * (reg >> 2) + 4 * h; }
DI bf16x8 frag(const LAS unsigned char* base, int ld, int row0, int k0, int lane) { return *(const LAS bf16x8*)(base + ((row0 + (lane & 31)) * ld + k0 + 8 * (lane >> 5)) * 2); }
DI f32x16 zero16() { f32x16 z; for (int i = 0; i < 16; ++i) z[i] = 0.f; return z; }

DI void p0_transpose_item(const float* W, int K, int N, bf16* Wt, const float* gain, int perm, int item, LAS float* scr, int lane) {
    const int ntile = N / 64, nt = item % ntile, kt = item / ntile, k0 = kt * 64, n0 = nt * 64;
    int src = n0 + lane;
    if (perm == 1) { const int pn = n0 >> 8, bj = (n0 >> 7) & 1, i = n0 & 127; src = bj * DFF + pn * 128 + i + lane; }
    if (perm == 2 && n0 >= 2560) {
        const int np = n0 + lane - 2560, t = np >> 8, r = np & 255, bj = r >> 7, wc = (r >> 5) & 3, dd = r & 31;
        const int base = (t == 0) ? 2560 + wc * 64 : (t == 1) ? 2560 + (4 + wc) * 64 : (wc < 2 ? 3072 + wc * 64 : 3200 + (wc - 2) * 64);
        src = base + bj * 32 + dd; }
    float wv[64];
#pragma unroll
    for (int kk = 0; kk < 64; ++kk) wv[kk] = W[(size_t)(k0 + kk) * N + src];
    if (gain) {
#pragma unroll
        for (int kk = 0; kk < 64; kk += 4) { const f32x4 g4 = *(const f32x4*)(gain + k0 + kk); wv[kk] *= g4[0]; wv[kk + 1] *= g4[1]; wv[kk + 2] *= g4[2]; wv[kk + 3] *= g4[3]; } }
#pragma unroll
    for (int kk = 0; kk < 64; ++kk) scr[lane * 65 + kk] = wv[kk];
    LDS_WAIT();
    const int c = lane & 7;
#pragma unroll
    for (int j = 0; j < 8; ++j) { const int n = (lane >> 3) + 8 * j; const LAS float* s = scr + n * 65 + 8 * c;
        u32x4 o; o.x = pk2(s[0], s[1]); o.y = pk2(s[2], s[3]); o.z = pk2(s[4], s[5]); o.w = pk2(s[6], s[7]);
        *(u32x4*)(Wt + (size_t)(n0 + n) * K + k0 + 8 * c) = o; }
    LDS_WAIT();
}
DI void p0_prologue(const Params& p, LAS unsigned char* lds, int tid, int G, int bid) {
    const int lane = tid & 63, wave = tid >> 6, gw = bid * NWAVES + wave, NGW = G * NWAVES;
    unsigned char* ws = p.ws;
    LAS float* scr = (LAS float*)(lds + wave * 16640);
    constexpr int I_WI = (DM / 64) * (2 * DFF / 64), I_WO = (DFF / 64) * (DM / 64), I_IN = (DM / 64) * (NIN / 64), I_OUT = (DM / 64) * (DM / 64);
    constexpr int NITEMS = 2 * I_WI + 2 * I_WO + I_IN + I_OUT;
    for (int it = gw; it < NITEMS; it += NGW) {
        int r = it;
        if (r < I_WI) { p0_transpose_item(p.ffn1_wi, DM, 2 * DFF, (bf16*)(ws + WS_WI1), p.ffn1_norm, 1, r, scr, lane); continue; } r -= I_WI;
        if (r < I_WI) { p0_transpose_item(p.ffn2_wi, DM, 2 * DFF, (bf16*)(ws + WS_WI2), p.ffn2_norm, 1, r, scr, lane); continue; } r -= I_WI;
        if (r < I_WO) { p0_transpose_item(p.ffn1_wo, DFF, DM, (bf16*)(ws + WS_WO1), nullptr, 0, r, scr, lane); continue; } r -= I_WO;
        if (r < I_WO) { p0_transpose_item(p.ffn2_wo, DFF, DM, (bf16*)(ws + WS_WO2), nullptr, 0, r, scr, lane); continue; } r -= I_WO;
        if (r < I_IN) { p0_transpose_item(p.w_in, DM, NIN, (bf16*)(ws + WS_WIN), p.mix_norm, 2, r, scr, lane); continue; } r -= I_IN;
        p0_transpose_item(p.w_out, DM, DM, (bf16*)(ws + WS_WOUT), nullptr, 0, r, scr, lane);
    }
    bf16* XB = (bf16*)(ws + WS_XB); float* RSTD = (float*)(ws + WS_RSTD);
    const int RPW = (MTOK + NGW - 1) / NGW;
    for (int row0_ = gw * RPW; row0_ < min((gw + 1) * RPW, MTOK); row0_ += 8) {
        f32x4 v[8][4]; bool on[8];
#pragma unroll
        for (int u = 0; u < 8; ++u) { const int row = row0_ + u; on[u] = row < min((gw + 1) * RPW, MTOK); const int rr = on[u] ? row : row0_;
            const float* xr = (rr < NPROMPT) ? p.xp + (size_t)rr * DM : p.xs + (size_t)(rr - NPROMPT) * DM;
#pragma unroll
            for (int j = 0; j < 4; ++j) v[u][j] = *(const f32x4*)(xr + 4 * lane + 256 * j); }
#pragma unroll
        for (int u = 0; u < 8; ++u) { if (!on[u]) continue; const int row = row0_ + u; float s = 0.f;
#pragma unroll
            for (int j = 0; j < 4; ++j) s += (v[u][j][0] * v[u][j][0] + v[u][j][1] * v[u][j][1]) + (v[u][j][2] * v[u][j][2] + v[u][j][3] * v[u][j][3]);
#pragma unroll
            for (int o = 32; o >= 1; o >>= 1) s += __shfl_xor(s, o);
            const float rsx = 1.0f / sqrtf(s * (1.0f / DM) + EPSV);
#pragma unroll
            for (int j = 0; j < 4; ++j) { u32x2 w; w.x = pk2(v[u][j][0] * rsx, v[u][j][1] * rsx); w.y = pk2(v[u][j][2] * rsx, v[u][j][3] * rsx); *(u32x2*)(XB + (size_t)row * DM + 4 * lane + 256 * j) = w; } }
    }
    float* ROPE = (float*)(ws + WS_ROPE);
    for (int i = bid * NTHREADS + tid; i < SEQ * 32; i += G * NTHREADS) { const int pos = i >> 5, fi = i & 31;
        const double rev = (double)pos * p.inv_freq_rev[fi]; const float fr = (float)(rev - rint(rev));
        ROPE[pos * 64 + fi] = __builtin_amdgcn_cosf(fr); ROPE[pos * 64 + 32 + fi] = __builtin_amdgcn_sinf(fr); }
    if (bid == 0) { float* LB = (float*)(ws + WS_LB);
        for (int c = tid; c < 2 * HGW; c += NTHREADS) { const float* a = (c < HGW) ? p.lb_fwd : p.lb_bwd; const int cc = c & (HGW - 1); LB[c] = 1.0f / (1.0f + expf(a[HGW + cc] - a[cc])); }
        if (tid < 8) *((unsigned*)(ws + WS_CNT) + 64 * tid) = 0u; }
}

typedef short s16x4 __attribute__((ext_vector_type(4)));
DI bf16x8 frag_tr(unsigned img, int ld, int s0, int c0, int lane) {
    const int i16 = lane & 15, q = i16 >> 2, pp = i16 & 3, blk = (lane >> 4) & 1, h = lane >> 5;
    const unsigned a0 = img + (unsigned)(((s0 + 8 * h + q) * ld + c0 + 16 * blk + 4 * pp) * 2), a1 = a0 + (unsigned)(8 * ld);
    s16x4 lo, hi;
    asm volatile("ds_read_b64_tr_b16 %0, %2\n\tds_read_b64_tr_b16 %1, %3\n\ts_waitcnt lgkmcnt(0)" : "=&v"(lo), "=&v"(hi) : "v"(a0), "v"(a1) : "memory");
    return __builtin_shufflevector(lo, hi, 0, 1, 2, 3, 4, 5, 6, 7);
}
template <int LD> DI void frag_tr4(bf16x8 (&f)[4], unsigned img, int s0, int c0, int lane) {
    const int i16 = lane & 15, q = i16 >> 2, pp = i16 & 3, blk = (lane >> 4) & 1, h = lane >> 5;
    const unsigned a0 = img + (unsigned)(((s0 + 8 * h + q) * LD + c0 + 16 * blk + 4 * pp) * 2);
    s16x4 r0, r1, r2, r3, r4, r5, r6, r7;
    asm volatile("ds_read_b64_tr_b16 %0, %8\n\tds_read_b64_tr_b16 %1, %8 offset:%9\n\tds_read_b64_tr_b16 %2, %8 offset:%10\n\tds_read_b64_tr_b16 %3, %8 offset:%11\n\t"
                 "ds_read_b64_tr_b16 %4, %8 offset:%12\n\tds_read_b64_tr_b16 %5, %8 offset:%13\n\tds_read_b64_tr_b16 %6, %8 offset:%14\n\tds_read_b64_tr_b16 %7, %8 offset:%15\n\ts_waitcnt lgkmcnt(0)"
                 : "=&v"(r0), "=&v"(r1), "=&v"(r2), "=&v"(r3), "=&v"(r4), "=&v"(r5), "=&v"(r6), "=&v"(r7)
                 : "v"(a0), "i"(8 * LD), "i"(32 * LD), "i"(40 * LD), "i"(64 * LD), "i"(72 * LD), "i"(96 * LD), "i"(104 * LD) : "memory");
    f[0] = __builtin_shufflevector(r0, r1, 0, 1, 2, 3, 4, 5, 6, 7); f[1] = __builtin_shufflevector(r2, r3, 0, 1, 2, 3, 4, 5, 6, 7);
    f[2] = __builtin_shufflevector(r4, r5, 0, 1, 2, 3, 4, 5, 6, 7); f[3] = __builtin_shufflevector(r6, r7, 0, 1, 2, 3, 4, 5, 6, 7);
}
constexpr int PP_Q = 0, PP_LF = 17408, PP_LB = 34816, PP_QB = 52224, PP_TOT = 69632, PP_PF = 73728, PP_PB = 82944;
DI void hgrn_prepass(const Params& p, LAS unsigned char* lds, int tid, int G, int bid) {
    bf16* PR = (bf16*)(p.ws + WS_BIG); bf16* QEB = (bf16*)p.out + (size_t)MTOK * DM; float* VEC = (float*)(p.ws + WS_VEC);
    const int r_a = tid >> 4, c_a = tid & 15, k = tid & 127, tq = tid >> 7;
    LAS float* TOT = (LAS float*)(lds + PP_TOT);
    u32x4 q0, q1, f0, f1, b0, b1;
#define PP_LOAD(u) do { const size_t rb = (size_t)((u) >> 2) * 64; const int hc = ((u) & 3) * 128 + 8 * c_a; const bf16* ra = PR + (rb + r_a) * NIN + hc; const bf16* rc = PR + (rb + r_a + 32) * NIN + hc; \
        q0 = *(const u32x4*)(ra); f0 = *(const u32x4*)(ra + 512); b0 = *(const u32x4*)(ra + 1024); q1 = *(const u32x4*)(rc); f1 = *(const u32x4*)(rc + 512); b1 = *(const u32x4*)(rc + 1024); } while (0)
    int unit = bid;
    if (unit < NSEQ * 128 * 4) PP_LOAD(unit);
    for (; unit < NSEQ * 128 * 4; unit += G) {
        { const int o0 = (r_a * 136 + 8 * c_a) * 2, o1 = ((r_a + 32) * 136 + 8 * c_a) * 2;
          *(LAS u32x4*)(lds + PP_Q + o0) = q0; *(LAS u32x4*)(lds + PP_Q + o1) = q1; *(LAS u32x4*)(lds + PP_LF + o0) = f0; *(LAS u32x4*)(lds + PP_LF + o1) = f1; *(LAS u32x4*)(lds + PP_LB + o0) = b0; *(LAS u32x4*)(lds + PP_LB + o1) = b1; }
        if (unit + G < NSEQ * 128 * 4) PP_LOAD(unit + G);
        __syncthreads();
        float q[16], lff[16], lfb[16], blf[16], blb[16];
#pragma unroll
        for (int i = 0; i < 16; ++i) { const int o = ((16 * tq + i) * 136 + k) * 2; q[i] = bf2f(*(const LAS unsigned short*)(lds + PP_Q + o)); lff[i] = h2f(*(const LAS unsigned short*)(lds + PP_LF + o)); lfb[i] = h2f(*(const LAS unsigned short*)(lds + PP_LB + o)); }
        { float run = 0.f;
#pragma unroll
          for (int i = 0; i < 16; ++i) { run += lff[i]; blf[i] = run; }
          TOT[tq * 128 + k] = run; run = 0.f;
#pragma unroll
          for (int i = 15; i >= 0; --i) { run += lfb[i]; blb[i] = run; }
          TOT[512 + tq * 128 + k] = run; }
        __syncthreads();
        { const float t0 = TOT[k], t1 = TOT[128 + k], t2 = TOT[256 + k], t3 = TOT[384 + k], u0 = TOT[512 + k], u1 = TOT[640 + k], u2 = TOT[768 + k], u3 = TOT[896 + k];
          const float offf = (tq > 0 ? t0 : 0.f) + (tq > 1 ? t1 : 0.f) + (tq > 2 ? t2 : 0.f), offb = (tq < 3 ? u3 : 0.f) + (tq < 2 ? u2 : 0.f) + (tq < 1 ? u1 : 0.f);
          const float bmid = t0 + t1, bmidb = u2 + u3;
#pragma unroll
          for (int i = 0; i < 16; ++i) { const int o = ((16 * tq + i) * 136 + k) * 2;
              const float bbf = blf[i] + offf, bbb = blb[i] + offb;
              const float qef = q[i] * __expf(bbf - bmid), kef = (1.0f - __expf(lff[i])) * __expf(bmid - bbf), qeb = q[i] * __expf(bbb - bmidb), keb = (1.0f - __expf(lfb[i])) * __expf(bmidb - bbb);
              const unsigned w1 = pk2(qef, kef), w2 = pk2(keb, qeb);
              *(LAS unsigned short*)(lds + PP_Q + o) = (unsigned short)(w1 & 0xffffu); *(LAS unsigned short*)(lds + PP_LF + o) = (unsigned short)(w1 >> 16); *(LAS unsigned short*)(lds + PP_LB + o) = (unsigned short)(w2 & 0xffffu); *(LAS unsigned short*)(lds + PP_QB + o) = (unsigned short)(w2 >> 16); }
          if (tq == 0) { float* vf = VEC + (size_t)(unit * 2) * 384; vf[k] = __expf(bmid); vf[128 + k] = __expf((t0 + t1) + (t2 + t3)); vf[256 + k] = __expf(t2 + t3);
                         vf[384 + k] = __expf(bmidb); vf[512 + k] = __expf((u0 + u1) + (u2 + u3)); vf[640 + k] = __expf(u0 + u1); } }
        __syncthreads();
        { const int wv_ = tid >> 6, ln_ = tid & 63, hh_ = ln_ >> 5, lr_ = ln_ & 31;
          if (wv_ < 6) { const int d_ = wv_ >= 3, w_ = wv_ - 3 * d_; const int ati = d_ ? (w_ > 1) : (w_ > 0), asi = d_ ? (w_ > 0) : (w_ > 1);
              const LAS unsigned char* qi_ = lds + (d_ ? PP_QB : PP_Q); const LAS unsigned char* ki_ = lds + (d_ ? PP_LB : PP_LF); f32x16 a_ = zero16();
#pragma unroll
              for (int ks = 0; ks < 8; ++ks) a_ = MFMA32(frag(ki_, 136, asi * 32, ks * 16, ln_), frag(qi_, 136, ati * 32, ks * 16, ln_), a_);
              const int t_ = ati * 32 + lr_;
#pragma unroll
              for (int g = 0; g < 4; ++g) { float v_[4];
#pragma unroll
                  for (int j = 0; j < 4; ++j) { const int s_ = asi * 32 + 8 * g + 4 * hh_ + j; const bool keep = d_ ? (s_ >= t_) : (s_ <= t_); v_[j] = keep ? a_[4 * g + j] : 0.f; }
                  u32x2 w_2; w_2.x = pk2(v_[0], v_[1]); w_2.y = pk2(v_[2], v_[3]); *(LAS u32x2*)(lds + (d_ ? PP_PB : PP_PF) + (t_ * 72 + asi * 32 + 8 * g + 4 * hh_) * 2) = w_2; } } }
        __syncthreads();
        { const size_t rb = (size_t)(unit >> 2) * 64; const int hh = unit & 3, hc = hh * 128 + 8 * c_a; const int o0 = (r_a * 136 + 8 * c_a) * 2, o1 = ((r_a + 32) * 136 + 8 * c_a) * 2;
          bf16* ra = PR + (rb + r_a) * NIN + hc; bf16* rc = PR + (rb + r_a + 32) * NIN + hc;
          *(u32x4*)(ra) = *(const LAS u32x4*)(lds + PP_Q + o0); *(u32x4*)(rc) = *(const LAS u32x4*)(lds + PP_Q + o1);
          *(u32x4*)(ra + 512) = *(const LAS u32x4*)(lds + PP_LF + o0); *(u32x4*)(rc + 512) = *(const LAS u32x4*)(lds + PP_LF + o1);
          *(u32x4*)(ra + 1024) = *(const LAS u32x4*)(lds + PP_LB + o0); *(u32x4*)(rc + 1024) = *(const LAS u32x4*)(lds + PP_LB + o1);
          *(u32x4*)(QEB + (rb + r_a) * HGW + hc) = *(const LAS u32x4*)(lds + PP_QB + o0); *(u32x4*)(QEB + (rb + r_a + 32) * HGW + hc) = *(const LAS u32x4*)(lds + PP_QB + o1);
          { const int pr_ = tid >> 3, pc_ = tid & 7; bf16* PF_ = (bf16*)(p.ws + WS_PF) + (size_t)unit * 4096; bf16* PB_ = (bf16*)p.out + (size_t)MTOK * DM + (size_t)MTOK * HGW + (size_t)unit * 4096;
            *(u32x4*)(PF_ + pr_ * 64 + 8 * pc_) = *(const LAS u32x4*)(lds + PP_PF + (pr_ * 72 + 8 * pc_) * 2); *(u32x4*)(PB_ + pr_ * 64 + 8 * pc_) = *(const LAS u32x4*)(lds + PP_PB + (pr_ * 72 + 8 * pc_) * 2); } }
        __syncthreads();
    }
#undef PP_LOAD
}

constexpr int S2_QE = 0, S2_KE = 17408, S2_V = 34816, S2_PB = 44032, S2_BUF = 53248, S2_ST = 106496  , S2_VECR = 141312  ;
DI void scan_unit2(const Params& p, LAS unsigned char* lds, unsigned lds32, int unit, int tid) {
    const int lane = tid & 63, wave = tid >> 6, h = lane >> 5, lr = lane & 31;
    const int b = unit >> 4, rem = unit & 15, hh = rem >> 2, dir = (rem >> 1) & 1, vh = rem & 1;
    const bf16* PR = (const bf16*)(p.ws + WS_BIG); const bf16* QEB = (const bf16*)p.out + (size_t)MTOK * DM; const float* VEC = (const float*)(p.ws + WS_VEC);
    const bf16* PIM = dir ? (const bf16*)p.out + (size_t)MTOK * DM + (size_t)MTOK * HGW : (const bf16*)(p.ws + WS_PF);
    bf16* OUT = (bf16*)(p.ws + WS_O) + (dir ? (size_t)MTOK * HGW : 0);
    const int colo = hh * 128 + vh * 64;
    const bf16* qsrc = dir ? QEB + hh * 128 : PR + hh * 128; const size_t qstride = dir ? HGW : NIN;
    const bf16* ksrc = PR + (dir ? 1024 : 512) + hh * 128; const bf16* vsrc = PR + 1536 + hh * 128 + vh * 64;
    for (int i = tid; i < 2 * 17408 / 4; i += NTHREADS) ((LAS unsigned*)(lds + S2_ST))[i] = 0u;
    f32x16 st0 = zero16(), st1 = zero16();
    const int r_a = tid >> 4, c_a = tid & 15, r_v = tid >> 3, c_v = tid & 7;
    const int ki = wave & 3, kc = ki * 32 + lr, ti = (wave - 4) >> 1, vi = (wave - 4) & 1;
    u32x4 pq0, pq1, pk0, pk1, pv, pp, pvec = (u32x4){0u, 0u, 0u, 0u};
#define S2_CH(i) (dir ? (SEQ / 64 - 1 - (i)) : (i))
#define S2_ROW0(i) ((size_t)b * SEQ + (size_t)S2_CH(i) * 64)
#define S2_VEC(i) (VEC + (size_t)((((b * 128 + S2_CH(i)) * 4 + hh) * 2 + dir)) * 384)
#define S2_LOAD(i) do { const size_t rb = S2_ROW0(i); pq0 = *(const u32x4*)(qsrc + (rb + r_a) * qstride + 8 * c_a); pq1 = *(const u32x4*)(qsrc + (rb + r_a + 32) * qstride + 8 * c_a); \
        pk0 = *(const u32x4*)(ksrc + (rb + r_a) * NIN + 8 * c_a); pk1 = *(const u32x4*)(ksrc + (rb + r_a + 32) * NIN + 8 * c_a); pv = *(const u32x4*)(vsrc + (rb + r_v) * NIN + 8 * c_v); \
        pp = *(const u32x4*)(PIM + (size_t)((b * 128 + S2_CH(i)) * 4 + hh) * 4096 + r_v * 64 + 8 * c_v); } while (0)
#define S2_STASH(bf) do { LAS unsigned char* bb_ = lds + (bf) * S2_BUF; *(LAS u32x4*)(bb_ + S2_QE + (r_a * 136 + 8 * c_a) * 2) = pq0; *(LAS u32x4*)(bb_ + S2_QE + ((r_a + 32) * 136 + 8 * c_a) * 2) = pq1; \
        *(LAS u32x4*)(bb_ + S2_KE + (r_a * 136 + 8 * c_a) * 2) = pk0; *(LAS u32x4*)(bb_ + S2_KE + ((r_a + 32) * 136 + 8 * c_a) * 2) = pk1; *(LAS u32x4*)(bb_ + S2_V + (r_v * 72 + 8 * c_v) * 2) = pv; \
        *(LAS u32x4*)(bb_ + S2_PB + (r_v * 72 + 8 * c_v) * 2) = pp; } while (0)
#define S2_VLOAD(i) do { if (tid < 96) pvec = *(const u32x4*)(S2_VEC(i) + 4 * tid); } while (0)
#define S2_VSTASH(slot) do { if (tid < 96) *(LAS u32x4*)(lds + S2_VECR + (slot) * 1536 + 16 * tid) = pvec; } while (0)
    S2_LOAD(0); S2_VLOAD(0); S2_STASH(0); S2_VSTASH(0); S2_VLOAD(1); S2_VSTASH(1); S2_LOAD(1); S2_VLOAD(2);
    int sl0 = 0, sl1 = 1, sl2 = 2;
    for (int i = 0; i < SEQ / 64; ++i) {
        const int cur = i & 1; const LAS unsigned char* bufc = lds + cur * S2_BUF; const unsigned buf32 = lds32 + (unsigned)(cur * S2_BUF);
        const LAS unsigned char* stc = lds + S2_ST + cur * 17408; LAS unsigned char* stn = lds + S2_ST + (cur ^ 1) * 17408;
        __syncthreads();
        if (i + 1 < SEQ / 64) S2_STASH(cur ^ 1);
        if (i + 2 < SEQ / 64) { S2_VSTASH(sl2); S2_LOAD(i + 2); }
        if (i + 3 < SEQ / 64) S2_VLOAD(i + 3);
        if (wave >= 4) { f32x16 oacc = zero16(), o2 = zero16();
            { bf16x8 fa[8], fb[8];
#pragma unroll
              for (int ks = 0; ks < 8; ++ks) { fa[ks] = frag(stc, 136, vi * 32, ks * 16, lane); fb[ks] = frag(bufc + S2_QE, 136, ti * 32, ks * 16, lane); }
              __builtin_amdgcn_sched_barrier(0);
#pragma unroll
              for (int ks = 0; ks < 8; ks += 2) { oacc = MFMA32(fa[ks], fb[ks], oacc); o2 = MFMA32(fa[ks + 1], fb[ks + 1], o2); } }
            bf16x8 vf[4]; frag_tr4<72>(vf, buf32 + S2_V, 0, vi * 32, lane);
            const int ks0 = dir ? 2 * ti : 0, ks1 = dir ? 4 : 2 * (ti + 1); u32x4 pfr[4];
#pragma unroll
            for (int ks = 0; ks < 4; ++ks) { pfr[ks] = __builtin_bit_cast(u32x4, frag(bufc + S2_PB, 72, ti * 32, ks * 16, lane)); }
            __builtin_amdgcn_sched_barrier(0);
#pragma unroll
            for (int ks = 0; ks < 4; ks += 2) {
#pragma unroll
                for (int kk = 0; kk < 2; ++kk) { const bool on = (ks + kk >= ks0 && ks + kk < ks1); u32x4 pw_ = pfr[ks + kk]; pw_.x = on ? pw_.x : 0u; pw_.y = on ? pw_.y : 0u; pw_.z = on ? pw_.z : 0u; pw_.w = on ? pw_.w : 0u;
                    if (kk == 0) oacc = MFMA32(vf[ks + kk], __builtin_bit_cast(bf16x8, pw_), oacc); else o2 = MFMA32(vf[ks + kk], __builtin_bit_cast(bf16x8, pw_), o2); } }
#pragma unroll
            for (int r = 0; r < 16; ++r) oacc[r] += o2[r];
            bf16* op = OUT + (S2_ROW0(i) + ti * 32 + lr) * HGW + colo + vi * 32 + 4 * h;
#pragma unroll
            for (int g = 0; g < 4; ++g) { u32x2 w; w.x = (unsigned)f2bf(oacc[4 * g]) | ((unsigned)f2bf(oacc[4 * g + 1]) << 16); w.y = (unsigned)f2bf(oacc[4 * g + 2]) | ((unsigned)f2bf(oacc[4 * g + 3]) << 16); *(u32x2*)(op + 8 * g) = w; }
        }
        else { const LAS float* vc_ = (const LAS float*)(lds + S2_VECR + sl0 * 1536); const float dk_c = vc_[128 + kc], c2_c = vc_[256 + kc], em_n = ((const LAS float*)(lds + S2_VECR + sl1 * 1536))[kc];
          bf16x8 kf[4], v0[4]; frag_tr4<136>(kf, buf32 + S2_KE, 0, ki * 32, lane); frag_tr4<72>(v0, buf32 + S2_V, 0, 0, lane);
          { f32x16 u0 = zero16();
#pragma unroll
            for (int ks = 0; ks < 4; ++ks) u0 = MFMA32(v0[ks], kf[ks], u0);
            frag_tr4<72>(v0, buf32 + S2_V, 0, 32, lane);
#pragma unroll
            for (int r = 0; r < 16; ++r) { st0[r] = st0[r] * dk_c + c2_c * u0[r]; *(LAS unsigned short*)(stn + (crow(r, h) * 136 + kc) * 2) = f2bf(st0[r] * em_n); } }
          { f32x16 u1 = zero16();
#pragma unroll
            for (int ks = 0; ks < 4; ++ks) u1 = MFMA32(v0[ks], kf[ks], u1);
#pragma unroll
            for (int r = 0; r < 16; ++r) { st1[r] = st1[r] * dk_c + c2_c * u1[r]; *(LAS unsigned short*)(stn + ((32 + crow(r, h)) * 136 + kc) * 2) = f2bf(st1[r] * em_n); } } }
        { const int t_ = sl0; sl0 = sl1; sl1 = sl2; sl2 = t_; }
    }
    __syncthreads();
#undef S2_CH
#undef S2_ROW0
#undef S2_VEC
#undef S2_LOAD
#undef S2_VLOAD
#undef S2_VSTASH
#undef S2_STASH
}

DI void attn_prepass(const Params& p, int tid, int G, int bid) {
    bf16* PR = (bf16*)(p.ws + WS_BIG); const float* ROPE = (const float*)(p.ws + WS_ROPE);
    const int c = tid & 7; const unsigned total = (unsigned)MTOK * 10u * 8u, stride = (unsigned)G * NTHREADS;
    const f32x4 qg0 = *(const f32x4*)(p.q_norm + 8 * c), qg1 = *(const f32x4*)(p.q_norm + 8 * c + 4), kg0 = *(const f32x4*)(p.k_norm + 8 * c), kg1 = *(const f32x4*)(p.k_norm + 8 * c + 4);
    for (unsigned base = (unsigned)bid * NTHREADS; base < total; base += 4u * stride) {
        bf16* ptr[4]; u32x4 w[4]; f32x4 c0[4], c1[4], s0[4], s1[4]; int hvv[4]; bool on[4];
#pragma unroll
        for (int u = 0; u < 4; ++u) { const unsigned bu = base + (unsigned)u * stride; on[u] = bu < total; const unsigned hvi = ((on[u] ? bu : base) + (unsigned)tid) >> 3;
            const int row = (int)(hvi / 10u), hv = (int)(hvi - (unsigned)row * 10u), pos = row & (SEQ - 1); hvv[u] = hv;
            ptr[u] = PR + (size_t)row * NIN + (hv < 8 ? 2560 + hv * 64 : 3072 + (hv - 8) * 64) + 8 * c; w[u] = *(const u32x4*)ptr[u];
            const float* rt = ROPE + pos * 64 + 8 * (c & 3); c0[u] = *(const f32x4*)(rt); c1[u] = *(const f32x4*)(rt + 4); s0[u] = *(const f32x4*)(rt + 32); s1[u] = *(const f32x4*)(rt + 36); }
#pragma unroll
        for (int u = 0; u < 4; ++u) { if (!on[u]) continue;
            const int hv = hvv[u];
            float x[8] = {bflo(w[u].x), bfhi(w[u].x), bflo(w[u].y), bfhi(w[u].y), bflo(w[u].z), bfhi(w[u].z), bflo(w[u].w), bfhi(w[u].w)};
            float ss = 0.f;
#pragma unroll
            for (int j = 0; j < 8; ++j) ss += x[j] * x[j];
            ss += __shfl_xor(ss, 1); ss += __shfl_xor(ss, 2); ss += __shfl_xor(ss, 4);
            const float rs = __builtin_amdgcn_rsqf(ss * (1.0f / 64.0f) + EPSV) * (hv < 8 ? 0.125f : 1.0f);
            float y[8];
#pragma unroll
            for (int j = 0; j < 8; ++j) { const float gq = (j < 4 ? qg0[j] : qg1[j - 4]), gk = (j < 4 ? kg0[j] : kg1[j - 4]); x[j] = x[j] * rs * (hv < 8 ? gq : gk); }
#pragma unroll
            for (int j = 0; j < 8; ++j) { const float pr = __shfl_xor(x[j], 4); const float cs = (j < 4 ? c0[u][j] : c1[u][j - 4]), sn = (j < 4 ? s0[u][j] : s1[u][j - 4]); y[j] = (c < 4) ? (x[j] * cs - pr * sn) : (x[j] * cs + pr * sn); }
            u32x4 o; o.x = pk2(y[0], y[1]); o.y = pk2(y[2], y[3]); o.z = pk2(y[4], y[5]); o.w = pk2(y[6], y[7]);
            *(u32x4*)ptr[u] = o; }
    }
}
constexpr int AT_KS = 0, AT_VS = 46080, AT_PW = 92160;
struct AttnRegs { u32x4 kw[5], vw[5]; };
DI void attn_load(const Params& p, int unit, int tid, AttnRegs& r) {
    const int b = unit >> 8, g = (unit >> 7) & 1, qb = unit & 127, key0 = qb * 64 - 128;
    const bf16* PR = (const bf16*)(p.ws + WS_BIG);
#pragma unroll
    for (int it = 0; it < 5; ++it) { const int item = tid + it * NTHREADS, kk = item >> 3, c = item & 7, pos = key0 + kk; const bool valid = pos >= 0 && pos < SEQ; const int pc = valid ? pos : 0;
        const bf16* rp = PR + ((size_t)b * SEQ + pc) * NIN + g * 64 + 8 * c; r.kw[it] = *(const u32x4*)(rp + 3072); r.vw[it] = *(const u32x4*)(rp + 3200);
        if (!valid) { r.kw[it] = (u32x4){0u, 0u, 0u, 0u}; r.vw[it] = r.kw[it]; } }
}
DI void attn_stash(LAS unsigned char* lds, int tid, const AttnRegs& r) {
#pragma unroll
    for (int it = 0; it < 5; ++it) { const int item = tid + it * NTHREADS, kk = item >> 3, c = item & 7;
        *(LAS u32x4*)(lds + AT_KS + (kk * 72 + 8 * c) * 2) = r.kw[it]; *(LAS u32x4*)(lds + AT_VS + (kk * 72 + 8 * c) * 2) = r.vw[it]; }
}
DI void attn_unit(const Params& p, LAS unsigned char* lds, unsigned lds32, int unit, int tid) {
    const int lane = tid & 63, wave = tid >> 6, h = lane >> 5, lr = lane & 31;
    const int b = unit >> 8, g = (unit >> 7) & 1, qb = unit & 127, q0 = qb * 64, key0 = q0 - 128;
    const bf16* PR = (const bf16*)(p.ws + WS_BIG);
    bf16* MIX = (bf16*)p.out;
    const int hd = wave >> 1, qs = wave & 1, head = g * 4 + hd, qpos = q0 + 32 * qs + lr; const size_t qrow = (size_t)b * SEQ + qpos;
    bf16x8 qf[4];
#pragma unroll
    for (int s = 0; s < 4; ++s) qf[s] = __builtin_bit_cast(bf16x8, *(const u32x4*)(PR + qrow * NIN + 2560 + head * 64 + 8 * h + 16 * s));
    float gq = fabsf(p.q_norm[lane]), gk = fabsf(p.k_norm[lane]);
#pragma unroll
    for (int o_ = 32; o_ >= 1; o_ >>= 1) { gq = fmaxf(gq, __shfl_xor(gq, o_)); gk = fmaxf(gk, __shfl_xor(gk, o_)); }
    const float mref = fminf(8.0f * gq * gk, 40.0f);
    float l = 0.0f; f32x16 o0 = zero16(), o1 = zero16();
    const LAS unsigned char* pw = lds + AT_PW + wave * 4608;
    for (int c = 0; c < 5; ++c) { const int kb = 64 * c, kp0 = key0 + kb;
        if (kp0 + 63 < 0 || kp0 >= SEQ) continue;
        f32x16 s0 = zero16(), s1 = zero16(); bf16x8 ka_[4], kb_[4];
#pragma unroll
        for (int s = 0; s < 4; ++s) { ka_[s] = frag(lds + AT_KS, 72, kb, 16 * s, lane); kb_[s] = frag(lds + AT_KS, 72, kb + 32, 16 * s, lane); }
        __builtin_amdgcn_sched_barrier(0);
#pragma unroll
        for (int s = 0; s < 4; ++s) { s0 = MFMA32(ka_[s], qf[s], s0); s1 = MFMA32(kb_[s], qf[s], s1); }
        if (c == 0 || c == 4 || kp0 < 0 || kp0 + 63 >= SEQ) {
#pragma unroll
            for (int i = 0; i < 16; ++i) { const int ka = kp0 + crow(i, h), kc = ka + 32;
                const bool va = ka >= 0 && ka < SEQ && ka >= qpos - 128 && ka <= qpos + 128, vc = kc >= 0 && kc < SEQ && kc >= qpos - 128 && kc <= qpos + 128;
                s0[i] = va ? s0[i] : -INFINITY; s1[i] = vc ? s1[i] : -INFINITY; }
        }
        float ps = 0.f;
#pragma unroll
        for (int i = 0; i < 16; ++i) { s0[i] = __expf(s0[i] - mref); s1[i] = __expf(s1[i] - mref); ps += s0[i] + s1[i]; }
        l += ps;
#pragma unroll
        for (int gq_ = 0; gq_ < 4; ++gq_) { u32x2 w; w.x = pk2(s0[4 * gq_], s0[4 * gq_ + 1]); w.y = pk2(s0[4 * gq_ + 2], s0[4 * gq_ + 3]); *(LAS u32x2*)(pw + (lr * 72 + 8 * gq_ + 4 * h) * 2) = w;
            w.x = pk2(s1[4 * gq_], s1[4 * gq_ + 1]); w.y = pk2(s1[4 * gq_ + 2], s1[4 * gq_ + 3]); *(LAS u32x2*)(pw + (lr * 72 + 32 + 8 * gq_ + 4 * h) * 2) = w; }
        LDS_WAIT();
        bf16x8 pf[4], va_[4], vb_[4];
#pragma unroll
        for (int ks = 0; ks < 4; ++ks) pf[ks] = frag(pw, 72, 0, 16 * ks, lane);
        frag_tr4<72>(va_, lds32 + AT_VS, kb, 0, lane); frag_tr4<72>(vb_, lds32 + AT_VS, kb, 32, lane);
#pragma unroll
        for (int ks = 0; ks < 4; ++ks) { o0 = MFMA32(va_[ks], pf[ks], o0); o1 = MFMA32(vb_[ks], pf[ks], o1); }
        LDS_WAIT();
    }
    l += __shfl_xor(l, 32); l += __expf(p.sink[head] - mref);
    { const float inv = 1.0f / l; bf16* op = MIX + qrow * DM + 512 + head * 64;
#pragma unroll
      for (int gq = 0; gq < 4; ++gq) { u32x2 w; w.x = pk2(o0[4 * gq] * inv, o0[4 * gq + 1] * inv); w.y = pk2(o0[4 * gq + 2] * inv, o0[4 * gq + 3] * inv); *(u32x2*)(op + 8 * gq + 4 * h) = w;
          w.x = pk2(o1[4 * gq] * inv, o1[4 * gq + 1] * inv); w.y = pk2(o1[4 * gq + 2] * inv, o1[4 * gq + 3] * inv); *(u32x2*)(op + 32 + 8 * gq + 4 * h) = w; } }
}

DI void combine_phase(const Params& p, int tid, int G, int bid) {
    const int lane = tid & 63, wave = tid >> 6, gw = bid * NWAVES + wave, NGW = G * NWAVES;
    const bf16* OF = (const bf16*)(p.ws + WS_O); const bf16* OB = OF + (size_t)MTOK * HGW; const bf16* PR = (const bf16*)(p.ws + WS_BIG); bf16* MIX = (bf16*)p.out;
    const int c0 = 8 * lane; const f32x4 n0 = *(const f32x4*)(p.out_norm + (c0 & 127)), n1 = *(const f32x4*)(p.out_norm + (c0 & 127) + 4);
    const int RPW = (MTOK + NGW - 1) / NGW;
    for (int row0_ = gw * RPW; row0_ < min((gw + 1) * RPW, MTOK); row0_ += 4) {
        u32x4 av[4], bv[4], gv4[4]; bool on[4];
#pragma unroll
        for (int u = 0; u < 4; ++u) { const int row = row0_ + u; on[u] = row < min((gw + 1) * RPW, MTOK); const size_t rr = on[u] ? row : row0_;
            av[u] = *(const u32x4*)(OF + rr * HGW + c0); bv[u] = *(const u32x4*)(OB + rr * HGW + c0); gv4[u] = *(const u32x4*)(PR + rr * NIN + 2048 + c0); }
#pragma unroll
        for (int u = 0; u < 4; ++u) { if (!on[u]) continue; const int row = row0_ + u; const u32x4 a = av[u], bq = bv[u], gg = gv4[u];
            float o[8] = {bflo(a.x) + bflo(bq.x), bfhi(a.x) + bfhi(bq.x), bflo(a.y) + bflo(bq.y), bfhi(a.y) + bfhi(bq.y), bflo(a.z) + bflo(bq.z), bfhi(a.z) + bfhi(bq.z), bflo(a.w) + bflo(bq.w), bfhi(a.w) + bfhi(bq.w)};
            const float gv[8] = {bflo(gg.x), bfhi(gg.x), bflo(gg.y), bfhi(gg.y), bflo(gg.z), bfhi(gg.z), bflo(gg.w), bfhi(gg.w)};
            float ss = 0.f;
#pragma unroll
            for (int j = 0; j < 8; ++j) ss += o[j] * o[j];
            ss += __shfl_xor(ss, 1); ss += __shfl_xor(ss, 2); ss += __shfl_xor(ss, 4); ss += __shfl_xor(ss, 8);
            const float rs = __builtin_amdgcn_rsqf(ss * (1.0f / 128.0f) + EPSV);
#pragma unroll
            for (int j = 0; j < 8; ++j) o[j] = o[j] * rs * (j < 4 ? n0[j] : n1[j - 4]) * gv[j];
            u32x4 w; w.x = pk2(o[0], o[1]); w.y = pk2(o[2], o[3]); w.z = pk2(o[4], o[5]); w.w = pk2(o[6], o[7]);
            *(u32x4*)(MIX + (size_t)row * DM + c0) = w; }
    }
}

#define XB_TMO      128
#define XB_XCNT(j)  (256  + 64 * (j))
#define XB_XSUB(j)  (1280 + 64 * (j))
#define XB_XGEN(j)  (2304 + 64 * (j))
#define XB_TOP      3328
#define XB_TOPGEN   3392
#define XCD_BAR_WORDS 3456
#define XB_SPIN_CAP (1u << 22)

__device__ __forceinline__ unsigned xb_ld(unsigned* p)              { return __hip_atomic_load(p, __ATOMIC_RELAXED, __HIP_MEMORY_SCOPE_AGENT); }
__device__ __forceinline__ unsigned xb_add(unsigned* p, unsigned v) { return __hip_atomic_fetch_add(p, v, __ATOMIC_RELAXED, __HIP_MEMORY_SCOPE_AGENT); }
__device__ __forceinline__ unsigned xb_xcc_id() { return (unsigned)__builtin_amdgcn_s_getreg((3 << 11) | 20) & 0xFu; }
#define XB_SPIN(cond, bar) do { unsigned _sp = 0; while (cond) { __builtin_amdgcn_s_sleep(1); \
    if ((++_sp & 255u) == 0u) { if (xb_ld(&(bar)[XB_TMO])) break; if (_sp > XB_SPIN_CAP) { atomicAdd(&(bar)[XB_TMO], 1u); break; } } } } while (0)

struct XcdBarrier {
    unsigned* bar; unsigned x;
    volatile LAS unsigned* st;
};

__device__ __forceinline__ XcdBarrier xcd_barrier_post(unsigned* bar, volatile LAS unsigned* st) {
    XcdBarrier b; b.bar = bar; b.x = xb_xcc_id(); b.st = st;
    if (threadIdx.x == 0) (void)xb_add(&bar[XB_XCNT(b.x)], 1u);
    return b;
}
__device__ __forceinline__ void xcd_barrier_complete(unsigned* bar, unsigned x, unsigned& nloc, unsigned& nx) {
    const unsigned G = gridDim.x * gridDim.y * gridDim.z;
    unsigned sum, cnt, mine, sp = 0u;
    for (;;) {
        sum = 0u; cnt = 0u; mine = 0u;
#pragma unroll
        for (unsigned j = 0; j < 16; ++j) { const unsigned c = xb_ld(&bar[XB_XCNT(j)]); sum += c; cnt += (c > 0u) ? 1u : 0u; mine = (j == x) ? c : mine; }
        if (sum == G) break;
        __builtin_amdgcn_s_sleep(1);
        if ((++sp & 255u) == 0u) { if (xb_ld(&bar[XB_TMO])) break; if (sp > XB_SPIN_CAP) { atomicAdd(&bar[XB_TMO], 1u); break; } }
    }
    nloc = mine > 0u ? mine : 1u; nx = cnt > 0u ? cnt : 1u;
}

__device__ __forceinline__ void xcd_barrier(const XcdBarrier& b) {
    asm volatile("s_waitcnt vmcnt(0)" ::: "memory");
    __syncthreads();
    if (threadIdx.x == 0) {
        unsigned* bar = b.bar;
        __builtin_amdgcn_s_waitcnt(0);
        unsigned nloc = b.st[0], nx = b.st[1];
        if (nloc == 0u) { xcd_barrier_complete(bar, b.x, nloc, nx); b.st[0] = nloc; b.st[1] = nx; }
        const unsigned old = xb_add(&bar[XB_XSUB(b.x)], 1u);
        const unsigned gen = old / nloc;
        if (old + 1u == (gen + 1u) * nloc) {
            __builtin_amdgcn_fence(__ATOMIC_RELEASE, "agent");
            asm volatile("s_waitcnt vmcnt(0)" ::: "memory");
            const unsigned og = xb_add(&bar[XB_TOP], 1u);
            const unsigned tg = og / nx;
            if (og + 1u == (tg + 1u) * nx) xb_add(&bar[XB_TOPGEN], 1u);
            else XB_SPIN(xb_ld(&bar[XB_TOPGEN]) == tg, bar);
            __builtin_amdgcn_fence(__ATOMIC_ACQUIRE, "agent");
            xb_add(&bar[XB_XGEN(b.x)], 1u);
            asm volatile("s_waitcnt vmcnt(0)" ::: "memory");
        } else {
            XB_SPIN(xb_ld(&bar[XB_XGEN(b.x)]) == gen, bar);
            __builtin_amdgcn_fence(__ATOMIC_ACQUIRE, "agent");
            asm volatile("s_waitcnt vmcnt(0)" ::: "memory");
        }
    }
    __syncthreads();
}


DI unsigned attn_dequeue(unsigned* heads, unsigned xcc) {
    constexpr unsigned PER = (unsigned)NATT_UNITS / 8u;
    for (unsigned t = 0; t < 8u; ++t) { const unsigned x = (xcc + t) & 7u; const unsigned u = atomicAdd(heads + 64 * x, 1u); if (u < PER) return x * PER + u; }
    return (unsigned)NATT_UNITS;
}
__global__ void __launch_bounds__(NTHREADS, 2) hymba_fwd(Params p) {
    extern __shared__ __attribute__((aligned(16))) unsigned char lds_raw[];
    LAS unsigned char* lds = (LAS unsigned char*)lds_raw;
    const int tid = threadIdx.x, G = gridDim.x, bid = blockIdx.x;
    unsigned char* ws = p.ws;
    const int lo = p.ph_lo, hi = p.ph_hi;
#ifndef PH_MASK
#define PH_MASK 0x1ff
#endif
#define IN(k) (lo <= (k) && (k) < hi)
#define SEAM(k) do { if (IN(k) && IN((k) + 1)) { xcd_barrier(xbar); } } while (0)
    volatile LAS unsigned* xst = (volatile LAS unsigned*)(lds + WQ_OFF + 16);
    if (tid == 0) { xst[0] = 0u; xst[1] = 0u; }
    __syncthreads();
    XcdBarrier xbar = xcd_barrier_post((unsigned*)(p.ws + WS_BARW), xst);
    if (p.coop == 2) cg::this_grid().sync();
    bf16* XB = (bf16*)(ws + WS_XB); bf16* BIG = (bf16*)(ws + WS_BIG); bf16* X2B = (bf16*)(ws + WS_O);
    float* RSTD = (float*)(ws + WS_RSTD); float* SSQ = (float*)(ws + WS_SSQ); const float* LB = (const float*)(ws + WS_LB);
    if (((PH_MASK >> 0) & 1) && IN(0)) { p0_prologue(p, lds, tid, G, bid); }
    SEAM(0);
    if (((PH_MASK >> 1) & 1) && IN(1)) {
        pg8::Gemm g{XB, (const bf16*)(ws + WS_WI1), MTOK, 2 * DFF, DM}; pg8::StaticOrder S; S.init(MTOK, 2 * DFF, G, bid);
        pg8::EpiSwiglu<true> E{BIG, nullptr};
        pg8::gemm_phase<pg8::EpiSwiglu<true>, pg8::StaticOrder, true, true>(lds, g, S, E); }
    SEAM(1);
    if (((PH_MASK >> 2) & 1) && IN(2)) {
        pg8::Gemm g{BIG, (const bf16*)(ws + WS_WO1), MTOK, DM, DFF}; pg8::StaticOrder S; S.init(MTOK, DM, G, bid);
        pg8::EpiRes<0, false, true, true> E{nullptr, p.xp, p.xs, nullptr, XB, SSQ};
        pg8::gemm_phase<pg8::EpiRes<0, false, true, true>, pg8::StaticOrder, true, true>(lds, g, S, E); }
    SEAM(2);
    if (((PH_MASK >> 3) & 1) && IN(3)) {
        for (int row = bid * NTHREADS + tid; row < MTOK; row += G * NTHREADS) { const f32x4* sp = (const f32x4*)(SSQ + (size_t)row * 16); const f32x4 a = sp[0], b = sp[1], c = sp[2], d = sp[3];
            const float tot = ((a[0] + a[1]) + (a[2] + a[3])) + ((b[0] + b[1]) + (b[2] + b[3])) + ((c[0] + c[1]) + (c[2] + c[3])) + ((d[0] + d[1]) + (d[2] + d[3]));
            RSTD[row] = 1.0f / sqrtf(tot * (1.0f / DM) + EPSV); }
        xcd_barrier(xbar);
        pg8::Gemm g{XB, (const bf16*)(ws + WS_WIN), MTOK, NIN, DM}; pg8::StaticOrder S; S.init(MTOK, NIN, G, bid);
        pg8::EpiProj E{BIG, RSTD, LB, LB + HGW, p.q_norm, p.k_norm, (const float*)(ws + WS_ROPE)};
        pg8::gemm_phase<pg8::EpiProj, pg8::StaticOrder, true, true>(lds, g, S, E); }
    SEAM(3);
    if (((PH_MASK >> 4) & 1) && IN(4)) {
        hgrn_prepass(p, lds, tid, G, bid);
        xcd_barrier(xbar);
        const unsigned lds32 = (unsigned)(size_t)lds_raw;
        for (int u = bid; u < NSCAN_UNITS; u += G) scan_unit2(p, lds, lds32, u, tid);
        unsigned* cnt = (unsigned*)(ws + WS_CNT); LAS unsigned* wq = (LAS unsigned*)(lds + WQ_OFF);
        const unsigned myx = xb_xcc_id() & 7u;
        __syncthreads(); if (tid == 0) *wq = attn_dequeue(cnt, myx); __syncthreads();
        unsigned u = *wq; AttnRegs ar; if (u < (unsigned)NATT_UNITS) attn_load(p, (int)u, tid, ar);
        while (u < (unsigned)NATT_UNITS) {
            __syncthreads();
            attn_stash(lds, tid, ar);
            if (tid == 0) *wq = attn_dequeue(cnt, myx);
            __syncthreads();
            const unsigned un = *wq; if (un < (unsigned)NATT_UNITS) attn_load(p, (int)un, tid, ar);
            attn_unit(p, lds, lds32, (int)u, tid);
            u = un; } }
    SEAM(4);
    if (((PH_MASK >> 5) & 1) && IN(5)) { combine_phase(p, tid, G, bid); }
    SEAM(5);
    if (((PH_MASK >> 6) & 1) && IN(6)) {
        pg8::Gemm g{(const bf16*)p.out, (const bf16*)(ws + WS_WOUT), MTOK, DM, DM}; pg8::StaticOrder S; S.init(MTOK, DM, G, bid);
        pg8::EpiRes<1, false, true, false> E{nullptr, nullptr, nullptr, XB, X2B, SSQ};
        pg8::gemm_phase<pg8::EpiRes<1, false, true, false>, pg8::StaticOrder, true, true>(lds, g, S, E); }
    SEAM(6);
    if (((PH_MASK >> 7) & 1) && IN(7)) {
        for (int row = bid * NTHREADS + tid; row < MTOK; row += G * NTHREADS) { const f32x4* sp = (const f32x4*)(SSQ + (size_t)row * 16); const f32x4 a = sp[0], b = sp[1], c = sp[2], d = sp[3];
            const float tot = ((a[0] + a[1]) + (a[2] + a[3])) + ((b[0] + b[1]) + (b[2] + b[3])) + ((c[0] + c[1]) + (c[2] + c[3])) + ((d[0] + d[1]) + (d[2] + d[3]));
            RSTD[row] = 1.0f / sqrtf(tot * (1.0f / DM) + EPSV); }
        xcd_barrier(xbar);
        pg8::Gemm g{X2B, (const bf16*)(ws + WS_WI2), MTOK, 2 * DFF, DM}; pg8::StaticOrder S; S.init(MTOK, 2 * DFF, G, bid);
        pg8::EpiSwiglu<false> E{BIG, RSTD};
        pg8::gemm_phase<pg8::EpiSwiglu<false>, pg8::StaticOrder, true, true>(lds, g, S, E); }
    SEAM(7);
    if (((PH_MASK >> 8) & 1) && IN(8)) {
        pg8::Gemm g{BIG, (const bf16*)(ws + WS_WO2), MTOK, DM, DFF}; pg8::StaticOrder S; S.init(MTOK, DM, G, bid);
        pg8::EpiRes<1, true, false, true> E{p.out, nullptr, nullptr, X2B, nullptr, nullptr};
        pg8::gemm_phase<pg8::EpiRes<1, true, false, true>, pg8::StaticOrder, true, true>(lds, g, S, E); }
#undef IN
#undef SEAM
}

#ifndef MK_MULTI
#define MK_MULTI 0
#endif
constexpr int NPHASES = 9;
extern "C" void kernel_launch(void* const* d_in, const int* in_sizes, int n_in, void* d_out, int out_size, void* d_ws, size_t ws_size, hipStream_t stream) {
    static int grid = 0;
    if (grid == 0) {
        int dev = 0, cus = 0;
        if (hipGetDevice(&dev) != hipSuccess || hipDeviceGetAttribute(&cus, hipDeviceAttributeMultiprocessorCount, dev) != hipSuccess) { fprintf(stderr, "kernel_launch: device query failed\n"); grid = -1; return; }
        if (hipFuncSetAttribute((const void*)hymba_fwd, hipFuncAttributeMaxDynamicSharedMemorySize, LDS_BYTES) != hipSuccess) { fprintf(stderr, "kernel_launch: hipFuncSetAttribute failed\n"); grid = -1; return; }
        int per_cu = 0;
        if (hipOccupancyMaxActiveBlocksPerMultiprocessor(&per_cu, (const void*)hymba_fwd, NTHREADS, LDS_BYTES) != hipSuccess || per_cu < 1) { fprintf(stderr, "kernel_launch: occupancy query says %d blocks per CU\n", per_cu); }
        (void)hipGetLastError();
        grid = cus;
        if (n_in != 17 || ws_size < WS_END) { fprintf(stderr, "kernel_launch: unexpected n_in %d or ws_size %zu (< %zu)\n", n_in, ws_size, (size_t)WS_END); }
    }
    if (grid < 0) return;
    Params p{};
    p.xp = (const float*)d_in[0]; p.xs = (const float*)d_in[1]; p.ffn1_norm = (const float*)d_in[2]; p.ffn1_wi = (const float*)d_in[3]; p.ffn1_wo = (const float*)d_in[4];
    p.mix_norm = (const float*)d_in[5]; p.w_in = (const float*)d_in[6]; p.lb_fwd = (const float*)d_in[7]; p.lb_bwd = (const float*)d_in[8]; p.out_norm = (const float*)d_in[9];
    p.q_norm = (const float*)d_in[10]; p.k_norm = (const float*)d_in[11]; p.sink = (const float*)d_in[12]; p.w_out = (const float*)d_in[13]; p.ffn2_norm = (const float*)d_in[14];
    p.ffn2_wi = (const float*)d_in[15]; p.ffn2_wo = (const float*)d_in[16];
    p.out = (float*)d_out; p.ws = (unsigned char*)d_ws;
    for (int i = 0; i < 32; ++i) p.inv_freq_rev[i] = pow(10000.0, -(double)(2 * i) / 64.0) / 6.283185307179586476925286766559;
#if MK_MULTI
    for (int ph = 0; ph < NPHASES; ++ph) { p.ph_lo = ph; p.ph_hi = ph + 1; p.coop = 0;
        hipLaunchKernelGGL(hymba_fwd, dim3(grid), dim3(NTHREADS), LDS_BYTES, stream, p);
        const hipError_t le = hipPeekAtLastError(); if (le != hipSuccess) { fprintf(stderr, "kernel_launch: launch %d failed: %s\n", ph, hipGetErrorName(le)); break; } }
#else
    if (hipMemsetAsync((unsigned char*)d_ws + WS_BARW, 0, 16384, stream) != hipSuccess) { fprintf(stderr, "kernel_launch: hipMemsetAsync failed\n"); return; }
    p.ph_lo = 0; p.ph_hi = NPHASES; p.coop = 1;
    void* args[] = {&p};
    const hipError_t le = hipLaunchCooperativeKernel((const void*)hymba_fwd, dim3(grid), dim3(NTHREADS), args, LDS_BYTES, stream);
    if (le != hipSuccess) fprintf(stderr, "kernel_launch: cooperative launch failed: %s (grid %d)\n", hipGetErrorName(le), grid);
#endif
}
```
